# Optimizing an MI355X kernel written in HIP

```python
import math
import jax, jax.numpy as jnp
from jax import lax
import numpy as np

D_MODEL = 1024
BATCH = 4
SEQ = 8192
DEPTH = 1

NSA_HEADS = 8
NSA_KV_GROUPS = 2
NSA_HPG = NSA_HEADS // NSA_KV_GROUPS
NSA_DK = 64
NSA_DV = 64
CMP_LEN = 32
CMP_STRIDE = 16
CMP_HIDDEN = 256
SLC_BLOCK = 64
SLC_TOPK = 16
WINDOW = 512
NSA_QCHUNK = 64
FORCED_SCORE = 1e4
ML_HEADS = 4
ML_DK = 128
ML_DV = 128
ML_CHUNK = 64
CONV_WIDTH = 4
D_FF = 4 * D_MODEL
REL_BUCKETS = 32
REL_MAX_DIST = 128
RMS_EPS = 1e-6

NSA_QW = NSA_HEADS * NSA_DK
NSA_KW = NSA_KV_GROUPS * NSA_DK
NSA_VW = NSA_KV_GROUPS * NSA_DV
NSA_OW = NSA_HEADS * NSA_DV
ML_QW = ML_HEADS * ML_DK
ML_VW = ML_HEADS * ML_DV
PROJ_WIDTHS = (NSA_QW, NSA_KW, NSA_VW, NSA_KW, NSA_VW, NSA_KW, NSA_VW, 3 * NSA_HEADS,
               ML_QW, ML_QW, ML_VW, ML_HEADS, ML_HEADS, ML_VW, 2 * D_MODEL)
D_PROJ = sum(PROJ_WIDTHS)

kernel_name = 'hybrid_nsa_mlstm_block'


def rms_norm(x, g):
    xf = x.astype(jnp.float32)
    y = xf * lax.rsqrt(jnp.mean(xf * xf, axis=-1, keepdims=True) + RMS_EPS)
    return (y * g.astype(jnp.float32)).astype(x.dtype)


def t5_bucket(dist):
    n = jnp.maximum(dist, 0)
    max_exact = REL_BUCKETS // 2
    nf = jnp.maximum(n, 1).astype(jnp.float32)
    large = max_exact + (jnp.log(nf / max_exact) / math.log(REL_MAX_DIST / max_exact)
                         * (REL_BUCKETS - max_exact)).astype(jnp.int32)
    return jnp.where(n < max_exact, n, jnp.minimum(large, REL_BUCKETS - 1))


def masked_softmax(s, mask):
    s = jnp.where(mask, s.astype(jnp.float32), -jnp.inf)
    m = jnp.max(s, axis=-1, keepdims=True)
    m = jnp.where(jnp.isfinite(m), m, 0.0)
    p = jnp.where(mask, jnp.exp(s - m), 0.0)
    return p / jnp.maximum(jnp.sum(p, axis=-1, keepdims=True), 1e-30)


def compress_blocks(kv, pos, w1, b1, w2, b2):
    bsz, s, g, d = kv.shape
    segs = kv.reshape(bsz, s // CMP_STRIDE, CMP_STRIDE, g, d)
    blocks = jnp.concatenate([segs[:, :-1], segs[:, 1:]], axis=2) + pos[:, None, :]
    flat = blocks.transpose(0, 1, 3, 2, 4).reshape(bsz, s // CMP_STRIDE - 1, g, CMP_LEN * d)
    return jax.nn.gelu(flat @ w1 + b1) @ w2 + b2


def nsa_mixer(q, kc, vc, ks, vs, kw, vw, gate_logits, q_gain, k_gain, cmp_k, cmp_v, rel_table):
    bsz, s = q.shape[:2]
    G, HPG = NSA_KV_GROUPS, NSA_HPG
    nc = s // CMP_STRIDE - 1
    ns = s // SLC_BLOCK
    topk = min(SLC_TOPK, ns)
    qg = (rms_norm(q, q_gain) * (NSA_DK ** -0.5)).reshape(bsz, s, G, HPG, NSA_DK)
    kcmp = rms_norm(compress_blocks(kc, *cmp_k), k_gain[0])
    vcmp = compress_blocks(vc, *cmp_v)
    ks_blk = rms_norm(ks, k_gain[1]).reshape(bsz, ns, SLC_BLOCK, G, NSA_DK)
    vs_blk = vs.reshape(bsz, ns, SLC_BLOCK, G, NSA_DV)
    pad = ((0, 0), (WINDOW, 0), (0, 0), (0, 0))
    kw_pad = jnp.pad(rms_norm(kw, k_gain[2]), pad)
    vw_pad = jnp.pad(vw, pad)
    gates = jax.nn.sigmoid(gate_logits.astype(jnp.float32)).astype(q.dtype).reshape(bsz, s, G, HPG, 3)
    table = rel_table.reshape(REL_BUCKETS, G, HPG)
    cmp_end = jnp.arange(nc) * CMP_STRIDE + (CMP_LEN - 1)
    ci = jnp.arange(nc)[:, None] * CMP_STRIDE
    sj = jnp.arange(ns)[None, :] * SLC_BLOCK
    cmp_to_slc = ((ci < sj + SLC_BLOCK) & (ci + CMP_LEN > sj)).astype(jnp.float32)
    blk_ids = jnp.arange(ns)
    b_i = jnp.arange(bsz)[:, None, None, None]
    g_i = jnp.arange(G)[None, None, :, None]
    g_i5 = jnp.arange(G)[None, None, :, None, None]

    def chunk(c):
        t0 = c * NSA_QCHUNK
        t = t0 + jnp.arange(NSA_QCHUNK)
        qc = lax.dynamic_slice_in_dim(qg, t0, NSA_QCHUNK, axis=1)
        dist_c = t[:, None] - cmp_end[None, :]
        bias_c = table[t5_bucket(dist_c)].transpose(0, 2, 3, 1)
        s_c = jnp.einsum('bqghd,bngd->bqghn', qc, kcmp).astype(jnp.float32) + bias_c
        p_c = masked_softmax(s_c, (dist_c >= 0)[:, None, None, :])
        o_c = jnp.einsum('bqghn,bngd->bqghd', p_c.astype(vcmp.dtype), vcmp)
        imp = jnp.sum(p_c, axis=3) @ cmp_to_slc
        cur = t // SLC_BLOCK
        valid = (blk_ids[None, :] * SLC_BLOCK) <= t[:, None]
        forced = (blk_ids[None, :] == 0) | (blk_ids[None, :] == cur[:, None]) | (blk_ids[None, :] == cur[:, None] - 1)
        score = jnp.where(forced[None, :, None, :], FORCED_SCORE,
                          jnp.where(valid[None, :, None, :], imp, -1.0))
        _, idx = lax.top_k(score, topk)
        k_sel = ks_blk[b_i, idx, :, g_i, :]
        v_sel = vs_blk[b_i, idx, :, g_i, :]
        pos_s = idx[..., None] * SLC_BLOCK + jnp.arange(SLC_BLOCK)
        dist_s = t[None, :, None, None, None] - pos_s
        bias_s = jnp.moveaxis(table[t5_bucket(dist_s), g_i5], -1, 3)
        s_s = (jnp.einsum('bqghd,bqgnkd->bqghnk', qc, k_sel).astype(jnp.float32) + bias_s)
        s_s = s_s.reshape(bsz, NSA_QCHUNK, G, HPG, topk * SLC_BLOCK)
        p_s = masked_softmax(s_s, (dist_s >= 0).reshape(bsz, NSA_QCHUNK, G, 1, topk * SLC_BLOCK))
        o_s = jnp.einsum('bqghm,bqgmd->bqghd', p_s.astype(v_sel.dtype),
                         v_sel.reshape(bsz, NSA_QCHUNK, G, topk * SLC_BLOCK, NSA_DV))
        kwc = lax.dynamic_slice_in_dim(kw_pad, t0, NSA_QCHUNK + WINDOW, axis=1)
        vwc = lax.dynamic_slice_in_dim(vw_pad, t0, NSA_QCHUNK + WINDOW, axis=1)
        pos_w = t0 - WINDOW + jnp.arange(NSA_QCHUNK + WINDOW)
        dist_w = t[:, None] - pos_w[None, :]
        mask_w = (dist_w >= 0) & (dist_w < WINDOW) & (pos_w >= 0)[None, :]
        bias_w = table[t5_bucket(dist_w)].transpose(0, 2, 3, 1)
        s_w = jnp.einsum('bqghd,bkgd->bqghk', qc, kwc).astype(jnp.float32) + bias_w
        p_w = masked_softmax(s_w, mask_w[:, None, None, :])
        o_w = jnp.einsum('bqghk,bkgd->bqghd', p_w.astype(vwc.dtype), vwc)
        gc = lax.dynamic_slice_in_dim(gates, t0, NSA_QCHUNK, axis=1)
        o = gc[..., 0:1] * o_c + gc[..., 1:2] * o_s + gc[..., 2:3] * o_w
        return o.reshape(bsz, NSA_QCHUNK, NSA_OW)

    out = lax.map(chunk, jnp.arange(s // NSA_QCHUNK))
    return out.transpose(1, 0, 2, 3).reshape(bsz, s, NSA_OW)


def causal_dwconv(x, w, b):
    s = x.shape[1]
    xp = jnp.pad(x, ((0, 0), (CONV_WIDTH - 1, 0), (0, 0)))
    y = b
    for j in range(CONV_WIDTH):
        y = y + xp[:, j:j + s] * w[j]
    return y


def mlstm_mixer(q, k, v, i_raw, f_raw, o_raw, conv_w, conv_b, i_bias, f_bias):
    bsz, s = q.shape[:2]
    nch = s // ML_CHUNK
    qk = jax.nn.silu(causal_dwconv(jnp.concatenate([q, k], axis=-1), conv_w, conv_b))
    q, k = jnp.split(qk, 2, axis=-1)

    def to_chunks(a, d):
        return a.astype(jnp.float32).reshape(bsz, nch, ML_CHUNK, ML_HEADS, d).transpose(1, 0, 3, 2, 4)

    def gate_chunks(a):
        return a.astype(jnp.float32).reshape(bsz, nch, ML_CHUNK, ML_HEADS).transpose(1, 0, 3, 2)

    qc = to_chunks(q * (ML_DK ** -0.5), ML_DK)
    kc = to_chunks(k, ML_DK)
    vc = to_chunks(v, ML_DV)
    li = gate_chunks(i_raw + i_bias)
    lf = jax.nn.log_sigmoid(gate_chunks(f_raw + f_bias))
    causal = jnp.tril(jnp.ones((ML_CHUNK, ML_CHUNK), dtype=bool))

    def step(carry, inp):
        c_mat, n_vec, m_prev = carry
        qb, kb, vb, lib, lfb = inp
        b = jnp.cumsum(lfb, axis=-1)
        g = b[..., -1]
        log_d = jnp.where(causal, b[..., :, None] - b[..., None, :] + lib[..., None, :], -jnp.inf)
        inter = b + m_prev[..., None]
        m_row = jnp.maximum(inter, jnp.max(log_d, axis=-1))
        w = jnp.einsum('bhid,bhjd->bhij', qb, kb) * jnp.exp(log_d - m_row[..., None])
        inter_scale = jnp.exp(inter - m_row)
        num = inter_scale[..., None] * jnp.einsum('bhid,bhde->bhie', qb, c_mat) + jnp.einsum('bhij,bhje->bhie', w, vb)
        den = inter_scale * jnp.einsum('bhid,bhd->bhi', qb, n_vec) + jnp.sum(w, axis=-1)
        h = num / jnp.maximum(jnp.abs(den), jnp.exp(-m_row))[..., None]
        log_src = g[..., None] - b + lib
        m_new = jnp.maximum(g + m_prev, jnp.max(log_src, axis=-1))
        decay = jnp.exp(g + m_prev - m_new)
        src = jnp.exp(log_src - m_new[..., None])
        c_new = decay[..., None, None] * c_mat + jnp.einsum('bhj,bhjd,bhje->bhde', src, kb, vb)
        n_new = decay[..., None] * n_vec + jnp.einsum('bhj,bhjd->bhd', src, kb)
        return (c_new, n_new, m_new), h

    init = (jnp.zeros((bsz, ML_HEADS, ML_DK, ML_DV), jnp.float32),
            jnp.zeros((bsz, ML_HEADS, ML_DK), jnp.float32),
            jnp.zeros((bsz, ML_HEADS), jnp.float32))
    _, h = lax.scan(step, init, (qc, kc, vc, li, lf))
    h = h.transpose(1, 0, 3, 2, 4).reshape(bsz, s, ML_VW)
    return (jax.nn.sigmoid(o_raw.astype(jnp.float32)) * h).astype(o_raw.dtype)


def setup_inputs(seed: int = 0) -> dict:
    key = jax.random.key(seed)
    keys = iter(jax.random.split(key, 40))

    def nrm(shape, scale):
        return jax.random.normal(next(keys), shape, jnp.float32) * scale

    L = DEPTH
    inp = {}
    inp['x'] = nrm((BATCH, SEQ, D_MODEL), 1.0)
    inp['norm1_g'] = 1.0 + nrm((L, D_MODEL), 0.01)
    inp['w_in'] = nrm((L, D_MODEL, D_PROJ), D_MODEL ** -0.5)
    inp['nsa_q_gain'] = 1.0 + nrm((L, NSA_DK), 0.01)
    inp['nsa_k_gain'] = 1.0 + nrm((L, 3, NSA_DK), 0.01)
    for name, d in (('k', NSA_DK), ('v', NSA_DV)):
        inp['cmp_' + name + '_pos'] = nrm((L, CMP_LEN, d), 0.1)
        inp['cmp_' + name + '_w1'] = nrm((L, CMP_LEN * d, CMP_HIDDEN), (CMP_LEN * d) ** -0.5)
        inp['cmp_' + name + '_b1'] = nrm((L, CMP_HIDDEN), 0.01)
        inp['cmp_' + name + '_w2'] = nrm((L, CMP_HIDDEN, d), CMP_HIDDEN ** -0.5)
        inp['cmp_' + name + '_b2'] = nrm((L, d), 0.01)
    inp['rel_table'] = nrm((REL_BUCKETS, NSA_HEADS), 0.5)
    inp['ml_conv_w'] = nrm((L, CONV_WIDTH, 2 * ML_QW), CONV_WIDTH ** -0.5)
    inp['ml_conv_b'] = nrm((L, 2 * ML_QW), 0.01)
    inp['ml_i_bias'] = nrm((L, ML_HEADS), 0.1)
    inp['ml_f_bias'] = jnp.linspace(3.0, 6.0, ML_HEADS, dtype=jnp.float32)[None, :] + nrm((L, ML_HEADS), 0.1)
    inp['w_branch_a'] = nrm((L, NSA_OW, D_MODEL), NSA_OW ** -0.5)
    inp['w_branch_b'] = nrm((L, ML_VW, D_MODEL), ML_VW ** -0.5)
    inp['w_out'] = nrm((L, D_MODEL, D_MODEL), D_MODEL ** -0.5)
    inp['norm2_g'] = 1.0 + nrm((L, D_MODEL), 0.01)
    inp['w_ff1'] = nrm((L, D_MODEL, D_FF), D_MODEL ** -0.5)
    inp['w_ff2'] = nrm((L, D_FF, D_MODEL), D_FF ** -0.5)
    return inp


def reference(x, norm1_g, w_in, nsa_q_gain, nsa_k_gain,
              cmp_k_pos, cmp_k_w1, cmp_k_b1, cmp_k_w2, cmp_k_b2,
              cmp_v_pos, cmp_v_w1, cmp_v_b1, cmp_v_w2, cmp_v_b2,
              rel_table, ml_conv_w, ml_conv_b, ml_i_bias, ml_f_bias,
              w_branch_a, w_branch_b, w_out, norm2_g, w_ff1, w_ff2):
    bsz, s = x.shape[:2]
    offsets = np.cumsum(PROJ_WIDTHS)[:-1].tolist()
    for l in range(DEPTH):
        h = rms_norm(x, norm1_g[l])
        proj = h @ w_in[l]
        (nq, nkc, nvc, nks, nvs, nkw, nvw, ngate,
         mq, mk, mv, mi, mf, mo, mgate) = jnp.split(proj, offsets, axis=-1)
        heads = lambda a, n: a.reshape(bsz, s, n, -1)
        y_a = nsa_mixer(heads(nq, NSA_HEADS),
                        heads(nkc, NSA_KV_GROUPS), heads(nvc, NSA_KV_GROUPS),
                        heads(nks, NSA_KV_GROUPS), heads(nvs, NSA_KV_GROUPS),
                        heads(nkw, NSA_KV_GROUPS), heads(nvw, NSA_KV_GROUPS),
                        ngate, nsa_q_gain[l], nsa_k_gain[l],
                        (cmp_k_pos[l], cmp_k_w1[l], cmp_k_b1[l], cmp_k_w2[l], cmp_k_b2[l]),
                        (cmp_v_pos[l], cmp_v_w1[l], cmp_v_b1[l], cmp_v_w2[l], cmp_v_b2[l]),
                        rel_table)
        y_b = mlstm_mixer(mq, mk, mv, mi, mf, mo, ml_conv_w[l], ml_conv_b[l], ml_i_bias[l], ml_f_bias[l])
        gate_a, gate_b = jnp.split(jax.nn.sigmoid(mgate), 2, axis=-1)
        mixed = gate_a * (y_a @ w_branch_a[l]) + gate_b * (y_b @ w_branch_b[l])
        x = x + mixed @ w_out[l]
        h2 = rms_norm(x, norm2_g[l])
        x = x + jnp.square(jax.nn.relu(h2 @ w_ff1[l])) @ w_ff2[l]
    return x
```

```cpp
#include <hip/hip_runtime.h>
#include <cstdint>
#include <cstdio>

constexpr int D_MODEL = 1024, BATCH = 4, SEQ = 8192, NTOK = BATCH * SEQ;
constexpr int D_PROJ = 5408, D_FF = 4096;
constexpr int C_NQ = 0, C_NKC = 512, C_NVC = 640, C_NKS = 768, C_NVS = 896, C_NKW = 1024, C_NVW = 1152, C_NGATE = 1280;
constexpr int C_MQ = 1304, C_MG = 3360;
constexpr int NSA_W = 1304;
constexpr int ML_W = 2056;
constexpr int P_MQ = 0, P_MK = 512, P_MV = 1024, P_MI = 1536, P_MF = 1540, P_MO = 1544;
constexpr int NCMP = 511, NSLC = 128;

__device__ const unsigned char BUCKET_TAB[129] = {0, 1, 2, 3, 4, 5, 6, 7, 8, 9, 10, 11, 12, 13, 14, 15, 16, 16, 16, 17, 17, 18, 18, 18, 19, 19, 19, 20, 20, 20, 20, 21, 21, 21, 21, 22, 22, 22, 22, 22, 23, 23, 23, 23, 23, 23, 24, 24, 24, 24, 24, 24, 25, 25, 25, 25, 25, 25, 25, 26, 26, 26, 26, 26, 26, 26, 26, 27, 27, 27, 27, 27, 27, 27, 27, 27, 27, 28, 28, 28, 28, 28, 28, 28, 28, 28, 28, 29, 29, 29, 29, 29, 29, 29, 29, 29, 29, 29, 29, 30, 30, 30, 30, 30, 30, 30, 30, 30, 30, 30, 30, 30, 30, 31, 31, 31, 31, 31, 31, 31, 31, 31, 31, 31, 31, 31, 31, 31, 31};
__device__ __forceinline__ int t5_bucket(int dist) { return dist >= 128 ? 31 : (int)BUCKET_TAB[dist < 0 ? 0 : dist]; }

__device__ __forceinline__ float wave_sum(float v) {
#pragma unroll
    for (int o = 1; o < 64; o <<= 1) v += __shfl_xor(v, o);
    return v;
}
__device__ __forceinline__ float wave_max(float v) {
#pragma unroll
    for (int o = 1; o < 64; o <<= 1) v = fmaxf(v, __shfl_xor(v, o));
    return v;
}
__device__ __forceinline__ float sigmoidf_(float x) { return 1.f / (1.f + expf(-x)); }

__global__ __launch_bounds__(256) void rowstat_k(const float* __restrict__ x, float* __restrict__ rstd, int rows) {
    const int w = (blockIdx.x * 256 + threadIdx.x) >> 6, lane = threadIdx.x & 63;
    if (w >= rows) return;
    const float4* p = (const float4*)(x + (size_t)w * D_MODEL);
    float s = 0.f;
#pragma unroll
    for (int j = 0; j < 4; ++j) { const float4 v = p[lane + 64 * j]; s += v.x * v.x + v.y * v.y + v.z * v.z + v.w * v.w; }
    s = wave_sum(s);
    if (lane == 0) rstd[w] = 1.f / sqrtf(s * (1.f / D_MODEL) + 1e-6f);
}

template <int EPI>
__global__ __launch_bounds__(256) void gemm_f32(const float* __restrict__ A, int lda, const float* __restrict__ gk, const float* __restrict__ Bm, int ldb,
                                                float* C, int ldc, const float* __restrict__ rs, const float* T2, int ldt, int M, int N, int K) {
    __shared__ __attribute__((aligned(16))) float As[16][68];
    __shared__ __attribute__((aligned(16))) float Bs[16][68];
    const int tid = threadIdx.x, tx = tid & 15, ty = tid >> 4;
    const int m0 = blockIdx.y * 64, n0 = blockIdx.x * 64;
    float acc[4][4];
#pragma unroll
    for (int i = 0; i < 4; ++i)
#pragma unroll
        for (int j = 0; j < 4; ++j) acc[i][j] = 0.f;
    for (int k0 = 0; k0 < K; k0 += 16) {
        {
            const int r = tid >> 2, kq = (tid & 3) * 4;
            float4 v = *(const float4*)(A + (size_t)(m0 + r) * lda + k0 + kq);
            if (gk) { const float4 g = *(const float4*)(gk + k0 + kq); v.x *= g.x; v.y *= g.y; v.z *= g.z; v.w *= g.w; }
            As[kq + 0][r] = v.x; As[kq + 1][r] = v.y; As[kq + 2][r] = v.z; As[kq + 3][r] = v.w;
        }
        {
            const int kr = tid >> 4, nq = (tid & 15) * 4;
            float4 v = make_float4(0.f, 0.f, 0.f, 0.f);
            if (n0 + nq < N) v = *(const float4*)(Bm + (size_t)(k0 + kr) * ldb + n0 + nq);
            *(float4*)&Bs[kr][nq] = v;
        }
        __syncthreads();
#pragma unroll
        for (int k = 0; k < 16; ++k) {
            const float4 a = *(const float4*)&As[k][ty * 4];
            const float4 b = *(const float4*)&Bs[k][tx * 4];
            acc[0][0] += a.x * b.x; acc[0][1] += a.x * b.y; acc[0][2] += a.x * b.z; acc[0][3] += a.x * b.w;
            acc[1][0] += a.y * b.x; acc[1][1] += a.y * b.y; acc[1][2] += a.y * b.z; acc[1][3] += a.y * b.w;
            acc[2][0] += a.z * b.x; acc[2][1] += a.z * b.y; acc[2][2] += a.z * b.z; acc[2][3] += a.z * b.w;
            acc[3][0] += a.w * b.x; acc[3][1] += a.w * b.y; acc[3][2] += a.w * b.z; acc[3][3] += a.w * b.w;
        }
        __syncthreads();
    }
#pragma unroll
    for (int i = 0; i < 4; ++i) {
        const int m = m0 + ty * 4 + i;
        const float sc = rs ? rs[m] : 1.f;
#pragma unroll
        for (int j = 0; j < 4; ++j) {
            const int n = n0 + tx * 4 + j;
            if (n < N) {
                const float v = acc[i][j] * sc;
                float* cp = C + (size_t)m * ldc + n;
                if (EPI == 0) *cp = v;
                else if (EPI == 1) *cp = T2[(size_t)m * ldt + n] + v;
                else if (EPI == 2) { const float r = fmaxf(v, 0.f); *cp = r * r; }
                else if (EPI == 3) *cp = sigmoidf_(v) * (*cp);
                else *cp = *cp + sigmoidf_(v) * T2[(size_t)m * ldt + n];
            }
        }
    }
}

__global__ __launch_bounds__(256) void nsa_norm_k(float* PA, const float* __restrict__ qg, const float* __restrict__ kg) {
    const int w = (blockIdx.x * 256 + threadIdx.x) >> 6, lane = threadIdx.x & 63;
    const int row = w / 12, v = w % 12;
    if (row >= NTOK) return;
    int col; const float* gain; float sc = 1.f;
    if (v < 8) { col = C_NQ + v * 64; gain = qg; sc = 0.125f; }
    else if (v < 10) { col = C_NKS + (v - 8) * 64; gain = kg + 64; }
    else { col = C_NKW + (v - 10) * 64; gain = kg + 128; }
    float* p = PA + (size_t)row * NSA_W + col + lane;
    const float x = *p;
    const float ss = wave_sum(x * x);
    *p = x * (1.f / sqrtf(ss * (1.f / 64.f) + 1e-6f)) * gain[lane] * sc;
}

__global__ __launch_bounds__(256) void compress_k(const float* __restrict__ PA, int coloff, const float* __restrict__ pos, const float* __restrict__ w1, const float* __restrict__ b1,
                                                  const float* __restrict__ w2, const float* __restrict__ b2, const float* __restrict__ gain, float* __restrict__ out) {
    __shared__ float in[2048];
    __shared__ float hid[256];
    const int tid = threadIdx.x, blk = blockIdx.x;
    const int g = blk & 1, n = (blk >> 1) % NCMP, b = (blk >> 1) / NCMP;
    for (int i = tid; i < 2048; i += 256) { const int j = i >> 6, d = i & 63; in[i] = PA[(size_t)(b * SEQ + 16 * n + j) * NSA_W + coloff + g * 64 + d] + pos[i]; }
    __syncthreads();
    float a = b1[tid];
    for (int i = 0; i < 2048; ++i) a += in[i] * w1[(size_t)i * 256 + tid];
    { const float x = a; const float u = 0.7978845608028654f * (x + 0.044715f * x * x * x); hid[tid] = 0.5f * x * (1.f + tanhf(u)); }
    __syncthreads();
    if (tid < 64) {
        float o = b2[tid];
        for (int u = 0; u < 256; ++u) o += hid[u] * w2[u * 64 + tid];
        if (gain) { const float ss = wave_sum(o * o); o = o * (1.f / sqrtf(ss * (1.f / 64.f) + 1e-6f)) * gain[tid]; }
        out[((size_t)(b * NCMP + n) * 2 + g) * 64 + tid] = o;
    }
}

__global__ __launch_bounds__(256) void nsa_cmp_k(const float* __restrict__ PA, const float* __restrict__ kcmp, const float* __restrict__ vcmp, const float* __restrict__ rel,
                                                 float* __restrict__ ya, int* __restrict__ selidx) {
    __shared__ float q[256];
    __shared__ float p[4][512];
    __shared__ float Psum[512];
    __shared__ float sc[128];
    const int tid = threadIdx.x, lane = tid & 63, hw = tid >> 6;
    const int bt = blockIdx.x >> 1, g = blockIdx.x & 1, b = bt / SEQ, t = bt % SEQ, c = t >> 6;
    q[tid] = PA[(size_t)bt * NSA_W + C_NQ + g * 256 + tid];
    __syncthreads();
    const int nvalid = (t >= 31) ? ((t - 31) / 16 + 1) : 0;
    for (int n = tid; n < 512; n += 256) {
        float s0 = -INFINITY, s1 = -INFINITY, s2 = -INFINITY, s3 = -INFINITY;
        if (n < nvalid) {
            const float* kr = kcmp + ((size_t)(b * NCMP + n) * 2 + g) * 64;
            float a0 = 0.f, a1 = 0.f, a2 = 0.f, a3 = 0.f;
            for (int d = 0; d < 64; ++d) { const float kv = kr[d]; a0 += q[d] * kv; a1 += q[64 + d] * kv; a2 += q[128 + d] * kv; a3 += q[192 + d] * kv; }
            const int bk = t5_bucket(t - (16 * n + 31));
            s0 = a0 + rel[bk * 8 + 4 * g + 0]; s1 = a1 + rel[bk * 8 + 4 * g + 1]; s2 = a2 + rel[bk * 8 + 4 * g + 2]; s3 = a3 + rel[bk * 8 + 4 * g + 3];
        }
        p[0][n] = s0; p[1][n] = s1; p[2][n] = s2; p[3][n] = s3;
    }
    __syncthreads();
    {
        float m = -INFINITY;
        for (int n = lane; n < nvalid; n += 64) m = fmaxf(m, p[hw][n]);
        m = wave_max(m);
        if (nvalid == 0) m = 0.f;
        float sum = 0.f;
        for (int n = lane; n < 512; n += 64) { const float e = (n < nvalid) ? expf(p[hw][n] - m) : 0.f; p[hw][n] = e; sum += e; }
        sum = wave_sum(sum);
        const float inv = 1.f / fmaxf(sum, 1e-30f);
        for (int n = lane; n < 512; n += 64) p[hw][n] *= inv;
    }
    __syncthreads();
    {
        float o = 0.f;
        for (int n = 0; n < nvalid; ++n) o += p[hw][n] * vcmp[((size_t)(b * NCMP + n) * 2 + g) * 64 + lane];
        const float gate = sigmoidf_(PA[(size_t)bt * NSA_W + C_NGATE + (4 * g + hw) * 3 + 0]);
        ya[(size_t)bt * 512 + (4 * g + hw) * 64 + lane] = gate * o;
    }
    for (int n = tid; n < 512; n += 256) Psum[n] = (n < NCMP) ? ((p[0][n] + p[1][n]) + (p[2][n] + p[3][n])) : 0.f;
    __syncthreads();
    if (tid < 128) {
        const int j = tid;
        float im = 0.f;
        for (int n = 4 * j - 1; n <= 4 * j + 3; ++n) if (n >= 0 && n < NCMP) im += Psum[n];
        float s;
        if (j == 0 || j == c || j == c - 1) s = 1e4f; else if (j <= c) s = im; else s = -1.f;
        sc[j] = s;
    }
    __syncthreads();
    if (tid < 128) {
        const int j = tid; const float s = sc[j]; int rank = 0;
        for (int i = 0; i < 128; ++i) { const float si = sc[i]; rank += ((si > s) || (si == s && i < j)) ? 1 : 0; }
        if (rank < 16) selidx[((size_t)bt * 2 + g) * 16 + rank] = j;
    }
}

template <int MODE>
__global__ __launch_bounds__(256) void nsa_kv_k(const float* __restrict__ PA, const float* __restrict__ rel, const int* __restrict__ selidx, float* __restrict__ ya) {
    constexpr int NK = MODE == 0 ? 1024 : 512;
    constexpr int KOFF = MODE == 0 ? C_NKS : C_NKW, VOFF = MODE == 0 ? C_NVS : C_NVW;
    __shared__ float q[256];
    __shared__ float s[4][NK];
    __shared__ int sel[16];
    const int tid = threadIdx.x, lane = tid & 63, hw = tid >> 6;
    const int bt = blockIdx.x >> 1, g = blockIdx.x & 1, b = bt / SEQ, t = bt % SEQ;
    q[tid] = PA[(size_t)bt * NSA_W + C_NQ + g * 256 + tid];
    if (MODE == 0 && tid < 16) sel[tid] = selidx[((size_t)bt * 2 + g) * 16 + tid];
    __syncthreads();
    for (int m = tid; m < NK; m += 256) {
        const int pos = (MODE == 0) ? (sel[m >> 6] * 64 + (m & 63)) : (t - 511 + m);
        float s0 = -INFINITY, s1 = -INFINITY, s2 = -INFINITY, s3 = -INFINITY;
        if (pos >= 0 && pos <= t) {
            const float4* kr = (const float4*)(PA + (size_t)(b * SEQ + pos) * NSA_W + KOFF + g * 64);
            float a0 = 0.f, a1 = 0.f, a2 = 0.f, a3 = 0.f;
            for (int d4 = 0; d4 < 16; ++d4) {
                const float4 kv = kr[d4]; const int d = d4 * 4;
                a0 += q[d] * kv.x + q[d + 1] * kv.y + q[d + 2] * kv.z + q[d + 3] * kv.w;
                a1 += q[64 + d] * kv.x + q[64 + d + 1] * kv.y + q[64 + d + 2] * kv.z + q[64 + d + 3] * kv.w;
                a2 += q[128 + d] * kv.x + q[128 + d + 1] * kv.y + q[128 + d + 2] * kv.z + q[128 + d + 3] * kv.w;
                a3 += q[192 + d] * kv.x + q[192 + d + 1] * kv.y + q[192 + d + 2] * kv.z + q[192 + d + 3] * kv.w;
            }
            const int bk = t5_bucket(t - pos);
            s0 = a0 + rel[bk * 8 + 4 * g + 0]; s1 = a1 + rel[bk * 8 + 4 * g + 1]; s2 = a2 + rel[bk * 8 + 4 * g + 2]; s3 = a3 + rel[bk * 8 + 4 * g + 3];
        }
        s[0][m] = s0; s[1][m] = s1; s[2][m] = s2; s[3][m] = s3;
    }
    __syncthreads();
    {
        float mx = -INFINITY;
        for (int m = lane; m < NK; m += 64) mx = fmaxf(mx, s[hw][m]);
        mx = wave_max(mx);
        float sum = 0.f;
        for (int m = lane; m < NK; m += 64) { const float e = expf(s[hw][m] - mx); s[hw][m] = e; sum += e; }
        sum = wave_sum(sum);
        const float inv = 1.f / fmaxf(sum, 1e-30f);
        for (int m = lane; m < NK; m += 64) s[hw][m] *= inv;
    }
    __syncthreads();
    {
        float o = 0.f;
        for (int m = 0; m < NK; ++m) {
            const float pm = s[hw][m];
            if (pm != 0.f) {
                const int pos = (MODE == 0) ? (sel[m >> 6] * 64 + (m & 63)) : (t - 511 + m);
                o += pm * PA[(size_t)(b * SEQ + pos) * NSA_W + VOFF + g * 64 + lane];
            }
        }
        const float gate = sigmoidf_(PA[(size_t)bt * NSA_W + C_NGATE + (4 * g + hw) * 3 + (MODE == 0 ? 1 : 2)]);
        ya[(size_t)bt * 512 + (4 * g + hw) * 64 + lane] += gate * o;
    }
}

__global__ __launch_bounds__(256) void ml_conv_k(const float* __restrict__ PB, const float* __restrict__ cw, const float* __restrict__ cb, float* __restrict__ qkc) {
    const size_t idx = (size_t)blockIdx.x * 256 + threadIdx.x;
    const int row = (int)(idx >> 10), c = (int)(idx & 1023), t = row % SEQ;
    float a = cb[c];
#pragma unroll
    for (int j = 0; j < 4; ++j) { const int tt = t - 3 + j; if (tt >= 0) a += PB[(size_t)(row - 3 + j) * ML_W + c] * cw[j * 1024 + c]; }
    float y = a / (1.f + expf(-a));
    if (c < 512) y *= 0.08838834764831845f;
    qkc[idx] = y;
}

__global__ __launch_bounds__(64) void ml_gates_k(const float* __restrict__ PB, const float* __restrict__ ib, const float* __restrict__ fb, double* __restrict__ uD, double* __restrict__ aD, float* __restrict__ mr) {
    const int bh = blockIdx.x, b = bh >> 2, h = bh & 3, lane = threadIdx.x;
    const int t0 = lane * 128;
    const float fbias = fb[h], ibias = ib[h];
    double loc = 0.0;
    for (int i = 0; i < 128; ++i) {
        const float f = PB[(size_t)(b * SEQ + t0 + i) * ML_W + P_MF + h] + fbias;
        const float lf = fminf(f, 0.f) - log1pf(expf(-fabsf(f)));
        loc += (double)lf;
    }
    double inc = loc;
#pragma unroll
    for (int o = 1; o < 64; o <<= 1) { const double v = __shfl_up(inc, o); if (lane >= o) inc += v; }
    const double base = inc - loc;
    double run = base, lmax = -1e300;
    for (int i = 0; i < 128; ++i) {
        const size_t r = (size_t)(b * SEQ + t0 + i) * ML_W;
        const float f = PB[r + P_MF + h] + fbias;
        const float lf = fminf(f, 0.f) - log1pf(expf(-fabsf(f)));
        run += (double)lf;
        const double u = (double)(PB[r + P_MI + h] + ibias) - run;
        uD[(size_t)bh * SEQ + t0 + i] = u;
        lmax = fmax(lmax, u);
    }
    double pm = lmax;
#pragma unroll
    for (int o = 1; o < 64; o <<= 1) { const double v = __shfl_up(pm, o); if (lane >= o) pm = fmax(pm, v); }
    double prev = __shfl_up(pm, 1); if (lane == 0) prev = 0.0;
    double a = fmax(prev, 0.0);
    run = base;
    for (int i = 0; i < 128; ++i) {
        const size_t r = (size_t)(b * SEQ + t0 + i) * ML_W;
        const float f = PB[r + P_MF + h] + fbias;
        const float lf = fminf(f, 0.f) - log1pf(expf(-fabsf(f)));
        run += (double)lf;
        const double u = uD[(size_t)bh * SEQ + t0 + i];
        a = fmax(a, u);
        aD[(size_t)bh * SEQ + t0 + i] = a;
        mr[(size_t)bh * SEQ + t0 + i] = (float)(run + a);
    }
}

__global__ __launch_bounds__(256) void ml_quad_k(const float* __restrict__ qkc, const float* __restrict__ PB, const double* __restrict__ uD, const double* __restrict__ aD,
                                                 const float* __restrict__ mr, float* __restrict__ yb) {
    __shared__ float Qs[64][65];
    __shared__ float Ks[64][65];
    __shared__ float Ws[64][65];
    __shared__ double us[64], as_[64];
    const int tid = threadIdx.x, tx = tid & 15, ty = tid >> 4;
    const int it = blockIdx.x, h = blockIdx.y, b = blockIdx.z, bh = b * 4 + h;
    const int i0 = it * 64;
    float num[2][4][4];
#pragma unroll
    for (int v = 0; v < 2; ++v)
#pragma unroll
        for (int a = 0; a < 4; ++a)
#pragma unroll
            for (int e = 0; e < 4; ++e) num[v][a][e] = 0.f;
    float den[4] = {0.f, 0.f, 0.f, 0.f};
    if (tid < 64) as_[tid] = aD[(size_t)bh * SEQ + i0 + tid];
    for (int jt = 0; jt <= it; ++jt) {
        const int j0 = jt * 64;
        float S[4][4];
#pragma unroll
        for (int a = 0; a < 4; ++a)
#pragma unroll
            for (int e = 0; e < 4; ++e) S[a][e] = 0.f;
        __syncthreads();
        if (tid < 64) us[tid] = uD[(size_t)bh * SEQ + j0 + tid];
        for (int dh = 0; dh < 2; ++dh) {
            if (dh) __syncthreads();
            for (int k = 0; k < 16; ++k) {
                const int r = (tid >> 6) + 4 * k, dd = tid & 63;
                Qs[r][dd] = qkc[(size_t)(b * SEQ + i0 + r) * 1024 + h * 128 + dh * 64 + dd];
                Ks[r][dd] = qkc[(size_t)(b * SEQ + j0 + r) * 1024 + 512 + h * 128 + dh * 64 + dd];
            }
            __syncthreads();
            for (int dd = 0; dd < 64; ++dd) {
                float qa[4], kb[4];
#pragma unroll
                for (int a = 0; a < 4; ++a) { qa[a] = Qs[ty * 4 + a][dd]; kb[a] = Ks[tx * 4 + a][dd]; }
#pragma unroll
                for (int a = 0; a < 4; ++a)
#pragma unroll
                    for (int e = 0; e < 4; ++e) S[a][e] += qa[a] * kb[e];
            }
        }
#pragma unroll
        for (int a = 0; a < 4; ++a)
#pragma unroll
            for (int e = 0; e < 4; ++e) {
                const int il = ty * 4 + a, jl = tx * 4 + e;
                float w = 0.f;
                if (j0 + jl <= i0 + il) w = S[a][e] * expf((float)(us[jl] - as_[il]));
                Ws[il][jl] = w;
            }
        for (int vh = 0; vh < 2; ++vh) {
            __syncthreads();
            for (int k = 0; k < 16; ++k) {
                const int r = (tid >> 6) + 4 * k, dd = tid & 63;
                Ks[r][dd] = PB[(size_t)(b * SEQ + j0 + r) * ML_W + P_MV + h * 128 + vh * 64 + dd];
            }
            __syncthreads();
            for (int jj = 0; jj < 64; ++jj) {
                float wa[4], vv[4];
#pragma unroll
                for (int a = 0; a < 4; ++a) { wa[a] = Ws[ty * 4 + a][jj]; vv[a] = Ks[jj][tx * 4 + a]; }
                if (vh == 0) {
#pragma unroll
                    for (int a = 0; a < 4; ++a) den[a] += wa[a];
                }
#pragma unroll
                for (int a = 0; a < 4; ++a)
#pragma unroll
                    for (int e = 0; e < 4; ++e) {
                        if (vh == 0) num[0][a][e] += wa[a] * vv[e]; else num[1][a][e] += wa[a] * vv[e];
                    }
            }
        }
    }
#pragma unroll
    for (int a = 0; a < 4; ++a) {
        const int i = i0 + ty * 4 + a;
        const float dn = fmaxf(fabsf(den[a]), expf(-mr[(size_t)bh * SEQ + i]));
#pragma unroll
        for (int v = 0; v < 2; ++v)
#pragma unroll
            for (int e = 0; e < 4; ++e) {
                const int col = h * 128 + v * 64 + tx * 4 + e;
                const float o = PB[(size_t)(b * SEQ + i) * ML_W + P_MO + col];
                yb[(size_t)(b * SEQ + i) * 512 + col] = sigmoidf_(o) * (num[v][a][e] / dn);
            }
    }
}

template <int EPI>
static void gemm(hipStream_t st, const float* A, int lda, const float* gk, const float* B, int ldb, float* C, int ldc, const float* rs, const float* T2, int ldt, int M, int N, int K) {
    dim3 grid((N + 63) / 64, M / 64);
    hipLaunchKernelGGL(gemm_f32<EPI>, grid, dim3(256), 0, st, A, lda, gk, B, ldb, C, ldc, rs, T2, ldt, M, N, K);
}

extern "C" void kernel_launch(void* const* d_in, const int* in_sizes, int n_in, void* d_out, int out_size, void* d_ws, size_t ws_size, hipStream_t stream) {
    const float* x = (const float*)d_in[0];
    const float* norm1_g = (const float*)d_in[1];
    const float* w_in = (const float*)d_in[2];
    const float* q_gain = (const float*)d_in[3];
    const float* k_gain = (const float*)d_in[4];
    const float* ck_pos = (const float*)d_in[5];  const float* ck_w1 = (const float*)d_in[6];  const float* ck_b1 = (const float*)d_in[7];
    const float* ck_w2 = (const float*)d_in[8];   const float* ck_b2 = (const float*)d_in[9];
    const float* cv_pos = (const float*)d_in[10]; const float* cv_w1 = (const float*)d_in[11]; const float* cv_b1 = (const float*)d_in[12];
    const float* cv_w2 = (const float*)d_in[13];  const float* cv_b2 = (const float*)d_in[14];
    const float* rel = (const float*)d_in[15];
    const float* conv_w = (const float*)d_in[16]; const float* conv_b = (const float*)d_in[17];
    const float* i_bias = (const float*)d_in[18]; const float* f_bias = (const float*)d_in[19];
    const float* w_a = (const float*)d_in[20];    const float* w_b = (const float*)d_in[21];
    const float* w_out = (const float*)d_in[22];  const float* norm2_g = (const float*)d_in[23];
    const float* w_ff1 = (const float*)d_in[24];  const float* w_ff2 = (const float*)d_in[25];
    float* out = (float*)d_out;
    char* ws = (char*)d_ws;
    constexpr size_t MiB = 1u << 20;
    float* rstd1 = (float*)(ws + 0);
    float* rstd2 = (float*)(ws + 128 * 1024);
    float* mrow = (float*)(ws + 256 * 1024);
    float* kcmp = (float*)(ws + 1 * MiB);
    float* vcmp = (float*)(ws + 2 * MiB);
    double* uD = (double*)(ws + 3 * MiB);
    double* aD = (double*)(ws + 4 * MiB);
    int* selidx = (int*)(ws + 8 * MiB);
    float* ya = (float*)(ws + 16 * MiB);
    float* yb = (float*)(ws + 80 * MiB);
    float* PA = (float*)(ws + 144 * MiB);
    float* PB = PA;
    float* Mx = (float*)(ws + 144 * MiB);
    float* T2 = (float*)(ws + 272 * MiB);
    float* U = (float*)(ws + 144 * MiB);

    hipLaunchKernelGGL(rowstat_k, dim3(NTOK / 4), dim3(256), 0, stream, x, rstd1, NTOK);
    gemm<0>(stream, x, D_MODEL, norm1_g, w_in + 0, D_PROJ, PA, NSA_W, rstd1, nullptr, 0, NTOK, NSA_W, D_MODEL);
    hipLaunchKernelGGL(nsa_norm_k, dim3(NTOK * 12 / 4), dim3(256), 0, stream, PA, q_gain, k_gain);
    hipLaunchKernelGGL(compress_k, dim3(BATCH * NCMP * 2), dim3(256), 0, stream, (const float*)PA, C_NKC, ck_pos, ck_w1, ck_b1, ck_w2, ck_b2, k_gain, kcmp);
    hipLaunchKernelGGL(compress_k, dim3(BATCH * NCMP * 2), dim3(256), 0, stream, (const float*)PA, C_NVC, cv_pos, cv_w1, cv_b1, cv_w2, cv_b2, (const float*)nullptr, vcmp);
    hipLaunchKernelGGL(nsa_cmp_k, dim3(NTOK * 2), dim3(256), 0, stream, (const float*)PA, (const float*)kcmp, (const float*)vcmp, rel, ya, selidx);
    hipLaunchKernelGGL(nsa_kv_k<0>, dim3(NTOK * 2), dim3(256), 0, stream, (const float*)PA, rel, (const int*)selidx, ya);
    hipLaunchKernelGGL(nsa_kv_k<1>, dim3(NTOK * 2), dim3(256), 0, stream, (const float*)PA, rel, (const int*)selidx, ya);
    gemm<0>(stream, x, D_MODEL, norm1_g, w_in + C_MQ, D_PROJ, PB, ML_W, rstd1, nullptr, 0, NTOK, ML_W, D_MODEL);
    hipLaunchKernelGGL(ml_conv_k, dim3(NTOK * 1024 / 256), dim3(256), 0, stream, (const float*)PB, conv_w, conv_b, out);
    hipLaunchKernelGGL(ml_gates_k, dim3(16), dim3(64), 0, stream, (const float*)PB, i_bias, f_bias, uD, aD, mrow);
    hipLaunchKernelGGL(ml_quad_k, dim3(SEQ / 64, 4, BATCH), dim3(256), 0, stream, (const float*)out, (const float*)PB, (const double*)uD, (const double*)aD, (const float*)mrow, yb);
    gemm<0>(stream, ya, 512, nullptr, w_a, D_MODEL, Mx, D_MODEL, nullptr, nullptr, 0, NTOK, D_MODEL, 512);
    gemm<3>(stream, x, D_MODEL, norm1_g, w_in + C_MG, D_PROJ, Mx, D_MODEL, rstd1, nullptr, 0, NTOK, D_MODEL, D_MODEL);
    gemm<0>(stream, yb, 512, nullptr, w_b, D_MODEL, T2, D_MODEL, nullptr, nullptr, 0, NTOK, D_MODEL, 512);
    gemm<4>(stream, x, D_MODEL, norm1_g, w_in + C_MG + 1024, D_PROJ, Mx, D_MODEL, rstd1, T2, D_MODEL, NTOK, D_MODEL, D_MODEL);
    gemm<1>(stream, Mx, D_MODEL, nullptr, w_out, D_MODEL, out, D_MODEL, nullptr, x, D_MODEL, NTOK, D_MODEL, D_MODEL);
    hipLaunchKernelGGL(rowstat_k, dim3(NTOK / 4), dim3(256), 0, stream, (const float*)out, rstd2, NTOK);
    for (int ch = 0; ch < 4; ++ch) {
        const size_t r0 = (size_t)ch * 8192;
        gemm<2>(stream, out + r0 * D_MODEL, D_MODEL, norm2_g, w_ff1, D_FF, U, D_FF, rstd2 + r0, nullptr, 0, 8192, D_FF, D_MODEL);
        gemm<1>(stream, U, D_FF, nullptr, w_ff2, D_MODEL, out + r0 * D_MODEL, D_MODEL, nullptr, out + r0 * D_MODEL, D_MODEL, 8192, D_MODEL, D_FF);
    }
}
```

```cpp
#include <hip/hip_runtime.h>
#include <cstdint>
#include <cstdio>
namespace pg8 {
#define PG8_LAS __attribute__((address_space(3)))
typedef unsigned short bf16_t;
typedef short bf16x8 __attribute__((ext_vector_type(8)));
typedef float f32x4 __attribute__((ext_vector_type(4)));
typedef unsigned u32x4 __attribute__((ext_vector_type(4)));
constexpr int BM = 256, BK = 64, HALF = 128, HTB = HALF * BK * 2  , STAGE_BYTES = 8 * HTB, NXCD = 8, WGM = 8;

__host__ __device__ __forceinline__ int lds_byte(int r, int c) { const int st = (r >> 4) * 2 + (c >> 5), rr = r & 15, cc = c & 31, ob = rr * 64 + cc * 2; return st * 1024 + (ob ^ (((ob >> 9) & 1) << 5)); }
__host__ __device__ __forceinline__ void stage_rc(int b, int& R, int& C) { const int st = b / 1024, sb = b % 1024, swz = sb ^ (((sb >> 9) & 1) << 5); R = (st >> 1) * 16 + swz / 64; C = (st & 1) * 32 + (swz % 64) / 2; }
__host__ __device__ __forceinline__ int perm32(int rho) { const int n = rho >> 4, i = rho & 15; return 8 * (i >> 2) + 4 * n + (i & 3); }

struct Unit { int pm, pn; };
struct Gemm { const bf16_t* A; const bf16_t* Bt; int M, N, K; };

struct StaticOrder {
    int nM, nN, nwg, G, c;
    __host__ __device__ void init(int M, int N, int G_, int c_) { nM = M / BM; nN = N / BM; nwg = nM * nN; G = G_; c = c_; }
    __host__ __device__ bool next(int i, Unit& u) const {
        const long L = (long)i * G + c; if (L >= nwg) return false;
        int wgid = (int)L; { const int q = nwg / NXCD, r = nwg % NXCD, xcd = wgid % NXCD, off = wgid / NXCD; wgid = (xcd < r ? xcd * (q + 1) : r * (q + 1) + (xcd - r) * q) + off; }
        const int nig = WGM * nN, gid = wgid / nig, fm = gid * WGM, gsz = (nM - fm) < WGM ? (nM - fm) : WGM;
        u.pm = fm + ((wgid % nig) % gsz); u.pn = (wgid % nig) / gsz; return true;
    }
    __device__ __forceinline__ void a_ready(const Unit&) const {}
    __device__ __forceinline__ void done(const Unit&) const {}
};
__device__ __forceinline__ unsigned cvt_pk_bf16(float lo, float hi) { unsigned r; asm volatile("v_cvt_pk_bf16_f32 %0, %1, %2" : "=v"(r) : "v"(lo), "v"(hi)); return r; }
__device__ __forceinline__ float bf_lo(unsigned w) { return __uint_as_float(w << 16); }
__device__ __forceinline__ float bf_hi(unsigned w) { return __uint_as_float(w & 0xffff0000u); }
__device__ __forceinline__ float fsigmoid(float v) { return __builtin_amdgcn_rcpf(1.f + __builtin_amdgcn_exp2f(-1.4426950408889634f * v)); }
__device__ __forceinline__ u32x4 pack8(const f32x4 v0, const f32x4 v1) { u32x4 w; w.x = cvt_pk_bf16(v0[0], v0[1]); w.y = cvt_pk_bf16(v0[2], v0[3]); w.z = cvt_pk_bf16(v1[0], v1[1]); w.w = cvt_pk_bf16(v1[2], v1[3]); return w; }

struct EpiProj {
    static constexpr bool PERM = true, AFTER_DRAIN = false;
    bf16_t *Qn, *KV, *ML, *G; float* S;
    __device__ __forceinline__ void operator()(const f32x4 (&acc)[2][2][4][2], const Unit& u, int wr, int wc, int fr, int fq) const {
        const int pn = u.pn, row0 = u.pm * BM + wr * 64 + fr;
        if (pn == 21) {
            if (wc == 0) {
#pragma unroll
                for (int ai = 0; ai < 2; ++ai)
#pragma unroll
                    for (int m = 0; m < 4; ++m) { float* p = S + (size_t)(row0 + ai * HALF + m * 16) * 32 + 8 * fq; *(f32x4*)p = acc[ai][0][m][0]; *(f32x4*)(p + 4) = acc[ai][0][m][1]; }
            }
            return;
        }
        bf16_t* base; int ld, ct; bool sig = false;
        if (pn < 2) { base = Qn; ld = 512; ct = pn; }
        else if (pn < 5) { base = KV; ld = 768; ct = pn - 2; }
        else if (pn < 13) { base = ML; ld = 2048; ct = pn - 5; }
        else { base = G; ld = 2048; ct = pn - 13; sig = true; }
        const int col0 = ct * 256 + wc * 32 + 8 * fq;
#pragma unroll
        for (int ai = 0; ai < 2; ++ai)
#pragma unroll
            for (int m = 0; m < 4; ++m) { bf16_t* rowp = base + (size_t)(row0 + ai * HALF + m * 16) * ld + col0;
#pragma unroll
                for (int bj = 0; bj < 2; ++bj) { f32x4 v0 = acc[ai][bj][m][0], v1 = acc[ai][bj][m][1];
                    if (sig) {
#pragma unroll
                        for (int i = 0; i < 4; ++i) { v0[i] = fsigmoid(v0[i]); v1[i] = fsigmoid(v1[i]); } }
                    *(u32x4*)(rowp + bj * HALF) = pack8(v0, v1); } }
    }
};
template <bool ACCUM> struct EpiGate {
    static constexpr bool PERM = true, AFTER_DRAIN = false;
    const bf16_t* G; int gcol0; bf16_t* Mx;
    __device__ __forceinline__ void operator()(const f32x4 (&acc)[2][2][4][2], const Unit& u, int wr, int wc, int fr, int fq) const {
        const int row0 = u.pm * BM + wr * 64 + fr, col0 = u.pn * BM + wc * 32 + 8 * fq;
#pragma unroll
        for (int ai = 0; ai < 2; ++ai)
#pragma unroll
            for (int m = 0; m < 4; ++m) { const size_t row = (size_t)(row0 + ai * HALF + m * 16);
#pragma unroll
                for (int bj = 0; bj < 2; ++bj) {
                    const u32x4 g = *(const u32x4*)(G + row * 2048 + gcol0 + col0 + bj * HALF);
                    f32x4 v0 = acc[ai][bj][m][0], v1 = acc[ai][bj][m][1];
                    v0[0] *= bf_lo(g.x); v0[1] *= bf_hi(g.x); v0[2] *= bf_lo(g.y); v0[3] *= bf_hi(g.y);
                    v1[0] *= bf_lo(g.z); v1[1] *= bf_hi(g.z); v1[2] *= bf_lo(g.w); v1[3] *= bf_hi(g.w);
                    bf16_t* mp = Mx + row * 1024 + col0 + bj * HALF;
                    if (ACCUM) { const u32x4 o = *(const u32x4*)mp;
                        v0[0] += bf_lo(o.x); v0[1] += bf_hi(o.x); v0[2] += bf_lo(o.y); v0[3] += bf_hi(o.y);
                        v1[0] += bf_lo(o.z); v1[1] += bf_hi(o.z); v1[2] += bf_lo(o.w); v1[3] += bf_hi(o.w); }
                    *(u32x4*)mp = pack8(v0, v1); } }
    }
};
struct EpiOut {
    static constexpr bool PERM = true, AFTER_DRAIN = false;
    const float* x; float* x1; bf16_t* x1b; float* rowss;
    __device__ __forceinline__ void operator()(const f32x4 (&acc)[2][2][4][2], const Unit& u, int wr, int wc, int fr, int fq) const {
        const int row0 = u.pm * BM + wr * 64 + fr, col0 = u.pn * BM + wc * 32 + 8 * fq;
#pragma unroll
        for (int ai = 0; ai < 2; ++ai)
#pragma unroll
            for (int m = 0; m < 4; ++m) { const size_t row = (size_t)(row0 + ai * HALF + m * 16); float ss = 0.f;
#pragma unroll
                for (int bj = 0; bj < 2; ++bj) { const size_t off = row * 1024 + col0 + bj * HALF;
                    const f32x4 v0 = acc[ai][bj][m][0] + *(const f32x4*)(x + off), v1 = acc[ai][bj][m][1] + *(const f32x4*)(x + off + 4);
                    *(f32x4*)(x1 + off) = v0; *(f32x4*)(x1 + off + 4) = v1; *(u32x4*)(x1b + off) = pack8(v0, v1);
                    ss += (v0[0] * v0[0] + v0[1] * v0[1]) + (v0[2] * v0[2] + v0[3] * v0[3]) + (v1[0] * v1[0] + v1[1] * v1[1]) + (v1[2] * v1[2] + v1[3] * v1[3]); }
                ss += __shfl_xor(ss, 16); ss += __shfl_xor(ss, 32);
                if (fq == 0) atomicAdd(rowss + row, ss); }
    }
};
struct EpiFF1 {
    static constexpr bool PERM = true, AFTER_DRAIN = false;
    const float* rowss; bf16_t* U;
    __device__ __forceinline__ void operator()(const f32x4 (&acc)[2][2][4][2], const Unit& u, int wr, int wc, int fr, int fq) const {
        const int row0 = u.pm * BM + wr * 64 + fr, col0 = u.pn * BM + wc * 32 + 8 * fq;
#pragma unroll
        for (int ai = 0; ai < 2; ++ai)
#pragma unroll
            for (int m = 0; m < 4; ++m) { const size_t row = (size_t)(row0 + ai * HALF + m * 16);
                const float rs = 1.0f / sqrtf(rowss[row] * (1.f / 1024.f) + 1e-6f);
#pragma unroll
                for (int bj = 0; bj < 2; ++bj) { f32x4 v0 = acc[ai][bj][m][0] * rs, v1 = acc[ai][bj][m][1] * rs;
#pragma unroll
                    for (int i = 0; i < 4; ++i) { const float a = fmaxf(v0[i], 0.f), b = fmaxf(v1[i], 0.f); v0[i] = a * a; v1[i] = b * b; }
                    *(u32x4*)(U + row * 4096 + col0 + bj * HALF) = pack8(v0, v1); } }
    }
};
struct EpiFF2 {
    static constexpr bool PERM = true, AFTER_DRAIN = false;
    float* out;
    __device__ __forceinline__ void operator()(const f32x4 (&acc)[2][2][4][2], const Unit& u, int wr, int wc, int fr, int fq) const {
        const int row0 = u.pm * BM + wr * 64 + fr, col0 = u.pn * BM + wc * 32 + 8 * fq;
#pragma unroll
        for (int ai = 0; ai < 2; ++ai)
#pragma unroll
            for (int m = 0; m < 4; ++m) { const size_t row = (size_t)(row0 + ai * HALF + m * 16);
#pragma unroll
                for (int bj = 0; bj < 2; ++bj) { float* p = out + row * 1024 + col0 + bj * HALF;
                    const f32x4 v0 = acc[ai][bj][m][0] + *(const f32x4*)p, v1 = acc[ai][bj][m][1] + *(const f32x4*)(p + 4);
                    *(f32x4*)p = v0; *(f32x4*)(p + 4) = v1; } }
    }
};
template <class Epi, class Sched, bool ALIGN_EPI = false, bool SP2 = false>
__device__ __forceinline__ void gemm_phase(PG8_LAS unsigned char* lds, const Gemm g, const Sched& S, const Epi& E) {
    const int tid = threadIdx.x, wid = __builtin_amdgcn_readfirstlane(tid >> 6), lane = tid & 63, wr = wid >> 2, wc = wid & 3, fr = lane & 15, fq = lane >> 4;
    const int K = g.K, nt = K / BK;
    unsigned voffA[2], voffB[2];
#pragma unroll
    for (int i = 0; i < 2; ++i) { int R, C; stage_rc(tid * 16 + i * 8192, R, C); const int Rb = Epi::PERM ? ((R & ~31) + perm32(R & 31)) : R;
        voffA[i] = (unsigned)(R * K + C) * 2u; voffB[i] = (unsigned)(Rb * K + C) * 2u; }
    const size_t kstep = (size_t)(BK * 2);
    const size_t hstep = (size_t)HALF * K * 2;
    const size_t tstep = 2 * hstep;
    const unsigned ldsw = (unsigned)wid * 1024u;
    const int aoff = lds_byte(wr * 64 + fr, fq * 8), boff = lds_byte(wc * 32 + fr, fq * 8);
#define PG8_SA(b, h) (((b) * 2 + (h)) * HTB)
#define PG8_SB(b, h) ((4 + (b) * 2 + (h)) * HTB)
#define PG8_STAGE(bufoff, gbase, voff) do { _Pragma("unroll") for (int _i = 0; _i < 2; ++_i) \
        __builtin_amdgcn_global_load_lds((const unsigned*)((const char*)(gbase) + (voff)[_i]), (PG8_LAS unsigned*)(lds + (bufoff) + ldsw + _i * 8192), 16, 0, 0); } while (0)
#define PG8_LDA(dst, b, h) do { _Pragma("unroll") for (int m = 0; m < 4; ++m) _Pragma("unroll") for (int k = 0; k < 2; ++k) dst[m][k] = *(const PG8_LAS bf16x8*)(lds + PG8_SA(b, h) + aoff + m * 2048 + k * 1024); } while (0)
#define PG8_LDB(dst, b, h) do { _Pragma("unroll") for (int n = 0; n < 2; ++n) _Pragma("unroll") for (int k = 0; k < 2; ++k) dst[n][k] = *(const PG8_LAS bf16x8*)(lds + PG8_SB(b, h) + boff + n * 2048 + k * 1024); } while (0)
#define PG8_MMA(ai, bj, At, Bt) do { __builtin_amdgcn_s_setprio(1); _Pragma("unroll") for (int m = 0; m < 4; ++m) _Pragma("unroll") for (int n = 0; n < 2; ++n) _Pragma("unroll") for (int k = 0; k < 2; ++k) \
        acc[ai][bj][m][n] = __builtin_amdgcn_mfma_f32_16x16x32_bf16(Bt[n][k], At[m][k], acc[ai][bj][m][n], 0, 0, 0); __builtin_amdgcn_s_setprio(0); } while (0)
#define PG8_WAIT_V(n) asm volatile("s_waitcnt vmcnt(" #n ")" ::: "memory")
#define PG8_WAIT_L(n) asm volatile("s_waitcnt lgkmcnt(" #n ")" ::: "memory")
#define PG8_BAR __builtin_amdgcn_s_barrier()
#define PG8_SCHED __builtin_amdgcn_sched_barrier(0)
    Unit cur, nxt; int ui = 0;
    if (!S.next(0, cur)) return;
    f32x4 acc[2][2][4][2];
#pragma unroll
    for (int a = 0; a < 2; ++a)
#pragma unroll
        for (int b = 0; b < 2; ++b)
#pragma unroll
            for (int m = 0; m < 4; ++m)
#pragma unroll
                for (int n = 0; n < 2; ++n) acc[a][b][m][n] = (f32x4){0.f, 0.f, 0.f, 0.f};
    bf16x8 At[4][2], B0[2][2], B1[2][2];
    const char* cA = (const char*)g.A + (size_t)cur.pm * tstep; const char* cB = (const char*)g.Bt + (size_t)cur.pn * tstep;
    S.a_ready(cur);
    if constexpr (SP2) {
        PG8_STAGE(PG8_SB(0, 0), cB, voffB); PG8_STAGE(PG8_SB(0, 1), cB + hstep, voffB); PG8_STAGE(PG8_SA(0, 0), cA, voffA); PG8_STAGE(PG8_SA(0, 1), cA + hstep, voffA);
        if (wr == 1) PG8_BAR;
        PG8_WAIT_V(2); PG8_BAR;
        PG8_STAGE(PG8_SB(1, 0), cB + kstep, voffB); PG8_STAGE(PG8_SA(1, 0), cA + kstep, voffA); PG8_STAGE(PG8_SB(1, 1), cB + hstep + kstep, voffB);
        PG8_WAIT_V(6); PG8_BAR;
    } else {
        PG8_STAGE(PG8_SB(0, 0), cB, voffB); PG8_STAGE(PG8_SA(0, 0), cA, voffA); PG8_STAGE(PG8_SB(0, 1), cB + hstep, voffB); PG8_STAGE(PG8_SA(0, 1), cA + hstep, voffA);
        if (wr == 1) PG8_BAR;
        PG8_WAIT_V(4); PG8_BAR;
        PG8_STAGE(PG8_SB(1, 0), cB + kstep, voffB); PG8_STAGE(PG8_SA(1, 0), cA + kstep, voffA); PG8_STAGE(PG8_SB(1, 1), cB + hstep + kstep, voffB);
        PG8_WAIT_V(6); PG8_BAR;
    }
    for (;;) {
        const bool has_next = S.next(ui + 1, nxt);
        const char* nA = has_next ? (const char*)g.A + (size_t)nxt.pm * tstep : cA; const char* nB = has_next ? (const char*)g.Bt + (size_t)nxt.pn * tstep : cB;
        for (int t = 0; t < nt; t += 2) {
            const bool last = (t == nt - 2);
            const char* a1 = cA + (size_t)(t + 1) * kstep;
            const char* a2 = last ? nA : cA + (size_t)(t + 2) * kstep; const char* b2 = last ? nB : cB + (size_t)(t + 2) * kstep;
            const char* a3 = a2 + kstep; const char* b3 = b2 + kstep;
            if (last && has_next) S.a_ready(nxt);
            if constexpr (SP2) {
            PG8_LDB(B0, 0, 0); PG8_LDB(B1, 0, 1); PG8_SCHED; PG8_LDA(At, 0, 0); PG8_STAGE(PG8_SA(1, 1), a1 + hstep, voffA);
            PG8_WAIT_V(8); PG8_WAIT_L(0); PG8_BAR; PG8_MMA(0, 0, At, B0); PG8_MMA(0, 1, At, B1); PG8_BAR; PG8_SCHED;
            PG8_LDA(At, 0, 1); PG8_STAGE(PG8_SB(0, 0), b2, voffB); PG8_STAGE(PG8_SB(0, 1), b2 + hstep, voffB); PG8_STAGE(PG8_SA(0, 0), a2, voffA);
            PG8_WAIT_V(8); PG8_WAIT_L(0); PG8_BAR; PG8_MMA(1, 0, At, B0); PG8_MMA(1, 1, At, B1); PG8_BAR; PG8_SCHED;
            PG8_LDB(B0, 1, 0); PG8_LDB(B1, 1, 1); PG8_SCHED; PG8_LDA(At, 1, 0); PG8_STAGE(PG8_SA(0, 1), a2 + hstep, voffA);
            PG8_WAIT_V(8); PG8_WAIT_L(0); PG8_BAR; PG8_MMA(0, 0, At, B0); PG8_MMA(0, 1, At, B1); PG8_BAR; PG8_SCHED;
            PG8_LDA(At, 1, 1); PG8_STAGE(PG8_SB(1, 0), b3, voffB); PG8_STAGE(PG8_SB(1, 1), b3 + hstep, voffB); PG8_STAGE(PG8_SA(1, 0), a3, voffA);
            PG8_WAIT_V(8); PG8_WAIT_L(0); PG8_BAR; PG8_MMA(1, 0, At, B0); PG8_MMA(1, 1, At, B1); PG8_BAR; PG8_SCHED;
            } else {
            PG8_LDB(B0, 0, 0); PG8_SCHED; PG8_LDA(At, 0, 0); PG8_STAGE(PG8_SA(1, 1), a1 + hstep, voffA);
            PG8_WAIT_L(8); PG8_BAR; PG8_WAIT_L(0); PG8_MMA(0, 0, At, B0); PG8_BAR; PG8_SCHED;
            PG8_LDB(B1, 0, 1); PG8_STAGE(PG8_SB(0, 0), b2, voffB);
            PG8_BAR; PG8_WAIT_L(0); PG8_MMA(0, 1, At, B1); PG8_BAR;
            PG8_LDA(At, 0, 1); PG8_STAGE(PG8_SA(0, 0), a2, voffA);
            PG8_BAR; PG8_WAIT_L(0); PG8_MMA(1, 0, At, B0); PG8_BAR; PG8_SCHED;
            PG8_STAGE(PG8_SB(0, 1), b2 + hstep, voffB);
            PG8_WAIT_V(6); PG8_BAR; PG8_MMA(1, 1, At, B1); PG8_BAR;
            PG8_LDB(B0, 1, 0); PG8_SCHED; PG8_LDA(At, 1, 0); PG8_STAGE(PG8_SA(0, 1), a2 + hstep, voffA);
            PG8_WAIT_L(8); PG8_BAR; PG8_WAIT_L(0); PG8_MMA(0, 0, At, B0); PG8_BAR; PG8_SCHED;
            PG8_LDB(B1, 1, 1); PG8_STAGE(PG8_SB(1, 0), b3, voffB);
            PG8_BAR; PG8_WAIT_L(0); PG8_MMA(0, 1, At, B1); PG8_BAR;
            PG8_LDA(At, 1, 1); PG8_STAGE(PG8_SA(1, 0), a3, voffA);
            PG8_BAR; PG8_WAIT_L(0); PG8_MMA(1, 0, At, B0); PG8_BAR; PG8_SCHED;
            PG8_STAGE(PG8_SB(1, 1), b3 + hstep, voffB);
            PG8_WAIT_V(6); PG8_BAR; PG8_MMA(1, 1, At, B1); PG8_BAR;
            }
        }
        if constexpr (ALIGN_EPI) { if (wr == 0) PG8_BAR; }
        if constexpr (!Epi::AFTER_DRAIN) { E(acc, cur, wr, wc, fr, fq); S.done(cur); }
        if (!has_next) break;
#pragma unroll
        for (int a = 0; a < 2; ++a)
#pragma unroll
            for (int b = 0; b < 2; ++b)
#pragma unroll
                for (int m = 0; m < 4; ++m)
#pragma unroll
                    for (int n = 0; n < 2; ++n) acc[a][b][m][n] = (f32x4){0.f, 0.f, 0.f, 0.f};
        cur = nxt; cA = nA; cB = nB; ++ui;
        if constexpr (ALIGN_EPI) { if (wr == 1) PG8_BAR; }
    }
    PG8_WAIT_V(0);
    if constexpr (!ALIGN_EPI) { if (wr == 0) PG8_BAR; }
    PG8_BAR;
    if constexpr (Epi::AFTER_DRAIN) { E.fused(acc, cur, wr, wc, fr, fq, lds, wid, lane); S.done(cur); }
#undef PG8_SA
#undef PG8_SB
#undef PG8_STAGE
#undef PG8_LDA
#undef PG8_LDB
#undef PG8_MMA
#undef PG8_WAIT_V
#undef PG8_WAIT_L
#undef PG8_BAR
#undef PG8_SCHED
}
}
constexpr int D_MODEL = 1024, BATCH = 4, SEQ = 8192, NTOK = BATCH * SEQ;
constexpr int D_PROJ = 5408, D_FF = 4096, NP_PAD = 5632;
constexpr int NWAVES = 8;
constexpr size_t MiB = 1u << 20;
constexpr size_t WS_CTL = 0, CTL_ZERO_BYTES = 1 * MiB;
constexpr size_t CTL_ROWSS = 512 * 1024;
constexpr size_t WS_WIN = 2 * MiB, WS_WA = 13 * MiB, WS_WB = 14 * MiB, WS_WO = 15 * MiB, WS_W1 = 17 * MiB, WS_W2 = 25 * MiB, WS_CK1 = 33 * MiB, WS_CV1 = 34 * MiB;
constexpr size_t WS_XN = 36 * MiB;
constexpr size_t WS_QN = 100 * MiB, WS_KV = 132 * MiB, WS_ML = 180 * MiB, WS_G = 308 * MiB, WS_S = 436 * MiB;
constexpr size_t WS_YA = 440 * MiB, WS_YB = 472 * MiB;
constexpr size_t WS_MX = 180 * MiB;
constexpr size_t WS_U = 180 * MiB;
constexpr size_t WS_END = 504 * MiB;
constexpr int RING_BYTES = 131072, MISC_OFF = RING_BYTES + 320, LDS_BYTES = 147456;

#define GAS __attribute__((address_space(1)))
#define LAS __attribute__((address_space(3)))
typedef unsigned short bf16;
typedef unsigned v4u __attribute__((ext_vector_type(4)));
typedef float f32x4 __attribute__((ext_vector_type(4)));
#define LDS_WAIT() asm volatile("s_waitcnt lgkmcnt(0)" ::: "memory")
#define VM_WAIT() asm volatile("s_waitcnt vmcnt(0)" ::: "memory")
__device__ __forceinline__ unsigned f2bf(float f) { unsigned u = __builtin_bit_cast(unsigned, f); return (u + 0x7fffu + ((u >> 16) & 1u)) >> 16; }
__device__ __forceinline__ unsigned pk2(float lo, float hi) { return f2bf(lo) | (f2bf(hi) << 16); }
__device__ __forceinline__ float wave_sum(float v) {
#pragma unroll
    for (int o = 1; o < 64; o <<= 1) v += __shfl_xor(v, o);
    return v;
}
__device__ __forceinline__ float wave_max(float v) {
#pragma unroll
    for (int o = 1; o < 64; o <<= 1) v = fmaxf(v, __shfl_xor(v, o));
    return v;
}

__device__ __forceinline__ int proj_src_col(int n) {
    if (n < 1280) return n;
    if (n < 3328) { const int q = (n - 1280) >> 9, r = (n - 1280) & 511; return (q == 0 ? 1304 : q == 1 ? 1816 : q == 2 ? 2328 : 2848) + r; }
    if (n < 5376) return 3360 + (n - 3328);
    if (n < 5400) return 1280 + (n - 5376);
    if (n < 5404) return 2840 + (n - 5400);
    if (n < 5408) return 2844 + (n - 5404);
    return -1;
}
template <bool MAP>
__device__ __forceinline__ void transpose_item(const float* W, int K, int ldw, const float* kscale, bf16* WT, int Nout, LAS float* scr, int item, int lane) {
    const int nblk = Nout / 32, kb = item / nblk, nb = item % nblk, k0 = 64 * kb, n0 = 32 * nb;
    const int sc = MAP ? proj_src_col(n0 + (lane & 31)) : (n0 + (lane & 31));
#pragma unroll 8
    for (int i = 0; i < 32; ++i) { const int kk = 2 * i + (lane >> 5); float v = sc >= 0 ? W[(size_t)(k0 + kk) * ldw + sc] : 0.f; if (kscale) v *= kscale[k0 + kk]; scr[kk * 33 + (lane & 31)] = v; }
    LDS_WAIT(); asm volatile("" ::: "memory");
    const int c = lane & 7;
#pragma unroll
    for (int j = 0; j < 4; ++j) { const int n = (lane >> 3) + 8 * j; const LAS float* s = scr + (8 * c) * 33 + n;
        v4u o; o.x = pk2(s[0 * 33], s[1 * 33]); o.y = pk2(s[2 * 33], s[3 * 33]); o.z = pk2(s[4 * 33], s[5 * 33]); o.w = pk2(s[6 * 33], s[7 * 33]);
        *(GAS v4u*)(WT + (size_t)(n0 + n) * K + k0 + 8 * c) = o; }
    LDS_WAIT(); asm volatile("" ::: "memory");
}
__device__ __forceinline__ void rms_row_to_bf16(const float* xrow, bf16* orow, int lane) {
    const GAS f32x4* xr = (const GAS f32x4*)xrow + lane;
    f32x4 v[4]; float s = 0.f;
#pragma unroll
    for (int j = 0; j < 4; ++j) { v[j] = xr[64 * j]; s += (v[j].x * v[j].x + v[j].y * v[j].y) + (v[j].z * v[j].z + v[j].w * v[j].w); }
    const float rstd = 1.f / sqrtf(wave_sum(s) * (1.f / D_MODEL) + 1e-6f);
    GAS unsigned long long* o8 = (GAS unsigned long long*)orow + lane;
#pragma unroll
    for (int j = 0; j < 4; ++j) o8[64 * j] = (unsigned long long)pk2(v[j].x * rstd, v[j].y * rstd) | ((unsigned long long)pk2(v[j].z * rstd, v[j].w * rstd) << 32);
}

struct Args { const float* in[26]; float* out; unsigned char* ws; int ph_lo, ph_hi; };

__global__ void __launch_bounds__(NWAVES * 64, 2) mk_fwd(Args args) {
    extern __shared__ __attribute__((aligned(16))) unsigned char lds_raw[];
    LAS unsigned char* lds = (LAS unsigned char*)lds_raw;
    const int tid = threadIdx.x, lane = tid & 63, wave = __builtin_amdgcn_readfirstlane(tid >> 6);
    const int G = gridDim.x; const int bx = blockIdx.x;
    const int vcu = (G % 8 == 0) ? (bx % 8) * (G / 8) + bx / 8 : bx;
    unsigned char* ws = args.ws;
    const float* x = args.in[0];
    bf16* WinT = (bf16*)(ws + WS_WIN); bf16* WaT = (bf16*)(ws + WS_WA); bf16* WbT = (bf16*)(ws + WS_WB); bf16* WoT = (bf16*)(ws + WS_WO);
    bf16* W1T = (bf16*)(ws + WS_W1); bf16* W2T = (bf16*)(ws + WS_W2);
    bf16* XN = (bf16*)(ws + WS_XN); bf16* QN = (bf16*)(ws + WS_QN); bf16* KV = (bf16*)(ws + WS_KV); bf16* ML = (bf16*)(ws + WS_ML); bf16* GB = (bf16*)(ws + WS_G);
    float* SB = (float*)(ws + WS_S); bf16* YA = (bf16*)(ws + WS_YA); bf16* YB = (bf16*)(ws + WS_YB); bf16* MX = (bf16*)(ws + WS_MX); bf16* UB = (bf16*)(ws + WS_U);
    float* rowss = (float*)(ws + WS_CTL + CTL_ROWSS);
    const int lo = args.ph_lo, hi = args.ph_hi;
#define IN(k) (lo <= (k) && (k) < hi)

    if (IN(0)) {
        LAS float* scr = (LAS float*)(lds + wave * 16384);
        const int gw = vcu * NWAVES + wave, NGW = G * NWAVES;
        constexpr int I_IN = (1024 / 64) * (NP_PAD / 32), I_A = (512 / 64) * (1024 / 32), I_O = (1024 / 64) * (1024 / 32), I_1 = (1024 / 64) * (4096 / 32), I_2 = (4096 / 64) * (1024 / 32);
        constexpr int NITEMS = I_IN + 2 * I_A + I_O + I_1 + I_2;
        for (int it = gw; it < NITEMS; it += NGW) {
            int r = it;
            if (r < I_IN) { transpose_item<true>(args.in[2], 1024, D_PROJ, args.in[1], WinT, NP_PAD, scr, r, lane); continue; } r -= I_IN;
            if (r < I_A) { transpose_item<false>(args.in[20], 512, 1024, nullptr, WaT, 1024, scr, r, lane); continue; } r -= I_A;
            if (r < I_A) { transpose_item<false>(args.in[21], 512, 1024, nullptr, WbT, 1024, scr, r, lane); continue; } r -= I_A;
            if (r < I_O) { transpose_item<false>(args.in[22], 1024, 1024, nullptr, WoT, 1024, scr, r, lane); continue; } r -= I_O;
            if (r < I_1) { transpose_item<false>(args.in[24], 1024, 4096, args.in[23], W1T, 4096, scr, r, lane); continue; } r -= I_1;
            transpose_item<false>(args.in[25], 4096, 1024, nullptr, W2T, 1024, scr, r, lane);
        }
        for (int m = gw; m < NTOK; m += NGW) rms_row_to_bf16(x + (size_t)m * D_MODEL, XN + (size_t)m * D_MODEL, lane);
    }
    if (IN(1)) {
        pg8::Gemm g{XN, WinT, NTOK, NP_PAD, 1024}; pg8::StaticOrder S; S.init(NTOK, NP_PAD, G, bx);
        pg8::EpiProj E{QN, KV, ML, GB, SB};
        pg8::gemm_phase<pg8::EpiProj, pg8::StaticOrder, true, true>(lds, g, S, E);
    }
    if (IN(4)) {
        pg8::Gemm g{YA, WaT, NTOK, 1024, 512}; pg8::StaticOrder S; S.init(NTOK, 1024, G, bx);
        pg8::EpiGate<false> E{GB, 0, MX};
        pg8::gemm_phase<pg8::EpiGate<false>, pg8::StaticOrder, true, true>(lds, g, S, E);
    }
    if (IN(5)) {
        pg8::Gemm g{YB, WbT, NTOK, 1024, 512}; pg8::StaticOrder S; S.init(NTOK, 1024, G, bx);
        pg8::EpiGate<true> E{GB, 1024, MX};
        pg8::gemm_phase<pg8::EpiGate<true>, pg8::StaticOrder, true, true>(lds, g, S, E);
    }
    if (IN(6)) {
        pg8::Gemm g{MX, WoT, NTOK, 1024, 1024}; pg8::StaticOrder S; S.init(NTOK, 1024, G, bx);
        pg8::EpiOut E{x, args.out, XN, rowss};
        pg8::gemm_phase<pg8::EpiOut, pg8::StaticOrder, true, true>(lds, g, S, E);
    }
    if (IN(7)) {
        pg8::Gemm g{XN, W1T, NTOK, 4096, 1024}; pg8::StaticOrder S; S.init(NTOK, 4096, G, bx);
        pg8::EpiFF1 E{rowss, UB};
        pg8::gemm_phase<pg8::EpiFF1, pg8::StaticOrder, true, true>(lds, g, S, E);
    }
    if (IN(8)) {
        pg8::Gemm g{UB, W2T, NTOK, 1024, 4096}; pg8::StaticOrder S; S.init(NTOK, 1024, G, bx);
        pg8::EpiFF2 E{args.out};
        pg8::gemm_phase<pg8::EpiFF2, pg8::StaticOrder, true, true>(lds, g, S, E);
    }
#undef IN
}
constexpr int C_NQ = 0, C_NKC = 512, C_NVC = 640, C_NKS = 768, C_NVS = 896, C_NKW = 1024, C_NVW = 1152, C_NGATE = 1280;
constexpr int C_MQ = 1304, C_MG = 3360;
constexpr int NSA_W = 1304;
constexpr int ML_W = 2056;
constexpr int P_MQ = 0, P_MK = 512, P_MV = 1024, P_MI = 1536, P_MF = 1540, P_MO = 1544;
constexpr int NCMP = 511, NSLC = 128;

__device__ const unsigned char BUCKET_TAB[129] = {0, 1, 2, 3, 4, 5, 6, 7, 8, 9, 10, 11, 12, 13, 14, 15, 16, 16, 16, 17, 17, 18, 18, 18, 19, 19, 19, 20, 20, 20, 20, 21, 21, 21, 21, 22, 22, 22, 22, 22, 23, 23, 23, 23, 23, 23, 24, 24, 24, 24, 24, 24, 25, 25, 25, 25, 25, 25, 25, 26, 26, 26, 26, 26, 26, 26, 26, 27, 27, 27, 27, 27, 27, 27, 27, 27, 27, 28, 28, 28, 28, 28, 28, 28, 28, 28, 28, 29, 29, 29, 29, 29, 29, 29, 29, 29, 29, 29, 29, 30, 30, 30, 30, 30, 30, 30, 30, 30, 30, 30, 30, 30, 30, 31, 31, 31, 31, 31, 31, 31, 31, 31, 31, 31, 31, 31, 31, 31, 31};
__device__ __forceinline__ int t5_bucket(int dist) { return dist >= 128 ? 31 : (int)BUCKET_TAB[dist < 0 ? 0 : dist]; }

__device__ __forceinline__ float sigmoidf_(float x) { return 1.f / (1.f + expf(-x)); }

__global__ __launch_bounds__(256) void rowstat_k(const float* __restrict__ x, float* __restrict__ rstd, int rows) {
    const int w = (blockIdx.x * 256 + threadIdx.x) >> 6, lane = threadIdx.x & 63;
    if (w >= rows) return;
    const float4* p = (const float4*)(x + (size_t)w * D_MODEL);
    float s = 0.f;
#pragma unroll
    for (int j = 0; j < 4; ++j) { const float4 v = p[lane + 64 * j]; s += v.x * v.x + v.y * v.y + v.z * v.z + v.w * v.w; }
    s = wave_sum(s);
    if (lane == 0) rstd[w] = 1.f / sqrtf(s * (1.f / D_MODEL) + 1e-6f);
}

template <int EPI>
__global__ __launch_bounds__(256) void gemm_f32(const float* __restrict__ A, int lda, const float* __restrict__ gk, const float* __restrict__ Bm, int ldb,
                                                float* C, int ldc, const float* __restrict__ rs, const float* T2, int ldt, int M, int N, int K) {
    __shared__ __attribute__((aligned(16))) float As[16][68];
    __shared__ __attribute__((aligned(16))) float Bs[16][68];
    const int tid = threadIdx.x, tx = tid & 15, ty = tid >> 4;
    const int m0 = blockIdx.y * 64, n0 = blockIdx.x * 64;
    float acc[4][4];
#pragma unroll
    for (int i = 0; i < 4; ++i)
#pragma unroll
        for (int j = 0; j < 4; ++j) acc[i][j] = 0.f;
    for (int k0 = 0; k0 < K; k0 += 16) {
        {
            const int r = tid >> 2, kq = (tid & 3) * 4;
            float4 v = *(const float4*)(A + (size_t)(m0 + r) * lda + k0 + kq);
            if (gk) { const float4 g = *(const float4*)(gk + k0 + kq); v.x *= g.x; v.y *= g.y; v.z *= g.z; v.w *= g.w; }
            As[kq + 0][r] = v.x; As[kq + 1][r] = v.y; As[kq + 2][r] = v.z; As[kq + 3][r] = v.w;
        }
        {
            const int kr = tid >> 4, nq = (tid & 15) * 4;
            float4 v = make_float4(0.f, 0.f, 0.f, 0.f);
            if (n0 + nq < N) v = *(const float4*)(Bm + (size_t)(k0 + kr) * ldb + n0 + nq);
            *(float4*)&Bs[kr][nq] = v;
        }
        __syncthreads();
#pragma unroll
        for (int k = 0; k < 16; ++k) {
            const float4 a = *(const float4*)&As[k][ty * 4];
            const float4 b = *(const float4*)&Bs[k][tx * 4];
            acc[0][0] += a.x * b.x; acc[0][1] += a.x * b.y; acc[0][2] += a.x * b.z; acc[0][3] += a.x * b.w;
            acc[1][0] += a.y * b.x; acc[1][1] += a.y * b.y; acc[1][2] += a.y * b.z; acc[1][3] += a.y * b.w;
            acc[2][0] += a.z * b.x; acc[2][1] += a.z * b.y; acc[2][2] += a.z * b.z; acc[2][3] += a.z * b.w;
            acc[3][0] += a.w * b.x; acc[3][1] += a.w * b.y; acc[3][2] += a.w * b.z; acc[3][3] += a.w * b.w;
        }
        __syncthreads();
    }
#pragma unroll
    for (int i = 0; i < 4; ++i) {
        const int m = m0 + ty * 4 + i;
        const float sc = rs ? rs[m] : 1.f;
#pragma unroll
        for (int j = 0; j < 4; ++j) {
            const int n = n0 + tx * 4 + j;
            if (n < N) {
                const float v = acc[i][j] * sc;
                float* cp = C + (size_t)m * ldc + n;
                if (EPI == 0) *cp = v;
                else if (EPI == 1) *cp = T2[(size_t)m * ldt + n] + v;
                else if (EPI == 2) { const float r = fmaxf(v, 0.f); *cp = r * r; }
                else if (EPI == 3) *cp = sigmoidf_(v) * (*cp);
                else *cp = *cp + sigmoidf_(v) * T2[(size_t)m * ldt + n];
            }
        }
    }
}

__global__ __launch_bounds__(256) void nsa_norm_k(float* PA, const float* __restrict__ qg, const float* __restrict__ kg) {
    const int w = (blockIdx.x * 256 + threadIdx.x) >> 6, lane = threadIdx.x & 63;
    const int row = w / 12, v = w % 12;
    if (row >= NTOK) return;
    int col; const float* gain; float sc = 1.f;
    if (v < 8) { col = C_NQ + v * 64; gain = qg; sc = 0.125f; }
    else if (v < 10) { col = C_NKS + (v - 8) * 64; gain = kg + 64; }
    else { col = C_NKW + (v - 10) * 64; gain = kg + 128; }
    float* p = PA + (size_t)row * NSA_W + col + lane;
    const float x = *p;
    const float ss = wave_sum(x * x);
    *p = x * (1.f / sqrtf(ss * (1.f / 64.f) + 1e-6f)) * gain[lane] * sc;
}

__global__ __launch_bounds__(256) void compress_k(const float* __restrict__ PA, int coloff, const float* __restrict__ pos, const float* __restrict__ w1, const float* __restrict__ b1,
                                                  const float* __restrict__ w2, const float* __restrict__ b2, const float* __restrict__ gain, float* __restrict__ out) {
    __shared__ float in[2048];
    __shared__ float hid[256];
    const int tid = threadIdx.x, blk = blockIdx.x;
    const int g = blk & 1, n = (blk >> 1) % NCMP, b = (blk >> 1) / NCMP;
    for (int i = tid; i < 2048; i += 256) { const int j = i >> 6, d = i & 63; in[i] = PA[(size_t)(b * SEQ + 16 * n + j) * NSA_W + coloff + g * 64 + d] + pos[i]; }
    __syncthreads();
    float a = b1[tid];
    for (int i = 0; i < 2048; ++i) a += in[i] * w1[(size_t)i * 256 + tid];
    { const float x = a; const float u = 0.7978845608028654f * (x + 0.044715f * x * x * x); hid[tid] = 0.5f * x * (1.f + tanhf(u)); }
    __syncthreads();
    if (tid < 64) {
        float o = b2[tid];
        for (int u = 0; u < 256; ++u) o += hid[u] * w2[u * 64 + tid];
        if (gain) { const float ss = wave_sum(o * o); o = o * (1.f / sqrtf(ss * (1.f / 64.f) + 1e-6f)) * gain[tid]; }
        out[((size_t)(b * NCMP + n) * 2 + g) * 64 + tid] = o;
    }
}

__global__ __launch_bounds__(256) void nsa_cmp_k(const float* __restrict__ PA, const float* __restrict__ kcmp, const float* __restrict__ vcmp, const float* __restrict__ rel,
                                                 float* __restrict__ ya, int* __restrict__ selidx) {
    __shared__ float q[256];
    __shared__ float p[4][512];
    __shared__ float Psum[512];
    __shared__ float sc[128];
    const int tid = threadIdx.x, lane = tid & 63, hw = tid >> 6;
    const int bt = blockIdx.x >> 1, g = blockIdx.x & 1, b = bt / SEQ, t = bt % SEQ, c = t >> 6;
    q[tid] = PA[(size_t)bt * NSA_W + C_NQ + g * 256 + tid];
    __syncthreads();
    const int nvalid = (t >= 31) ? ((t - 31) / 16 + 1) : 0;
    for (int n = tid; n < 512; n += 256) {
        float s0 = -INFINITY, s1 = -INFINITY, s2 = -INFINITY, s3 = -INFINITY;
        if (n < nvalid) {
            const float* kr = kcmp + ((size_t)(b * NCMP + n) * 2 + g) * 64;
            float a0 = 0.f, a1 = 0.f, a2 = 0.f, a3 = 0.f;
            for (int d = 0; d < 64; ++d) { const float kv = kr[d]; a0 += q[d] * kv; a1 += q[64 + d] * kv; a2 += q[128 + d] * kv; a3 += q[192 + d] * kv; }
            const int bk = t5_bucket(t - (16 * n + 31));
            s0 = a0 + rel[bk * 8 + 4 * g + 0]; s1 = a1 + rel[bk * 8 + 4 * g + 1]; s2 = a2 + rel[bk * 8 + 4 * g + 2]; s3 = a3 + rel[bk * 8 + 4 * g + 3];
        }
        p[0][n] = s0; p[1][n] = s1; p[2][n] = s2; p[3][n] = s3;
    }
    __syncthreads();
    {
        float m = -INFINITY;
        for (int n = lane; n < nvalid; n += 64) m = fmaxf(m, p[hw][n]);
        m = wave_max(m);
        if (nvalid == 0) m = 0.f;
        float sum = 0.f;
        for (int n = lane; n < 512; n += 64) { const float e = (n < nvalid) ? expf(p[hw][n] - m) : 0.f; p[hw][n] = e; sum += e; }
        sum = wave_sum(sum);
        const float inv = 1.f / fmaxf(sum, 1e-30f);
        for (int n = lane; n < 512; n += 64) p[hw][n] *= inv;
    }
    __syncthreads();
    {
        float o = 0.f;
        for (int n = 0; n < nvalid; ++n) o += p[hw][n] * vcmp[((size_t)(b * NCMP + n) * 2 + g) * 64 + lane];
        const float gate = sigmoidf_(PA[(size_t)bt * NSA_W + C_NGATE + (4 * g + hw) * 3 + 0]);
        ya[(size_t)bt * 512 + (4 * g + hw) * 64 + lane] = gate * o;
    }
    for (int n = tid; n < 512; n += 256) Psum[n] = (n < NCMP) ? ((p[0][n] + p[1][n]) + (p[2][n] + p[3][n])) : 0.f;
    __syncthreads();
    if (tid < 128) {
        const int j = tid;
        float im = 0.f;
        for (int n = 4 * j - 1; n <= 4 * j + 3; ++n) if (n >= 0 && n < NCMP) im += Psum[n];
        float s;
        if (j == 0 || j == c || j == c - 1) s = 1e4f; else if (j <= c) s = im; else s = -1.f;
        sc[j] = s;
    }
    __syncthreads();
    if (tid < 128) {
        const int j = tid; const float s = sc[j]; int rank = 0;
        for (int i = 0; i < 128; ++i) { const float si = sc[i]; rank += ((si > s) || (si == s && i < j)) ? 1 : 0; }
        if (rank < 16) selidx[((size_t)bt * 2 + g) * 16 + rank] = j;
    }
}

template <int MODE>
__global__ __launch_bounds__(256) void nsa_kv_k(const float* __restrict__ PA, const float* __restrict__ rel, const int* __restrict__ selidx, float* __restrict__ ya) {
    constexpr int NK = MODE == 0 ? 1024 : 512;
    constexpr int KOFF = MODE == 0 ? C_NKS : C_NKW, VOFF = MODE == 0 ? C_NVS : C_NVW;
    __shared__ float q[256];
    __shared__ float s[4][NK];
    __shared__ int sel[16];
    const int tid = threadIdx.x, lane = tid & 63, hw = tid >> 6;
    const int bt = blockIdx.x >> 1, g = blockIdx.x & 1, b = bt / SEQ, t = bt % SEQ;
    q[tid] = PA[(size_t)bt * NSA_W + C_NQ + g * 256 + tid];
    if (MODE == 0 && tid < 16) sel[tid] = selidx[((size_t)bt * 2 + g) * 16 + tid];
    __syncthreads();
    for (int m = tid; m < NK; m += 256) {
        const int pos = (MODE == 0) ? (sel[m >> 6] * 64 + (m & 63)) : (t - 511 + m);
        float s0 = -INFINITY, s1 = -INFINITY, s2 = -INFINITY, s3 = -INFINITY;
        if (pos >= 0 && pos <= t) {
            const float4* kr = (const float4*)(PA + (size_t)(b * SEQ + pos) * NSA_W + KOFF + g * 64);
            float a0 = 0.f, a1 = 0.f, a2 = 0.f, a3 = 0.f;
            for (int d4 = 0; d4 < 16; ++d4) {
                const float4 kv = kr[d4]; const int d = d4 * 4;
                a0 += q[d] * kv.x + q[d + 1] * kv.y + q[d + 2] * kv.z + q[d + 3] * kv.w;
                a1 += q[64 + d] * kv.x + q[64 + d + 1] * kv.y + q[64 + d + 2] * kv.z + q[64 + d + 3] * kv.w;
                a2 += q[128 + d] * kv.x + q[128 + d + 1] * kv.y + q[128 + d + 2] * kv.z + q[128 + d + 3] * kv.w;
                a3 += q[192 + d] * kv.x + q[192 + d + 1] * kv.y + q[192 + d + 2] * kv.z + q[192 + d + 3] * kv.w;
            }
            const int bk = t5_bucket(t - pos);
            s0 = a0 + rel[bk * 8 + 4 * g + 0]; s1 = a1 + rel[bk * 8 + 4 * g + 1]; s2 = a2 + rel[bk * 8 + 4 * g + 2]; s3 = a3 + rel[bk * 8 + 4 * g + 3];
        }
        s[0][m] = s0; s[1][m] = s1; s[2][m] = s2; s[3][m] = s3;
    }
    __syncthreads();
    {
        float mx = -INFINITY;
        for (int m = lane; m < NK; m += 64) mx = fmaxf(mx, s[hw][m]);
        mx = wave_max(mx);
        float sum = 0.f;
        for (int m = lane; m < NK; m += 64) { const float e = expf(s[hw][m] - mx); s[hw][m] = e; sum += e; }
        sum = wave_sum(sum);
        const float inv = 1.f / fmaxf(sum, 1e-30f);
        for (int m = lane; m < NK; m += 64) s[hw][m] *= inv;
    }
    __syncthreads();
    {
        float o = 0.f;
        for (int m = 0; m < NK; ++m) {
            const float pm = s[hw][m];
            if (pm != 0.f) {
                const int pos = (MODE == 0) ? (sel[m >> 6] * 64 + (m & 63)) : (t - 511 + m);
                o += pm * PA[(size_t)(b * SEQ + pos) * NSA_W + VOFF + g * 64 + lane];
            }
        }
        const float gate = sigmoidf_(PA[(size_t)bt * NSA_W + C_NGATE + (4 * g + hw) * 3 + (MODE == 0 ? 1 : 2)]);
        ya[(size_t)bt * 512 + (4 * g + hw) * 64 + lane] += gate * o;
    }
}

__global__ __launch_bounds__(256) void ml_conv_k(const float* __restrict__ PB, const float* __restrict__ cw, const float* __restrict__ cb, float* __restrict__ qkc) {
    const size_t idx = (size_t)blockIdx.x * 256 + threadIdx.x;
    const int row = (int)(idx >> 10), c = (int)(idx & 1023), t = row % SEQ;
    float a = cb[c];
#pragma unroll
    for (int j = 0; j < 4; ++j) { const int tt = t - 3 + j; if (tt >= 0) a += PB[(size_t)(row - 3 + j) * ML_W + c] * cw[j * 1024 + c]; }
    float y = a / (1.f + expf(-a));
    if (c < 512) y *= 0.08838834764831845f;
    qkc[idx] = y;
}

__global__ __launch_bounds__(64) void ml_gates_k(const float* __restrict__ PB, const float* __restrict__ ib, const float* __restrict__ fb, double* __restrict__ uD, double* __restrict__ aD, float* __restrict__ mr) {
    const int bh = blockIdx.x, b = bh >> 2, h = bh & 3, lane = threadIdx.x;
    const int t0 = lane * 128;
    const float fbias = fb[h], ibias = ib[h];
    double loc = 0.0;
    for (int i = 0; i < 128; ++i) {
        const float f = PB[(size_t)(b * SEQ + t0 + i) * ML_W + P_MF + h] + fbias;
        const float lf = fminf(f, 0.f) - log1pf(expf(-fabsf(f)));
        loc += (double)lf;
    }
    double inc = loc;
#pragma unroll
    for (int o = 1; o < 64; o <<= 1) { const double v = __shfl_up(inc, o); if (lane >= o) inc += v; }
    const double base = inc - loc;
    double run = base, lmax = -1e300;
    for (int i = 0; i < 128; ++i) {
        const size_t r = (size_t)(b * SEQ + t0 + i) * ML_W;
        const float f = PB[r + P_MF + h] + fbias;
        const float lf = fminf(f, 0.f) - log1pf(expf(-fabsf(f)));
        run += (double)lf;
        const double u = (double)(PB[r + P_MI + h] + ibias) - run;
        uD[(size_t)bh * SEQ + t0 + i] = u;
        lmax = fmax(lmax, u);
    }
    double pm = lmax;
#pragma unroll
    for (int o = 1; o < 64; o <<= 1) { const double v = __shfl_up(pm, o); if (lane >= o) pm = fmax(pm, v); }
    double prev = __shfl_up(pm, 1); if (lane == 0) prev = 0.0;
    double a = fmax(prev, 0.0);
    run = base;
    for (int i = 0; i < 128; ++i) {
        const size_t r = (size_t)(b * SEQ + t0 + i) * ML_W;
        const float f = PB[r + P_MF + h] + fbias;
        const float lf = fminf(f, 0.f) - log1pf(expf(-fabsf(f)));
        run += (double)lf;
        const double u = uD[(size_t)bh * SEQ + t0 + i];
        a = fmax(a, u);
        aD[(size_t)bh * SEQ + t0 + i] = a;
        mr[(size_t)bh * SEQ + t0 + i] = (float)(run + a);
    }
}

__global__ __launch_bounds__(256) void ml_quad_k(const float* __restrict__ qkc, const float* __restrict__ PB, const double* __restrict__ uD, const double* __restrict__ aD,
                                                 const float* __restrict__ mr, float* __restrict__ yb) {
    __shared__ float Qs[64][65];
    __shared__ float Ks[64][65];
    __shared__ float Ws[64][65];
    __shared__ double us[64], as_[64];
    const int tid = threadIdx.x, tx = tid & 15, ty = tid >> 4;
    const int it = blockIdx.x, h = blockIdx.y, b = blockIdx.z, bh = b * 4 + h;
    const int i0 = it * 64;
    float num[2][4][4];
#pragma unroll
    for (int v = 0; v < 2; ++v)
#pragma unroll
        for (int a = 0; a < 4; ++a)
#pragma unroll
            for (int e = 0; e < 4; ++e) num[v][a][e] = 0.f;
    float den[4] = {0.f, 0.f, 0.f, 0.f};
    if (tid < 64) as_[tid] = aD[(size_t)bh * SEQ + i0 + tid];
    for (int jt = 0; jt <= it; ++jt) {
        const int j0 = jt * 64;
        float S[4][4];
#pragma unroll
        for (int a = 0; a < 4; ++a)
#pragma unroll
            for (int e = 0; e < 4; ++e) S[a][e] = 0.f;
        __syncthreads();
        if (tid < 64) us[tid] = uD[(size_t)bh * SEQ + j0 + tid];
        for (int dh = 0; dh < 2; ++dh) {
            if (dh) __syncthreads();
            for (int k = 0; k < 16; ++k) {
                const int r = (tid >> 6) + 4 * k, dd = tid & 63;
                Qs[r][dd] = qkc[(size_t)(b * SEQ + i0 + r) * 1024 + h * 128 + dh * 64 + dd];
                Ks[r][dd] = qkc[(size_t)(b * SEQ + j0 + r) * 1024 + 512 + h * 128 + dh * 64 + dd];
            }
            __syncthreads();
            for (int dd = 0; dd < 64; ++dd) {
                float qa[4], kb[4];
#pragma unroll
                for (int a = 0; a < 4; ++a) { qa[a] = Qs[ty * 4 + a][dd]; kb[a] = Ks[tx * 4 + a][dd]; }
#pragma unroll
                for (int a = 0; a < 4; ++a)
#pragma unroll
                    for (int e = 0; e < 4; ++e) S[a][e] += qa[a] * kb[e];
            }
        }
#pragma unroll
        for (int a = 0; a < 4; ++a)
#pragma unroll
            for (int e = 0; e < 4; ++e) {
                const int il = ty * 4 + a, jl = tx * 4 + e;
                float w = 0.f;
                if (j0 + jl <= i0 + il) w = S[a][e] * expf((float)(us[jl] - as_[il]));
                Ws[il][jl] = w;
            }
        for (int vh = 0; vh < 2; ++vh) {
            __syncthreads();
            for (int k = 0; k < 16; ++k) {
                const int r = (tid >> 6) + 4 * k, dd = tid & 63;
                Ks[r][dd] = PB[(size_t)(b * SEQ + j0 + r) * ML_W + P_MV + h * 128 + vh * 64 + dd];
            }
            __syncthreads();
            for (int jj = 0; jj < 64; ++jj) {
                float wa[4], vv[4];
#pragma unroll
                for (int a = 0; a < 4; ++a) { wa[a] = Ws[ty * 4 + a][jj]; vv[a] = Ks[jj][tx * 4 + a]; }
                if (vh == 0) {
#pragma unroll
                    for (int a = 0; a < 4; ++a) den[a] += wa[a];
                }
#pragma unroll
                for (int a = 0; a < 4; ++a)
#pragma unroll
                    for (int e = 0; e < 4; ++e) {
                        if (vh == 0) num[0][a][e] += wa[a] * vv[e]; else num[1][a][e] += wa[a] * vv[e];
                    }
            }
        }
    }
#pragma unroll
    for (int a = 0; a < 4; ++a) {
        const int i = i0 + ty * 4 + a;
        const float dn = fmaxf(fabsf(den[a]), expf(-mr[(size_t)bh * SEQ + i]));
#pragma unroll
        for (int v = 0; v < 2; ++v)
#pragma unroll
            for (int e = 0; e < 4; ++e) {
                const int col = h * 128 + v * 64 + tx * 4 + e;
                const float o = PB[(size_t)(b * SEQ + i) * ML_W + P_MO + col];
                yb[(size_t)(b * SEQ + i) * 512 + col] = sigmoidf_(o) * (num[v][a][e] / dn);
            }
    }
}

__device__ __forceinline__ float bf2f(bf16 v) { return __uint_as_float((unsigned)v << 16); }
__global__ __launch_bounds__(256) void unpack_nsa_k(const bf16* __restrict__ QN, const bf16* __restrict__ KV, const float* __restrict__ SB, float* __restrict__ PA, int row0) {
    const size_t idx = (size_t)blockIdx.x * 256 + threadIdx.x;
    if (idx >= (size_t)SEQ * NSA_W) return;
    const int t = (int)(idx / NSA_W), c = (int)(idx % NSA_W); const size_t row = (size_t)row0 + t;
    float v;
    if (c < 512) v = bf2f(QN[row * 512 + c]); else if (c < 1280) v = bf2f(KV[row * 768 + (c - 512)]); else v = SB[row * 32 + (c - 1280)];
    PA[idx] = v;
}
__global__ __launch_bounds__(256) void unpack_ml_k(const bf16* __restrict__ ML, const float* __restrict__ SB, float* __restrict__ PB, int row0) {
    const size_t idx = (size_t)blockIdx.x * 256 + threadIdx.x;
    if (idx >= (size_t)SEQ * ML_W) return;
    const int t = (int)(idx / ML_W), c = (int)(idx % ML_W); const size_t row = (size_t)row0 + t;
    float v;
    if (c < 1536) v = bf2f(ML[row * 2048 + c]); else if (c < 1540) v = SB[row * 32 + 24 + (c - 1536)]; else if (c < 1544) v = SB[row * 32 + 28 + (c - 1540)]; else v = bf2f(ML[row * 2048 + 1536 + (c - 1544)]);
    PB[idx] = v;
}
__global__ __launch_bounds__(256) void pack_y_k(const float* __restrict__ y32, bf16* __restrict__ yb, int row0) {
    const size_t idx = (size_t)blockIdx.x * 256 + threadIdx.x;
    yb[(size_t)row0 * 512 + idx] = (bf16)f2bf(y32[idx]);
}

static void launch_phase(hipStream_t st, Args a, int lo, int hi, int grid) {
    a.ph_lo = lo; a.ph_hi = hi;
    hipLaunchKernelGGL(mk_fwd, dim3(grid), dim3(NWAVES * 64), LDS_BYTES, st, a);
}

extern "C" void kernel_launch(void* const* d_in, const int* in_sizes, int n_in, void* d_out, int out_size, void* d_ws, size_t ws_size, hipStream_t stream) {
    static int grid = 0;
    if (grid == 0) {
        int dev = 0, cus = 0;
        if (hipGetDevice(&dev) != hipSuccess || hipDeviceGetAttribute(&cus, hipDeviceAttributeMultiprocessorCount, dev) != hipSuccess) { grid = -1; return; }
        if (hipFuncSetAttribute((const void*)mk_fwd, hipFuncAttributeMaxDynamicSharedMemorySize, LDS_BYTES) != hipSuccess) { fprintf(stderr, "hipFuncSetAttribute failed\n"); grid = -1; return; }
        if (ws_size < WS_END) { fprintf(stderr, "workspace too small: %zu < %zu\n", ws_size, (size_t)WS_END); grid = -1; return; }
        grid = cus;
    }
    if (grid < 0) return;
    (void)hipMemsetAsync((char*)d_ws + WS_CTL, 0, CTL_ZERO_BYTES, stream);
    Args a{};
    for (int i = 0; i < 26; ++i) a.in[i] = (const float*)d_in[i];
    a.out = (float*)d_out; a.ws = (unsigned char*)d_ws;
    char* ws = (char*)d_ws; float* out = (float*)d_out;
    launch_phase(stream, a, 0, 1, grid);
    launch_phase(stream, a, 1, 2, grid);
    const float* q_gain = (const float*)d_in[3]; const float* k_gain = (const float*)d_in[4];
    const float* rel = (const float*)d_in[15];
    const bf16* QN = (const bf16*)(ws + WS_QN); const bf16* KVb = (const bf16*)(ws + WS_KV); const bf16* MLb = (const bf16*)(ws + WS_ML); const float* SB = (const float*)(ws + WS_S);
    bf16* YA = (bf16*)(ws + WS_YA); bf16* YB = (bf16*)(ws + WS_YB);
    for (int b = 0; b < BATCH; ++b) {
        const int row0 = b * SEQ;
        float* PA = (float*)(ws + 36 * MiB); float* y32 = (float*)(ws + 80 * MiB);
        float* kcmp = out; float* vcmp = (float*)((char*)out + 1 * MiB); int* selidx = (int*)((char*)out + 2 * MiB);
        hipLaunchKernelGGL(unpack_nsa_k, dim3((SEQ * NSA_W + 255) / 256), dim3(256), 0, stream, QN, KVb, SB, PA, row0);
        hipLaunchKernelGGL(nsa_norm_k, dim3(SEQ * 12 / 4), dim3(256), 0, stream, PA, q_gain, k_gain);
        hipLaunchKernelGGL(compress_k, dim3(NCMP * 2), dim3(256), 0, stream, (const float*)PA, C_NKC, (const float*)d_in[5], (const float*)d_in[6], (const float*)d_in[7], (const float*)d_in[8], (const float*)d_in[9], k_gain, kcmp);
        hipLaunchKernelGGL(compress_k, dim3(NCMP * 2), dim3(256), 0, stream, (const float*)PA, C_NVC, (const float*)d_in[10], (const float*)d_in[11], (const float*)d_in[12], (const float*)d_in[13], (const float*)d_in[14], (const float*)nullptr, vcmp);
        hipLaunchKernelGGL(nsa_cmp_k, dim3(SEQ * 2), dim3(256), 0, stream, (const float*)PA, (const float*)kcmp, (const float*)vcmp, rel, y32, selidx);
        hipLaunchKernelGGL(nsa_kv_k<0>, dim3(SEQ * 2), dim3(256), 0, stream, (const float*)PA, rel, (const int*)selidx, y32);
        hipLaunchKernelGGL(nsa_kv_k<1>, dim3(SEQ * 2), dim3(256), 0, stream, (const float*)PA, rel, (const int*)selidx, y32);
        hipLaunchKernelGGL(pack_y_k, dim3(SEQ * 512 / 256), dim3(256), 0, stream, (const float*)y32, YA, row0);
        float* PB = out; float* qkc = (float*)((char*)out + 66 * MiB);
        double* uD = (double*)(ws + 36 * MiB); double* aD = (double*)(ws + 37 * MiB); float* mrow = (float*)(ws + 38 * MiB);
        hipLaunchKernelGGL(unpack_ml_k, dim3((SEQ * ML_W + 255) / 256), dim3(256), 0, stream, MLb, SB, PB, row0);
        hipLaunchKernelGGL(ml_conv_k, dim3(SEQ * 1024 / 256), dim3(256), 0, stream, (const float*)PB, (const float*)d_in[16], (const float*)d_in[17], qkc);
        hipLaunchKernelGGL(ml_gates_k, dim3(4), dim3(64), 0, stream, (const float*)PB, (const float*)d_in[18], (const float*)d_in[19], uD, aD, mrow);
        hipLaunchKernelGGL(ml_quad_k, dim3(SEQ / 64, 4, 1), dim3(256), 0, stream, (const float*)qkc, (const float*)PB, (const double*)uD, (const double*)aD, (const float*)mrow, y32);
        hipLaunchKernelGGL(pack_y_k, dim3(SEQ * 512 / 256), dim3(256), 0, stream, (const float*)y32, YB, row0);
    }
    launch_phase(stream, a, 4, 5, grid);
    launch_phase(stream, a, 5, 6, grid);
    launch_phase(stream, a, 6, 7, grid);
    launch_phase(stream, a, 7, 8, grid);
    launch_phase(stream, a, 8, 9, grid);
}
```

```cpp
#include <hip/hip_runtime.h>
#include <cstdint>
#include <cstdio>
namespace pg8 {
#define PG8_LAS __attribute__((address_space(3)))
typedef unsigned short bf16_t;
typedef short bf16x8 __attribute__((ext_vector_type(8)));
typedef float f32x4 __attribute__((ext_vector_type(4)));
typedef unsigned u32x4 __attribute__((ext_vector_type(4)));
constexpr int BM = 256, BK = 64, HALF = 128, HTB = HALF * BK * 2  , STAGE_BYTES = 8 * HTB, NXCD = 8, WGM = 8;

__host__ __device__ __forceinline__ int lds_byte(int r, int c) { const int st = (r >> 4) * 2 + (c >> 5), rr = r & 15, cc = c & 31, ob = rr * 64 + cc * 2; return st * 1024 + (ob ^ (((ob >> 9) & 1) << 5)); }
__host__ __device__ __forceinline__ void stage_rc(int b, int& R, int& C) { const int st = b / 1024, sb = b % 1024, swz = sb ^ (((sb >> 9) & 1) << 5); R = (st >> 1) * 16 + swz / 64; C = (st & 1) * 32 + (swz % 64) / 2; }
__host__ __device__ __forceinline__ int perm32(int rho) { const int n = rho >> 4, i = rho & 15; return 8 * (i >> 2) + 4 * n + (i & 3); }

struct Unit { int pm, pn; };
struct Gemm { const bf16_t* A; const bf16_t* Bt; int M, N, K; };

struct StaticOrder {
    int nM, nN, nwg, G, c;
    __host__ __device__ void init(int M, int N, int G_, int c_) { nM = M / BM; nN = N / BM; nwg = nM * nN; G = G_; c = c_; }
    __host__ __device__ bool next(int i, Unit& u) const {
        const long L = (long)i * G + c; if (L >= nwg) return false;
        int wgid = (int)L; { const int q = nwg / NXCD, r = nwg % NXCD, xcd = wgid % NXCD, off = wgid / NXCD; wgid = (xcd < r ? xcd * (q + 1) : r * (q + 1) + (xcd - r) * q) + off; }
        const int nig = WGM * nN, gid = wgid / nig, fm = gid * WGM, gsz = (nM - fm) < WGM ? (nM - fm) : WGM;
        u.pm = fm + ((wgid % nig) % gsz); u.pn = (wgid % nig) / gsz; return true;
    }
    __device__ __forceinline__ void a_ready(const Unit&) const {}
    __device__ __forceinline__ void done(const Unit&) const {}
};
__device__ __forceinline__ unsigned cvt_pk_bf16(float lo, float hi) { unsigned r; asm volatile("v_cvt_pk_bf16_f32 %0, %1, %2" : "=v"(r) : "v"(lo), "v"(hi)); return r; }
__device__ __forceinline__ float bf_lo(unsigned w) { return __uint_as_float(w << 16); }
__device__ __forceinline__ float bf_hi(unsigned w) { return __uint_as_float(w & 0xffff0000u); }
__device__ __forceinline__ float fsigmoid(float v) { return __builtin_amdgcn_rcpf(1.f + __builtin_amdgcn_exp2f(-1.4426950408889634f * v)); }
__device__ __forceinline__ u32x4 pack8(const f32x4 v0, const f32x4 v1) { u32x4 w; w.x = cvt_pk_bf16(v0[0], v0[1]); w.y = cvt_pk_bf16(v0[2], v0[3]); w.z = cvt_pk_bf16(v1[0], v1[1]); w.w = cvt_pk_bf16(v1[2], v1[3]); return w; }

struct EpiProj {
    static constexpr bool PERM = true, AFTER_DRAIN = false;
    bf16_t *Qn, *KV, *ML, *G; float* S;
    __device__ __forceinline__ void operator()(const f32x4 (&acc)[2][2][4][2], const Unit& u, int wr, int wc, int fr, int fq) const {
        const int pn = u.pn, row0 = u.pm * BM + wr * 64 + fr;
        if (pn == 21) {
            if (wc == 0) {
#pragma unroll
                for (int ai = 0; ai < 2; ++ai)
#pragma unroll
                    for (int m = 0; m < 4; ++m) { float* p = S + (size_t)(row0 + ai * HALF + m * 16) * 32 + 8 * fq; *(f32x4*)p = acc[ai][0][m][0]; *(f32x4*)(p + 4) = acc[ai][0][m][1]; }
            }
            return;
        }
        bf16_t* base; int ld, ct; bool sig = false;
        if (pn < 2) { base = Qn; ld = 512; ct = pn; }
        else if (pn < 5) { base = KV; ld = 768; ct = pn - 2; }
        else if (pn < 13) { base = ML; ld = 2048; ct = pn - 5; }
        else { base = G; ld = 2048; ct = pn - 13; sig = true; }
        const int col0 = ct * 256 + wc * 32 + 8 * fq;
#pragma unroll
        for (int ai = 0; ai < 2; ++ai)
#pragma unroll
            for (int m = 0; m < 4; ++m) { bf16_t* rowp = base + (size_t)(row0 + ai * HALF + m * 16) * ld + col0;
#pragma unroll
                for (int bj = 0; bj < 2; ++bj) { f32x4 v0 = acc[ai][bj][m][0], v1 = acc[ai][bj][m][1];
                    if (sig) {
#pragma unroll
                        for (int i = 0; i < 4; ++i) { v0[i] = fsigmoid(v0[i]); v1[i] = fsigmoid(v1[i]); } }
                    *(u32x4*)(rowp + bj * HALF) = pack8(v0, v1); } }
    }
};
template <bool ACCUM> struct EpiGate {
    static constexpr bool PERM = true, AFTER_DRAIN = false;
    const bf16_t* G; int gcol0; bf16_t* Mx;
    __device__ __forceinline__ void operator()(const f32x4 (&acc)[2][2][4][2], const Unit& u, int wr, int wc, int fr, int fq) const {
        const int row0 = u.pm * BM + wr * 64 + fr, col0 = u.pn * BM + wc * 32 + 8 * fq;
#pragma unroll
        for (int ai = 0; ai < 2; ++ai)
#pragma unroll
            for (int m = 0; m < 4; ++m) { const size_t row = (size_t)(row0 + ai * HALF + m * 16);
#pragma unroll
                for (int bj = 0; bj < 2; ++bj) {
                    const u32x4 g = *(const u32x4*)(G + row * 2048 + gcol0 + col0 + bj * HALF);
                    f32x4 v0 = acc[ai][bj][m][0], v1 = acc[ai][bj][m][1];
                    v0[0] *= bf_lo(g.x); v0[1] *= bf_hi(g.x); v0[2] *= bf_lo(g.y); v0[3] *= bf_hi(g.y);
                    v1[0] *= bf_lo(g.z); v1[1] *= bf_hi(g.z); v1[2] *= bf_lo(g.w); v1[3] *= bf_hi(g.w);
                    bf16_t* mp = Mx + row * 1024 + col0 + bj * HALF;
                    if (ACCUM) { const u32x4 o = *(const u32x4*)mp;
                        v0[0] += bf_lo(o.x); v0[1] += bf_hi(o.x); v0[2] += bf_lo(o.y); v0[3] += bf_hi(o.y);
                        v1[0] += bf_lo(o.z); v1[1] += bf_hi(o.z); v1[2] += bf_lo(o.w); v1[3] += bf_hi(o.w); }
                    *(u32x4*)mp = pack8(v0, v1); } }
    }
};
struct EpiOut {
    static constexpr bool PERM = true, AFTER_DRAIN = false;
    const float* x; float* x1; bf16_t* x1b; float* rowss;
    __device__ __forceinline__ void operator()(const f32x4 (&acc)[2][2][4][2], const Unit& u, int wr, int wc, int fr, int fq) const {
        const int row0 = u.pm * BM + wr * 64 + fr, col0 = u.pn * BM + wc * 32 + 8 * fq;
#pragma unroll
        for (int ai = 0; ai < 2; ++ai)
#pragma unroll
            for (int m = 0; m < 4; ++m) { const size_t row = (size_t)(row0 + ai * HALF + m * 16); float ss = 0.f;
#pragma unroll
                for (int bj = 0; bj < 2; ++bj) { const size_t off = row * 1024 + col0 + bj * HALF;
                    const f32x4 v0 = acc[ai][bj][m][0] + *(const f32x4*)(x + off), v1 = acc[ai][bj][m][1] + *(const f32x4*)(x + off + 4);
                    *(f32x4*)(x1 + off) = v0; *(f32x4*)(x1 + off + 4) = v1; *(u32x4*)(x1b + off) = pack8(v0, v1);
                    ss += (v0[0] * v0[0] + v0[1] * v0[1]) + (v0[2] * v0[2] + v0[3] * v0[3]) + (v1[0] * v1[0] + v1[1] * v1[1]) + (v1[2] * v1[2] + v1[3] * v1[3]); }
                ss += __shfl_xor(ss, 16); ss += __shfl_xor(ss, 32);
                if (fq == 0) atomicAdd(rowss + row, ss); }
    }
};
struct EpiFF1 {
    static constexpr bool PERM = true, AFTER_DRAIN = false;
    const float* rowss; bf16_t* U;
    __device__ __forceinline__ void operator()(const f32x4 (&acc)[2][2][4][2], const Unit& u, int wr, int wc, int fr, int fq) const {
        const int row0 = u.pm * BM + wr * 64 + fr, col0 = u.pn * BM + wc * 32 + 8 * fq;
#pragma unroll
        for (int ai = 0; ai < 2; ++ai)
#pragma unroll
            for (int m = 0; m < 4; ++m) { const size_t row = (size_t)(row0 + ai * HALF + m * 16);
                const float rs = 1.0f / sqrtf(rowss[row] * (1.f / 1024.f) + 1e-6f);
#pragma unroll
                for (int bj = 0; bj < 2; ++bj) { f32x4 v0 = acc[ai][bj][m][0] * rs, v1 = acc[ai][bj][m][1] * rs;
#pragma unroll
                    for (int i = 0; i < 4; ++i) { const float a = fmaxf(v0[i], 0.f), b = fmaxf(v1[i], 0.f); v0[i] = a * a; v1[i] = b * b; }
                    *(u32x4*)(U + row * 4096 + col0 + bj * HALF) = pack8(v0, v1); } }
    }
};
struct EpiFF2 {
    static constexpr bool PERM = true, AFTER_DRAIN = false;
    float* out;
    __device__ __forceinline__ void operator()(const f32x4 (&acc)[2][2][4][2], const Unit& u, int wr, int wc, int fr, int fq) const {
        const int row0 = u.pm * BM + wr * 64 + fr, col0 = u.pn * BM + wc * 32 + 8 * fq;
#pragma unroll
        for (int ai = 0; ai < 2; ++ai)
#pragma unroll
            for (int m = 0; m < 4; ++m) { const size_t row = (size_t)(row0 + ai * HALF + m * 16);
#pragma unroll
                for (int bj = 0; bj < 2; ++bj) { float* p = out + row * 1024 + col0 + bj * HALF;
                    const f32x4 v0 = acc[ai][bj][m][0] + *(const f32x4*)p, v1 = acc[ai][bj][m][1] + *(const f32x4*)(p + 4);
                    *(f32x4*)p = v0; *(f32x4*)(p + 4) = v1; } }
    }
};
template <class Epi, class Sched, bool ALIGN_EPI = false, bool SP2 = false>
__device__ __forceinline__ void gemm_phase(PG8_LAS unsigned char* lds, const Gemm g, const Sched& S, const Epi& E) {
    const int tid = threadIdx.x, wid = __builtin_amdgcn_readfirstlane(tid >> 6), lane = tid & 63, wr = wid >> 2, wc = wid & 3, fr = lane & 15, fq = lane >> 4;
    const int K = g.K, nt = K / BK;
    unsigned voffA[2], voffB[2];
#pragma unroll
    for (int i = 0; i < 2; ++i) { int R, C; stage_rc(tid * 16 + i * 8192, R, C); const int Rb = Epi::PERM ? ((R & ~31) + perm32(R & 31)) : R;
        voffA[i] = (unsigned)(R * K + C) * 2u; voffB[i] = (unsigned)(Rb * K + C) * 2u; }
    const size_t kstep = (size_t)(BK * 2);
    const size_t hstep = (size_t)HALF * K * 2;
    const size_t tstep = 2 * hstep;
    const unsigned ldsw = (unsigned)wid * 1024u;
    const int aoff = lds_byte(wr * 64 + fr, fq * 8), boff = lds_byte(wc * 32 + fr, fq * 8);
#define PG8_SA(b, h) (((b) * 2 + (h)) * HTB)
#define PG8_SB(b, h) ((4 + (b) * 2 + (h)) * HTB)
#define PG8_STAGE(bufoff, gbase, voff) do { _Pragma("unroll") for (int _i = 0; _i < 2; ++_i) \
        __builtin_amdgcn_global_load_lds((const unsigned*)((const char*)(gbase) + (voff)[_i]), (PG8_LAS unsigned*)(lds + (bufoff) + ldsw + _i * 8192), 16, 0, 0); } while (0)
#define PG8_LDA(dst, b, h) do { _Pragma("unroll") for (int m = 0; m < 4; ++m) _Pragma("unroll") for (int k = 0; k < 2; ++k) dst[m][k] = *(const PG8_LAS bf16x8*)(lds + PG8_SA(b, h) + aoff + m * 2048 + k * 1024); } while (0)
#define PG8_LDB(dst, b, h) do { _Pragma("unroll") for (int n = 0; n < 2; ++n) _Pragma("unroll") for (int k = 0; k < 2; ++k) dst[n][k] = *(const PG8_LAS bf16x8*)(lds + PG8_SB(b, h) + boff + n * 2048 + k * 1024); } while (0)
#define PG8_MMA(ai, bj, At, Bt) do { __builtin_amdgcn_s_setprio(1); _Pragma("unroll") for (int m = 0; m < 4; ++m) _Pragma("unroll") for (int n = 0; n < 2; ++n) _Pragma("unroll") for (int k = 0; k < 2; ++k) \
        acc[ai][bj][m][n] = __builtin_amdgcn_mfma_f32_16x16x32_bf16(Bt[n][k], At[m][k], acc[ai][bj][m][n], 0, 0, 0); __builtin_amdgcn_s_setprio(0); } while (0)
#define PG8_WAIT_V(n) asm volatile("s_waitcnt vmcnt(" #n ")" ::: "memory")
#define PG8_WAIT_L(n) asm volatile("s_waitcnt lgkmcnt(" #n ")" ::: "memory")
#define PG8_BAR __builtin_amdgcn_s_barrier()
#define PG8_SCHED __builtin_amdgcn_sched_barrier(0)
    Unit cur, nxt; int ui = 0;
    if (!S.next(0, cur)) return;
    f32x4 acc[2][2][4][2];
#pragma unroll
    for (int a = 0; a < 2; ++a)
#pragma unroll
        for (int b = 0; b < 2; ++b)
#pragma unroll
            for (int m = 0; m < 4; ++m)
#pragma unroll
                for (int n = 0; n < 2; ++n) acc[a][b][m][n] = (f32x4){0.f, 0.f, 0.f, 0.f};
    bf16x8 At[4][2], B0[2][2], B1[2][2];
    const char* cA = (const char*)g.A + (size_t)cur.pm * tstep; const char* cB = (const char*)g.Bt + (size_t)cur.pn * tstep;
    S.a_ready(cur);
    if constexpr (SP2) {
        PG8_STAGE(PG8_SB(0, 0), cB, voffB); PG8_STAGE(PG8_SB(0, 1), cB + hstep, voffB); PG8_STAGE(PG8_SA(0, 0), cA, voffA); PG8_STAGE(PG8_SA(0, 1), cA + hstep, voffA);
        if (wr == 1) PG8_BAR;
        PG8_WAIT_V(2); PG8_BAR;
        PG8_STAGE(PG8_SB(1, 0), cB + kstep, voffB); PG8_STAGE(PG8_SA(1, 0), cA + kstep, voffA); PG8_STAGE(PG8_SB(1, 1), cB + hstep + kstep, voffB);
        PG8_WAIT_V(6); PG8_BAR;
    } else {
        PG8_STAGE(PG8_SB(0, 0), cB, voffB); PG8_STAGE(PG8_SA(0, 0), cA, voffA); PG8_STAGE(PG8_SB(0, 1), cB + hstep, voffB); PG8_STAGE(PG8_SA(0, 1), cA + hstep, voffA);
        if (wr == 1) PG8_BAR;
        PG8_WAIT_V(4); PG8_BAR;
        PG8_STAGE(PG8_SB(1, 0), cB + kstep, voffB); PG8_STAGE(PG8_SA(1, 0), cA + kstep, voffA); PG8_STAGE(PG8_SB(1, 1), cB + hstep + kstep, voffB);
        PG8_WAIT_V(6); PG8_BAR;
    }
    for (;;) {
        const bool has_next = S.next(ui + 1, nxt);
        const char* nA = has_next ? (const char*)g.A + (size_t)nxt.pm * tstep : cA; const char* nB = has_next ? (const char*)g.Bt + (size_t)nxt.pn * tstep : cB;
        for (int t = 0; t < nt; t += 2) {
            const bool last = (t == nt - 2);
            const char* a1 = cA + (size_t)(t + 1) * kstep;
            const char* a2 = last ? nA : cA + (size_t)(t + 2) * kstep; const char* b2 = last ? nB : cB + (size_t)(t + 2) * kstep;
            const char* a3 = a2 + kstep; const char* b3 = b2 + kstep;
            if (last && has_next) S.a_ready(nxt);
            if constexpr (SP2) {
            PG8_LDB(B0, 0, 0); PG8_LDB(B1, 0, 1); PG8_SCHED; PG8_LDA(At, 0, 0); PG8_STAGE(PG8_SA(1, 1), a1 + hstep, voffA);
            PG8_WAIT_V(8); PG8_WAIT_L(0); PG8_BAR; PG8_MMA(0, 0, At, B0); PG8_MMA(0, 1, At, B1); PG8_BAR; PG8_SCHED;
            PG8_LDA(At, 0, 1); PG8_STAGE(PG8_SB(0, 0), b2, voffB); PG8_STAGE(PG8_SB(0, 1), b2 + hstep, voffB); PG8_STAGE(PG8_SA(0, 0), a2, voffA);
            PG8_WAIT_V(8); PG8_WAIT_L(0); PG8_BAR; PG8_MMA(1, 0, At, B0); PG8_MMA(1, 1, At, B1); PG8_BAR; PG8_SCHED;
            PG8_LDB(B0, 1, 0); PG8_LDB(B1, 1, 1); PG8_SCHED; PG8_LDA(At, 1, 0); PG8_STAGE(PG8_SA(0, 1), a2 + hstep, voffA);
            PG8_WAIT_V(8); PG8_WAIT_L(0); PG8_BAR; PG8_MMA(0, 0, At, B0); PG8_MMA(0, 1, At, B1); PG8_BAR; PG8_SCHED;
            PG8_LDA(At, 1, 1); PG8_STAGE(PG8_SB(1, 0), b3, voffB); PG8_STAGE(PG8_SB(1, 1), b3 + hstep, voffB); PG8_STAGE(PG8_SA(1, 0), a3, voffA);
            PG8_WAIT_V(8); PG8_WAIT_L(0); PG8_BAR; PG8_MMA(1, 0, At, B0); PG8_MMA(1, 1, At, B1); PG8_BAR; PG8_SCHED;
            } else {
            PG8_LDB(B0, 0, 0); PG8_SCHED; PG8_LDA(At, 0, 0); PG8_STAGE(PG8_SA(1, 1), a1 + hstep, voffA);
            PG8_WAIT_L(8); PG8_BAR; PG8_WAIT_L(0); PG8_MMA(0, 0, At, B0); PG8_BAR; PG8_SCHED;
            PG8_LDB(B1, 0, 1); PG8_STAGE(PG8_SB(0, 0), b2, voffB);
            PG8_BAR; PG8_WAIT_L(0); PG8_MMA(0, 1, At, B1); PG8_BAR;
            PG8_LDA(At, 0, 1); PG8_STAGE(PG8_SA(0, 0), a2, voffA);
            PG8_BAR; PG8_WAIT_L(0); PG8_MMA(1, 0, At, B0); PG8_BAR; PG8_SCHED;
            PG8_STAGE(PG8_SB(0, 1), b2 + hstep, voffB);
            PG8_WAIT_V(6); PG8_BAR; PG8_MMA(1, 1, At, B1); PG8_BAR;
            PG8_LDB(B0, 1, 0); PG8_SCHED; PG8_LDA(At, 1, 0); PG8_STAGE(PG8_SA(0, 1), a2 + hstep, voffA);
            PG8_WAIT_L(8); PG8_BAR; PG8_WAIT_L(0); PG8_MMA(0, 0, At, B0); PG8_BAR; PG8_SCHED;
            PG8_LDB(B1, 1, 1); PG8_STAGE(PG8_SB(1, 0), b3, voffB);
            PG8_BAR; PG8_WAIT_L(0); PG8_MMA(0, 1, At, B1); PG8_BAR;
            PG8_LDA(At, 1, 1); PG8_STAGE(PG8_SA(1, 0), a3, voffA);
            PG8_BAR; PG8_WAIT_L(0); PG8_MMA(1, 0, At, B0); PG8_BAR; PG8_SCHED;
            PG8_STAGE(PG8_SB(1, 1), b3 + hstep, voffB);
            PG8_WAIT_V(6); PG8_BAR; PG8_MMA(1, 1, At, B1); PG8_BAR;
            }
        }
        if constexpr (ALIGN_EPI) { if (wr == 0) PG8_BAR; }
        if constexpr (!Epi::AFTER_DRAIN) { E(acc, cur, wr, wc, fr, fq); S.done(cur); }
        if (!has_next) break;
#pragma unroll
        for (int a = 0; a < 2; ++a)
#pragma unroll
            for (int b = 0; b < 2; ++b)
#pragma unroll
                for (int m = 0; m < 4; ++m)
#pragma unroll
                    for (int n = 0; n < 2; ++n) acc[a][b][m][n] = (f32x4){0.f, 0.f, 0.f, 0.f};
        cur = nxt; cA = nA; cB = nB; ++ui;
        if constexpr (ALIGN_EPI) { if (wr == 1) PG8_BAR; }
    }
    PG8_WAIT_V(0);
    if constexpr (!ALIGN_EPI) { if (wr == 0) PG8_BAR; }
    PG8_BAR;
    if constexpr (Epi::AFTER_DRAIN) { E.fused(acc, cur, wr, wc, fr, fq, lds, wid, lane); S.done(cur); }
#undef PG8_SA
#undef PG8_SB
#undef PG8_STAGE
#undef PG8_LDA
#undef PG8_LDB
#undef PG8_MMA
#undef PG8_WAIT_V
#undef PG8_WAIT_L
#undef PG8_BAR
#undef PG8_SCHED
}
}
constexpr int D_MODEL = 1024, BATCH = 4, SEQ = 8192, NTOK = BATCH * SEQ;
constexpr int D_PROJ = 5408, D_FF = 4096, NP_PAD = 5632;
constexpr int NWAVES = 8;
constexpr size_t MiB = 1u << 20;
constexpr size_t WS_CTL = 0, CTL_ZERO_BYTES = 1 * MiB;
constexpr size_t CTL_ROWSS = 512 * 1024;
constexpr size_t WS_WIN = 2 * MiB, WS_WA = 13 * MiB, WS_WB = 14 * MiB, WS_WO = 15 * MiB, WS_W1 = 17 * MiB, WS_W2 = 25 * MiB, WS_CK1 = 33 * MiB, WS_CV1 = 34 * MiB;
constexpr size_t WS_SMALL = 35 * MiB;
constexpr size_t WS_KSN = 40 * MiB, WS_KWN = 48 * MiB, WS_VST = 56 * MiB, WS_VWT = 64 * MiB, WS_KCN = 72 * MiB, WS_VCT = 73 * MiB;
constexpr size_t CTL_QCTR = 4096;
constexpr size_t WS_XN = 36 * MiB;
constexpr size_t WS_QN = 100 * MiB, WS_KV = 132 * MiB, WS_ML = 180 * MiB, WS_G = 308 * MiB, WS_S = 436 * MiB;
constexpr size_t WS_YA = 440 * MiB, WS_YB = 472 * MiB;
constexpr size_t WS_MX = 180 * MiB;
constexpr size_t WS_U = 180 * MiB;
constexpr size_t WS_END = 504 * MiB;
constexpr int RING_BYTES = 131072, MISC_OFF = RING_BYTES + 320, LDS_BYTES = 147456;

#define GAS __attribute__((address_space(1)))
#define LAS __attribute__((address_space(3)))
typedef unsigned short bf16;
typedef unsigned v4u __attribute__((ext_vector_type(4)));
typedef float f32x4 __attribute__((ext_vector_type(4)));
#define LDS_WAIT() asm volatile("s_waitcnt lgkmcnt(0)" ::: "memory")
#define VM_WAIT() asm volatile("s_waitcnt vmcnt(0)" ::: "memory")
__device__ __forceinline__ unsigned f2bf(float f) { unsigned u = __builtin_bit_cast(unsigned, f); return (u + 0x7fffu + ((u >> 16) & 1u)) >> 16; }
__device__ __forceinline__ unsigned pk2(float lo, float hi) { return f2bf(lo) | (f2bf(hi) << 16); }
__device__ __forceinline__ float wave_sum(float v) {
#pragma unroll
    for (int o = 1; o < 64; o <<= 1) v += __shfl_xor(v, o);
    return v;
}
__device__ __forceinline__ float wave_max(float v) {
#pragma unroll
    for (int o = 1; o < 64; o <<= 1) v = fmaxf(v, __shfl_xor(v, o));
    return v;
}

__device__ __forceinline__ int proj_src_col(int n) {
    if (n < 1280) return n;
    if (n < 3328) { const int q = (n - 1280) >> 9, r = (n - 1280) & 511; return (q == 0 ? 1304 : q == 1 ? 1816 : q == 2 ? 2328 : 2848) + r; }
    if (n < 5376) return 3360 + (n - 3328);
    if (n < 5400) return 1280 + (n - 5376);
    if (n < 5404) return 2840 + (n - 5400);
    if (n < 5408) return 2844 + (n - 5404);
    return -1;
}
template <bool MAP>
__device__ __forceinline__ void transpose_item(const float* W, int K, int ldw, const float* kscale, bf16* WT, int Nout, LAS float* scr, int item, int lane) {
    const int nblk = Nout / 32, kb = item / nblk, nb = item % nblk, k0 = 64 * kb, n0 = 32 * nb;
    const int sc = MAP ? proj_src_col(n0 + (lane & 31)) : (n0 + (lane & 31));
#pragma unroll 8
    for (int i = 0; i < 32; ++i) { const int kk = 2 * i + (lane >> 5); float v = sc >= 0 ? W[(size_t)(k0 + kk) * ldw + sc] : 0.f; if (kscale) v *= kscale[k0 + kk]; scr[kk * 33 + (lane & 31)] = v; }
    LDS_WAIT(); asm volatile("" ::: "memory");
    const int c = lane & 7;
#pragma unroll
    for (int j = 0; j < 4; ++j) { const int n = (lane >> 3) + 8 * j; const LAS float* s = scr + (8 * c) * 33 + n;
        v4u o; o.x = pk2(s[0 * 33], s[1 * 33]); o.y = pk2(s[2 * 33], s[3 * 33]); o.z = pk2(s[4 * 33], s[5 * 33]); o.w = pk2(s[6 * 33], s[7 * 33]);
        *(GAS v4u*)(WT + (size_t)(n0 + n) * K + k0 + 8 * c) = o; }
    LDS_WAIT(); asm volatile("" ::: "memory");
}
__device__ __forceinline__ void rms_row_to_bf16(const float* xrow, bf16* orow, int lane) {
    const GAS f32x4* xr = (const GAS f32x4*)xrow + lane;
    f32x4 v[4]; float s = 0.f;
#pragma unroll
    for (int j = 0; j < 4; ++j) { v[j] = xr[64 * j]; s += (v[j].x * v[j].x + v[j].y * v[j].y) + (v[j].z * v[j].z + v[j].w * v[j].w); }
    const float rstd = 1.f / sqrtf(wave_sum(s) * (1.f / D_MODEL) + 1e-6f);
    GAS unsigned long long* o8 = (GAS unsigned long long*)orow + lane;
#pragma unroll
    for (int j = 0; j < 4; ++j) o8[64 * j] = (unsigned long long)pk2(v[j].x * rstd, v[j].y * rstd) | ((unsigned long long)pk2(v[j].z * rstd, v[j].w * rstd) << 32);
}

typedef short bf16x8 __attribute__((ext_vector_type(8)));
typedef float f32x16 __attribute__((ext_vector_type(16)));
typedef unsigned u32x4 __attribute__((ext_vector_type(4)));
typedef unsigned u32x2 __attribute__((ext_vector_type(2)));
constexpr float LOG2E = 1.4426950408889634f;
__device__ const unsigned char BUCKET_TAB2[129] = {0, 1, 2, 3, 4, 5, 6, 7, 8, 9, 10, 11, 12, 13, 14, 15, 16, 16, 16, 17, 17, 18, 18, 18, 19, 19, 19, 20, 20, 20, 20, 21, 21, 21, 21, 22, 22, 22, 22, 22, 23, 23, 23, 23, 23, 23, 24, 24, 24, 24, 24, 24, 25, 25, 25, 25, 25, 25, 25, 26, 26, 26, 26, 26, 26, 26, 26, 27, 27, 27, 27, 27, 27, 27, 27, 27, 27, 28, 28, 28, 28, 28, 28, 28, 28, 28, 28, 29, 29, 29, 29, 29, 29, 29, 29, 29, 29, 29, 29, 30, 30, 30, 30, 30, 30, 30, 30, 30, 30, 30, 30, 30, 30, 31, 31, 31, 31, 31, 31, 31, 31, 31, 31, 31, 31, 31, 31, 31, 31};
__device__ __forceinline__ unsigned cvtpk(float lo, float hi) { typedef float f2 __attribute__((ext_vector_type(2))); typedef __bf16 b2 __attribute__((ext_vector_type(2))); f2 v = {lo, hi}; b2 b = __builtin_convertvector(v, b2); return __builtin_bit_cast(unsigned, b); }
__device__ __forceinline__ float bflo(unsigned w) { return __uint_as_float(w << 16); }
__device__ __forceinline__ float bfhi(unsigned w) { return __uint_as_float(w & 0xffff0000u); }
__device__ __forceinline__ int key_off16(int pp) { return (pp & 3) + 8 * ((pp >> 2) & 1) + 4 * (pp >> 3); }
__device__ __forceinline__ int crow(int r, int hi) { return (r & 3) + 8 * (r >> 2) + 4 * hi; }

__device__ __forceinline__ void knorm_item(const bf16* KV, int col0, const float* gain, bf16* dst, size_t tok0, int lane) {
    const int ch = lane & 7;
    float gn[8];
#pragma unroll
    for (int i = 0; i < 8; ++i) gn[i] = gain[8 * ch + i];
#pragma unroll
    for (int it = 0; it < 8; ++it) {
        const int r = 8 * it + (lane >> 3);
        const u32x4 v = *(const u32x4*)(KV + (tok0 + r) * 768 + col0 + 8 * ch);
        float f[8] = {bflo(v.x), bfhi(v.x), bflo(v.y), bfhi(v.y), bflo(v.z), bfhi(v.z), bflo(v.w), bfhi(v.w)};
        float ss = 0.f;
#pragma unroll
        for (int i = 0; i < 8; ++i) ss += f[i] * f[i];
        ss += __shfl_xor(ss, 1); ss += __shfl_xor(ss, 2); ss += __shfl_xor(ss, 4);
        const float rs = 1.f / sqrtf(ss * (1.f / 64.f) + 1e-6f);
        u32x4 o; o.x = cvtpk(f[0] * rs * gn[0], f[1] * rs * gn[1]); o.y = cvtpk(f[2] * rs * gn[2], f[3] * rs * gn[3]); o.z = cvtpk(f[4] * rs * gn[4], f[5] * rs * gn[5]); o.w = cvtpk(f[6] * rs * gn[6], f[7] * rs * gn[7]);
        *(u32x4*)(dst + (size_t)r * 64 + 8 * ch) = o;
    }
}
__device__ __forceinline__ void vtrans_item(const bf16* KV, int col0, bf16* dst, size_t tok0, LAS unsigned short* scr, int lane) {
#pragma unroll
    for (int it = 0; it < 8; ++it) {
        const int r = 8 * it + (lane >> 3), ch = lane & 7;
        const u32x4 v = *(const u32x4*)(KV + (tok0 + r) * 768 + col0 + 8 * ch);
        *(LAS u32x4*)(scr + r * 72 + 8 * ch) = v;
    }
    LDS_WAIT(); asm volatile("" ::: "memory");
    const int d = lane;
#pragma unroll
    for (int oc = 0; oc < 8; ++oc) {
        unsigned w[4];
#pragma unroll
        for (int k2 = 0; k2 < 4; ++k2) {
            const int p0 = 8 * oc + 2 * k2, p1 = p0 + 1;
            const int key0 = 16 * (p0 >> 4) + key_off16(p0 & 15), key1 = 16 * (p1 >> 4) + key_off16(p1 & 15);
            w[k2] = (unsigned)scr[key0 * 72 + d] | ((unsigned)scr[key1 * 72 + d] << 16);
        }
        u32x4 o; o.x = w[0]; o.y = w[1]; o.z = w[2]; o.w = w[3];
        *(u32x4*)(dst + (size_t)d * 64 + 8 * oc) = o;
    }
    LDS_WAIT(); asm volatile("" ::: "memory");
}
__device__ __forceinline__ void compress_unit(int unit, const bf16* KV, const bf16* W1T, const bf16* W2T, const float* b1p, const float* b2, const float* kgain0,
                                              bf16* KCN, bf16* VCT, LAS unsigned char* lds, int tid) {
    const int kv = unit & 1, tl = (unit >> 1) & 7, bg = unit >> 4, b = bg >> 1, g = bg & 1;
    const int lane = tid & 63, w = __builtin_amdgcn_readfirstlane(tid >> 6), r32 = lane & 31, hi = lane >> 5;
    const int colbase = (kv ? 128 : 0) + 64 * g;
    LAS unsigned short* hid = (LAS unsigned short*)lds;
    LAS float* outl = (LAS float*)(lds + 64 * 264 * 2);
    f32x16 acc[2]; acc[0] = f32x16{}; acc[1] = f32x16{};
    const bf16* brow = W1T + (size_t)(32 * w + r32) * 2048 + 8 * hi;
    const bf16* arow[2];
#pragma unroll
    for (int rt = 0; rt < 2; ++rt) arow[rt] = KV + ((size_t)b * SEQ) * 768 + colbase + 8 * hi;
    int n16[2];
#pragma unroll
    for (int rt = 0; rt < 2; ++rt) n16[rt] = 16 * (64 * tl + 32 * rt + r32);
#pragma unroll 4
    for (int s = 0; s < 128; ++s) {
        const int jj = s >> 2, d0 = 16 * (s & 3);
        const bf16x8 bf = *(const bf16x8*)(brow + 16 * s);
#pragma unroll
        for (int rt = 0; rt < 2; ++rt) {
            int tok = n16[rt] + jj; tok = tok > SEQ - 1 ? SEQ - 1 : tok;
            const bf16x8 af = *(const bf16x8*)(arow[rt] + (size_t)tok * 768 + d0);
            acc[rt] = __builtin_amdgcn_mfma_f32_32x32x16_bf16(af, bf, acc[rt], 0, 0, 0);
        }
    }
    {
        const int col = 32 * w + r32; const float bb = b1p[col];
#pragma unroll
        for (int rt = 0; rt < 2; ++rt)
#pragma unroll
            for (int r = 0; r < 16; ++r) {
                const float x = acc[rt][r] + bb;
                const float u = 0.7978845608028654f * (x + 0.044715f * x * x * x);
                const float e = __builtin_amdgcn_exp2f(2.f * LOG2E * u);
                const float th = 1.f - 2.f * __builtin_amdgcn_rcpf(e + 1.f);
                hid[(32 * rt + crow(r, hi)) * 264 + col] = (unsigned short)(cvtpk(0.5f * x * (1.f + th), 0.f) & 0xffffu);
            }
    }
    __syncthreads();
    if (w < 4) {
        const int rt = w >> 1, ct = w & 1;
        f32x16 o = f32x16{};
        const bf16* b2row = W2T + (size_t)(32 * ct + r32) * 256 + 8 * hi;
#pragma unroll
        for (int s = 0; s < 16; ++s) {
            const bf16x8 af = *(const LAS bf16x8*)(hid + (32 * rt + r32) * 264 + 16 * s + 8 * hi);
            const bf16x8 bf = *(const bf16x8*)(b2row + 16 * s);
            o = __builtin_amdgcn_mfma_f32_32x32x16_bf16(af, bf, o, 0, 0, 0);
        }
        const float bb = b2[32 * ct + r32];
#pragma unroll
        for (int r = 0; r < 16; ++r) outl[(32 * rt + crow(r, hi)) * 65 + 32 * ct + r32] = o[r] + bb;
    }
    __syncthreads();
#pragma unroll
    for (int k = 0; k < 8; ++k) {
        const int r = 8 * w + k, n = 64 * tl + r;
        float v = outl[r * 65 + lane];
        if (kv == 0) {
            const float ss = wave_sum(v * v);
            v = v * (1.f / sqrtf(ss * (1.f / 64.f) + 1e-6f)) * kgain0[lane];
            if (n >= 511) v = 0.f;
            KCN[((size_t)bg * 512 + n) * 64 + lane] = (bf16)f2bf(v);
        } else {
            if (n >= 511) v = 0.f;
            const int pos = 16 * (r >> 4) + key_off16(r & 15);
            VCT[(((size_t)bg * 8 + tl) * 64 + lane) * 64 + pos] = (bf16)f2bf(v);
        }
    }
    __syncthreads();
}

constexpr int ENG_BUF = 0;
constexpr int ENG_LUT = 32768;
constexpr int LUTN = 704;
constexpr int ENG_IMP = ENG_LUT + 4 * LUTN * 4;
constexpr int ENG_SELM = ENG_IMP + 64 * 128 * 4;
constexpr int ENG_UNION = ENG_SELM + 64 * 4 * 4;
constexpr int ENG_TLIST = ENG_UNION + 16;
constexpr int ENG_MISC = ENG_TLIST + 132 * 4;
constexpr int ENG_STASH = ENG_MISC + 16;
constexpr int ENG_END = ENG_STASH + 32 * 512 * 4;

struct EngPtrs { const bf16 *QN, *KCN, *VCT, *KSN, *VST, *KWN, *VWT; const float* SB; const float* rel; const float* qgain; const float* bounds; bf16* YA; };

__device__ __forceinline__ int tile_off(int row, int ch) { return row * 128 + ((ch ^ (row & 7)) << 4); }

template <int BR>
__device__ __forceinline__ void eng_branch(LAS unsigned char* lds, const bf16* Kg, const bf16* Vg, int nt, int c, int tid, int lane, int hl, int qh,
                                           const bf16x8 (&qr)[4], float farc, float& lsum, float inv_l, f32x16 (&o)[2]) {
    const int r32 = lane & 31, hi = lane >> 5;
    const LAS int* tlist = (const LAS int*)(lds + ENG_TLIST);
    const LAS float* lut = (const LAS float*)(lds + ENG_LUT) + hl * LUTN;
    LAS float* imp = (LAS float*)(lds + ENG_IMP);
    auto tile_id = [&](int k) -> int { return BR <= 1 ? k : (BR == 2 ? tlist[k] : (c - 8 + k < 0 ? 0 : c - 8 + k)); };
    const int kofs = (BR == 3) ? (c < 8 ? 8 - c : 0) : 0;
    const int srow = tid >> 3, sch = tid & 7, soff = tile_off(srow, sch);
    u32x4 kreg, vreg;
    {
        const int j0 = tile_id(kofs);
        kreg = *(const u32x4*)(Kg + (size_t)j0 * 4096 + tid * 8);
        if (BR != 0) vreg = *(const u32x4*)(Vg + (size_t)j0 * 4096 + tid * 8);
        *(LAS u32x4*)(lds + ENG_BUF + soff) = kreg;
        if (BR != 0) *(LAS u32x4*)(lds + ENG_BUF + 8192 + soff) = vreg;
    }
    __syncthreads();
    for (int k = 0; k < nt; ++k) {
        const int j = tile_id(k + kofs);
        const int bufo = ENG_BUF + (k & 1) * 16384;
        if (k + 1 < nt) {
            const int jn = tile_id(k + 1 + kofs);
            kreg = *(const u32x4*)(Kg + (size_t)jn * 4096 + tid * 8);
            if (BR != 0) vreg = *(const u32x4*)(Vg + (size_t)jn * 4096 + tid * 8);
        }
        bool near_;
        float cinit;
        if (BR <= 1) { const int dmin = 64 * c - 16 * (64 * j + 63) - 31; near_ = dmin < 128; cinit = near_ ? 0.f : farc; }
        else if (BR == 2) { near_ = (j >= c - 2); cinit = near_ ? 0.f : farc; const unsigned wsel = ((const LAS unsigned*)(lds + ENG_SELM))[(32 * qh + r32) * 4 + (j >> 5)]; if (!((wsel >> (j & 31)) & 1u)) cinit = -INFINITY; }
        else { near_ = (j >= c - 2) || (j == c - 8); cinit = near_ ? 0.f : farc; }
        f32x16 p[2];
        {
            f32x16 ci;
#pragma unroll
            for (int r = 0; r < 16; ++r) ci[r] = cinit;
            p[0] = ci; p[1] = ci;
        }
#pragma unroll
        for (int s = 0; s < 4; ++s)
#pragma unroll
            for (int kh = 0; kh < 2; ++kh) {
                const bf16x8 kf = *(const LAS bf16x8*)(lds + bufo + tile_off(32 * kh + r32, 2 * s + hi));
                p[kh] = __builtin_amdgcn_mfma_f32_32x32x16_bf16(kf, qr[s], p[kh], 0, 0, 0);
            }
        if (near_) {
            if (BR <= 1) {
                const int dbase = 64 * c + 32 * qh + r32 - 16 * (64 * j + 4 * hi) - 31;
#pragma unroll
                for (int kh = 0; kh < 2; ++kh)
#pragma unroll
                    for (int r = 0; r < 16; ++r) {
                        const int cr = 32 * kh + (r & 3) + 8 * (r >> 2);
                        const int dist = dbase - 16 * cr;
                        const int idx = (dist > 128 ? 128 : dist) + 64;
                        const float bias = lut[idx < 0 ? 0 : idx];
                        p[kh][r] = dist >= 0 ? p[kh][r] + bias : -INFINITY;
                    }
            } else {
                const LAS float* pb = lut + (64 * (c - j) + 32 * qh + r32 - 4 * hi + 64 - 59);
#pragma unroll
                for (int kh = 0; kh < 2; ++kh)
#pragma unroll
                    for (int r = 0; r < 16; ++r) { const int cr = 32 * kh + (r & 3) + 8 * (r >> 2); p[kh][r] += pb[59 - cr]; }
            }
        }
        float ls = 0.f;
#pragma unroll
        for (int kh = 0; kh < 2; ++kh)
#pragma unroll
            for (int r = 0; r < 16; ++r) { p[kh][r] = __builtin_amdgcn_exp2f(p[kh][r]); ls += p[kh][r]; }
        lsum += ls;
        if (BR == 1) {
#pragma unroll
            for (int kh = 0; kh < 2; ++kh)
#pragma unroll
                for (int r = 0; r < 16; ++r) p[kh][r] *= inv_l;
            if (c >= 16) {
                const int q = 32 * qh + r32;
#pragma unroll
                for (int kh = 0; kh < 2; ++kh)
#pragma unroll
                    for (int a = 0; a < 4; ++a) {
                        const int jb = 16 * j + 8 * kh + 2 * a + hi;
                        const float gs = (p[kh][4 * a] + p[kh][4 * a + 1]) + (p[kh][4 * a + 2] + p[kh][4 * a + 3]);
                        __hip_atomic_fetch_add(&imp[q * 128 + jb], gs, __ATOMIC_RELAXED, __HIP_MEMORY_SCOPE_WORKGROUP);
                        if (jb + 1 < 128) __hip_atomic_fetch_add(&imp[q * 128 + jb + 1], p[kh][4 * a + 3], __ATOMIC_RELAXED, __HIP_MEMORY_SCOPE_WORKGROUP);
                    }
            }
        }
        if (BR != 0) {
#pragma unroll
            for (int ks = 0; ks < 4; ++ks) {
                const int kh = ks >> 1, s2 = ks & 1;
                u32x4 pw; pw.x = cvtpk(p[kh][8 * s2 + 0], p[kh][8 * s2 + 1]); pw.y = cvtpk(p[kh][8 * s2 + 2], p[kh][8 * s2 + 3]); pw.z = cvtpk(p[kh][8 * s2 + 4], p[kh][8 * s2 + 5]); pw.w = cvtpk(p[kh][8 * s2 + 6], p[kh][8 * s2 + 7]);
                const bf16x8 pf = __builtin_bit_cast(bf16x8, pw);
#pragma unroll
                for (int dh = 0; dh < 2; ++dh) {
                    const bf16x8 vf = *(const LAS bf16x8*)(lds + bufo + 8192 + tile_off(32 * dh + r32, 2 * ks + hi));
                    o[dh] = __builtin_amdgcn_mfma_f32_32x32x16_bf16(vf, pf, o[dh], 0, 0, 0);
                }
            }
        }
        if (k + 1 < nt) {
            const int bo = ENG_BUF + ((k + 1) & 1) * 16384;
            *(LAS u32x4*)(lds + bo + soff) = kreg;
            if (BR != 0) *(LAS u32x4*)(lds + bo + 8192 + soff) = vreg;
        }
        __syncthreads();
    }
}

__device__ __forceinline__ void eng_unit(int unit, const EngPtrs& P, LAS unsigned char* lds, int tid) {
    const int c = 127 - (unit >> 3), bg = unit & 7, b = bg >> 1, g = bg & 1;
    const int lane = tid & 63, w = __builtin_amdgcn_readfirstlane(tid >> 6), hl = w >> 1, qh = w & 1, r32 = lane & 31, hi = lane >> 5;
    const int head = 4 * g + hl;
    const int t = 64 * c + 32 * qh + r32;
    const size_t row = (size_t)b * SEQ + t;
    LAS float* lutw = (LAS float*)(lds + ENG_LUT);
    LAS float* imp = (LAS float*)(lds + ENG_IMP);
    LAS unsigned* selm = (LAS unsigned*)(lds + ENG_SELM);
    LAS unsigned* uni = (LAS unsigned*)(lds + ENG_UNION);
    LAS int* tlist = (LAS int*)(lds + ENG_TLIST);
    LAS int* misc = (LAS int*)(lds + ENG_MISC);
    for (int i = tid; i < 4 * LUTN; i += 512) {
        const int h4 = i / LUTN, ii = i % LUTN, dist = ii - 64, hd = 4 * g + h4;
        float v;
        if (dist < 0 || dist >= 512) v = -INFINITY;
        else { const int bk = dist >= 128 ? 31 : (int)BUCKET_TAB2[dist]; v = (P.rel[bk * 8 + hd] - P.bounds[hd]) * LOG2E; }
        lutw[i] = v;
    }
    if (c >= 16) for (int i = tid; i < 64 * 128; i += 512) imp[i] = 0.f;
    if (tid < 4) uni[tid] = 0u;
    bf16x8 qr[4];
    {
        const bf16* qp = P.QN + row * 512 + head * 64 + 8 * hi;
        u32x4 raw[4]; float ss = 0.f;
#pragma unroll
        for (int s = 0; s < 4; ++s) { raw[s] = *(const u32x4*)(qp + 16 * s);
            const float f[8] = {bflo(raw[s].x), bfhi(raw[s].x), bflo(raw[s].y), bfhi(raw[s].y), bflo(raw[s].z), bfhi(raw[s].z), bflo(raw[s].w), bfhi(raw[s].w)};
#pragma unroll
            for (int i = 0; i < 8; ++i) ss += f[i] * f[i]; }
        ss += __shfl_xor(ss, 32);
        const float rs = (1.f / sqrtf(ss * (1.f / 64.f) + 1e-6f)) * 0.125f * LOG2E;
#pragma unroll
        for (int s = 0; s < 4; ++s) {
            const float* gp = P.qgain + 16 * s + 8 * hi;
            u32x4 o4;
            o4.x = cvtpk(bflo(raw[s].x) * rs * gp[0], bfhi(raw[s].x) * rs * gp[1]); o4.y = cvtpk(bflo(raw[s].y) * rs * gp[2], bfhi(raw[s].y) * rs * gp[3]);
            o4.z = cvtpk(bflo(raw[s].z) * rs * gp[4], bfhi(raw[s].z) * rs * gp[5]); o4.w = cvtpk(bflo(raw[s].w) * rs * gp[6], bfhi(raw[s].w) * rs * gp[7]);
            qr[s] = __builtin_bit_cast(bf16x8, o4);
        }
    }
    const float* gl = P.SB + row * 32 + head * 3;
    const float gate0 = 1.f / (1.f + __expf(-gl[0])), gate1 = 1.f / (1.f + __expf(-gl[1])), gate2 = 1.f / (1.f + __expf(-gl[2]));
    const float farc = (P.rel[31 * 8 + head] - P.bounds[head]) * LOG2E;
    LAS float* stash = (LAS float*)(lds + ENG_STASH) + tid;
    __syncthreads();
    {
        const int nvmax = (4 * c + 3 > 511) ? 511 : 4 * c + 3;
        const int ntc = (nvmax + 63) >> 6;
        const bf16* Kg = P.KCN + (size_t)bg * 512 * 64; const bf16* Vg = P.VCT + (size_t)bg * 8 * 4096;
        float l1 = 0.f; f32x16 od[2]; od[0] = f32x16{}; od[1] = f32x16{};
        eng_branch<0>(lds, Kg, Vg, ntc, c, tid, lane, hl, qh, qr, farc, l1, 0.f, od);
        l1 += __shfl_xor(l1, 32);
        const float inv = l1 > 0.f ? 1.f / l1 : 0.f;
        float l2 = 0.f;
        eng_branch<1>(lds, Kg, Vg, ntc, c, tid, lane, hl, qh, qr, farc, l2, inv, od);
#pragma unroll
        for (int dh = 0; dh < 2; ++dh)
#pragma unroll
            for (int r = 0; r < 16; ++r) stash[(dh * 16 + r) * 512] = gate0 * od[dh][r];
    }
    {
        const int q = tid >> 3, part = tid & 7;
        unsigned m16 = 0u;
        if (c >= 16) {
            unsigned key[16];
#pragma unroll
            for (int jj = 0; jj < 16; ++jj) { const int j = part * 16 + jj; key[jj] = (j >= 1 && j <= c - 2) ? (__float_as_uint(imp[q * 128 + j]) + 1u) : 0u; }
            unsigned T = 0u;
            for (int bit = 31; bit >= 0; --bit) {
                const unsigned cand = T | (1u << bit);
                int cnt = 0;
#pragma unroll
                for (int jj = 0; jj < 16; ++jj) cnt += key[jj] >= cand ? 1 : 0;
                cnt += __shfl_xor(cnt, 1); cnt += __shfl_xor(cnt, 2); cnt += __shfl_xor(cnt, 4);
                if (cnt >= 13) T = cand;
            }
            int gt = 0, eq = 0;
#pragma unroll
            for (int jj = 0; jj < 16; ++jj) { gt += key[jj] > T ? 1 : 0; eq += key[jj] == T ? 1 : 0; }
            int gtot = gt; gtot += __shfl_xor(gtot, 1); gtot += __shfl_xor(gtot, 2); gtot += __shfl_xor(gtot, 4);
            int pre = 0;
#pragma unroll
            for (int pp = 0; pp < 8; ++pp) { const int e = __shfl(eq, (lane & ~7) + pp); if (pp < part) pre += e; }
            int quota = 13 - gtot - pre; quota = quota < 0 ? 0 : quota;
#pragma unroll
            for (int jj = 0; jj < 16; ++jj) {
                bool s = key[jj] > T;
                if (key[jj] == T && T != 0u) { if (quota > 0) { s = true; --quota; } }
                m16 |= s ? (1u << jj) : 0u;
            }
        }
        unsigned wd = m16 << (16 * (part & 1));
        wd |= __shfl_xor(wd, 1);
        const int wi = part >> 1;
        if (c >= 16) {
            if (wi == 0) wd |= 1u;
            if (((c - 1) >> 5) == wi) wd |= 1u << ((c - 1) & 31);
            if ((c >> 5) == wi) wd |= 1u << (c & 31);
        } else {
            wd = (wi == 0) ? ((c >= 31) ? 0xffffffffu : ((2u << c) - 1u)) : 0u;
        }
        if ((part & 1) == 0) { selm[q * 4 + wi] = wd; __hip_atomic_fetch_or(&uni[wi], wd, __ATOMIC_RELAXED, __HIP_MEMORY_SCOPE_WORKGROUP); }
    }
    __syncthreads();
    {
        if (tid < 128) { const int j = tid; const unsigned uw = uni[j >> 5];
            if ((uw >> (j & 31)) & 1u) { int pos = __popc(uw & ((1u << (j & 31)) - 1u)); for (int k2 = 0; k2 < (j >> 5); ++k2) pos += __popc(uni[k2]); tlist[pos] = j; } }
        if (tid == 0) misc[1] = __popc(uni[0]) + __popc(uni[1]) + __popc(uni[2]) + __popc(uni[3]);
    }
    __syncthreads();
    {
        const int nts = misc[1];
        float l = 0.f; f32x16 od[2]; od[0] = f32x16{}; od[1] = f32x16{};
        eng_branch<2>(lds, P.KSN + (size_t)bg * SEQ * 64, P.VST + (size_t)bg * 128 * 4096, nts, c, tid, lane, hl, qh, qr, farc, l, 0.f, od);
        l += __shfl_xor(l, 32);
        const float sc = gate1 / l;
#pragma unroll
        for (int dh = 0; dh < 2; ++dh)
#pragma unroll
            for (int r = 0; r < 16; ++r) stash[(dh * 16 + r) * 512] += sc * od[dh][r];
    }
    {
        const int ntw = c < 8 ? c + 1 : 9;
        float l = 0.f; f32x16 od[2]; od[0] = f32x16{}; od[1] = f32x16{};
        eng_branch<3>(lds, P.KWN + (size_t)bg * SEQ * 64, P.VWT + (size_t)bg * 128 * 4096, ntw, c, tid, lane, hl, qh, qr, farc, l, 0.f, od);
        l += __shfl_xor(l, 32);
        const float sc = gate2 / l;
        bf16* yp = P.YA + row * 512 + head * 64;
#pragma unroll
        for (int dh = 0; dh < 2; ++dh)
#pragma unroll
            for (int a = 0; a < 4; ++a) {
                float y4[4];
#pragma unroll
                for (int i = 0; i < 4; ++i) y4[i] = stash[(dh * 16 + 4 * a + i) * 512] + sc * od[dh][4 * a + i];
                u32x2 v; v.x = cvtpk(y4[0], y4[1]); v.y = cvtpk(y4[2], y4[3]);
                *(u32x2*)(yp + 32 * dh + 8 * a + 4 * hi) = v;
            }
    }
}
struct Args { const float* in[26]; float* out; unsigned char* ws; int ph_lo, ph_hi; };

__global__ void __launch_bounds__(NWAVES * 64, 2) mk_fwd(Args args) {
    extern __shared__ __attribute__((aligned(16))) unsigned char lds_raw[];
    LAS unsigned char* lds = (LAS unsigned char*)lds_raw;
    const int tid = threadIdx.x, lane = tid & 63, wave = __builtin_amdgcn_readfirstlane(tid >> 6);
    const int G = gridDim.x; const int bx = blockIdx.x;
    const int vcu = (G % 8 == 0) ? (bx % 8) * (G / 8) + bx / 8 : bx;
    unsigned char* ws = args.ws;
    const float* x = args.in[0];
    bf16* WinT = (bf16*)(ws + WS_WIN); bf16* WaT = (bf16*)(ws + WS_WA); bf16* WbT = (bf16*)(ws + WS_WB); bf16* WoT = (bf16*)(ws + WS_WO);
    bf16* W1T = (bf16*)(ws + WS_W1); bf16* W2T = (bf16*)(ws + WS_W2);
    bf16* XN = (bf16*)(ws + WS_XN); bf16* QN = (bf16*)(ws + WS_QN); bf16* KV = (bf16*)(ws + WS_KV); bf16* ML = (bf16*)(ws + WS_ML); bf16* GB = (bf16*)(ws + WS_G);
    float* SB = (float*)(ws + WS_S); bf16* YA = (bf16*)(ws + WS_YA); bf16* YB = (bf16*)(ws + WS_YB); bf16* MX = (bf16*)(ws + WS_MX); bf16* UB = (bf16*)(ws + WS_U);
    float* rowss = (float*)(ws + WS_CTL + CTL_ROWSS);
    bf16* CK1T = (bf16*)(ws + WS_CK1); bf16* CV1T = (bf16*)(ws + WS_CV1); bf16* CK2T = (bf16*)(ws + WS_SMALL); bf16* CV2T = (bf16*)(ws + WS_SMALL + 32768);
    float* B1K = (float*)(ws + WS_SMALL + 65536); float* B1V = (float*)(ws + WS_SMALL + 65536 + 1024); float* BOUNDS = (float*)(ws + WS_SMALL + 65536 + 2048);
    bf16* KSN = (bf16*)(ws + WS_KSN); bf16* KWN = (bf16*)(ws + WS_KWN); bf16* VST = (bf16*)(ws + WS_VST); bf16* VWT = (bf16*)(ws + WS_VWT); bf16* KCN = (bf16*)(ws + WS_KCN); bf16* VCT = (bf16*)(ws + WS_VCT);
    const int lo = args.ph_lo, hi = args.ph_hi;
#define IN(k) (lo <= (k) && (k) < hi)

    if (IN(0)) {
        LAS float* scr = (LAS float*)(lds + wave * 16384);
        const int gw = vcu * NWAVES + wave, NGW = G * NWAVES;
        constexpr int I_IN = (1024 / 64) * (NP_PAD / 32), I_A = (512 / 64) * (1024 / 32), I_O = (1024 / 64) * (1024 / 32), I_1 = (1024 / 64) * (4096 / 32), I_2 = (4096 / 64) * (1024 / 32);
        constexpr int I_C1 = (2048 / 64) * (256 / 32), I_C2 = (256 / 64) * (64 / 32), I_B1 = 512;
        constexpr int NITEMS = I_IN + 2 * I_A + I_O + I_1 + I_2 + 2 * I_C1 + 2 * I_C2 + I_B1 + 1;
        for (int it = gw; it < NITEMS; it += NGW) {
            int r = it;
            if (r < I_IN) { transpose_item<true>(args.in[2], 1024, D_PROJ, args.in[1], WinT, NP_PAD, scr, r, lane); continue; } r -= I_IN;
            if (r < I_A) { transpose_item<false>(args.in[20], 512, 1024, nullptr, WaT, 1024, scr, r, lane); continue; } r -= I_A;
            if (r < I_A) { transpose_item<false>(args.in[21], 512, 1024, nullptr, WbT, 1024, scr, r, lane); continue; } r -= I_A;
            if (r < I_O) { transpose_item<false>(args.in[22], 1024, 1024, nullptr, WoT, 1024, scr, r, lane); continue; } r -= I_O;
            if (r < I_1) { transpose_item<false>(args.in[24], 1024, 4096, args.in[23], W1T, 4096, scr, r, lane); continue; } r -= I_1;
            if (r < I_2) { transpose_item<false>(args.in[25], 4096, 1024, nullptr, W2T, 1024, scr, r, lane); continue; } r -= I_2;
            if (r < I_C1) { transpose_item<false>(args.in[6], 2048, 256, nullptr, CK1T, 256, scr, r, lane); continue; } r -= I_C1;
            if (r < I_C1) { transpose_item<false>(args.in[11], 2048, 256, nullptr, CV1T, 256, scr, r, lane); continue; } r -= I_C1;
            if (r < I_C2) { transpose_item<false>(args.in[8], 256, 64, nullptr, CK2T, 64, scr, r, lane); continue; } r -= I_C2;
            if (r < I_C2) { transpose_item<false>(args.in[13], 256, 64, nullptr, CV2T, 64, scr, r, lane); continue; } r -= I_C2;
            if (r < I_B1) {
                const int kv = r >> 8, u = r & 255; const float* pos = args.in[kv ? 10 : 5]; const float* w1 = args.in[kv ? 11 : 6]; const float* b1 = args.in[kv ? 12 : 7];
                float a = 0.f;
                for (int i = lane; i < 2048; i += 64) a += pos[i] * w1[(size_t)i * 256 + u];
                a = wave_sum(a);
                if (lane == 0) (kv ? B1V : B1K)[u] = a + b1[u];
                continue; } r -= I_B1;
            {
                float gq = fabsf(args.in[3][lane]); float gk = fmaxf(fmaxf(fabsf(args.in[4][lane]), fabsf(args.in[4][64 + lane])), fabsf(args.in[4][128 + lane]));
                gq = wave_max(gq); gk = wave_max(gk);
                if (lane < 8) { float mb = -1e30f; for (int bk = 0; bk < 32; ++bk) mb = fmaxf(mb, args.in[15][bk * 8 + lane]); BOUNDS[lane] = 8.f * gq * gk + mb; }
            }
        }
        for (int m = gw; m < NTOK; m += NGW) rms_row_to_bf16(x + (size_t)m * D_MODEL, XN + (size_t)m * D_MODEL, lane);
    }
    if (IN(1)) {
        pg8::Gemm g{XN, WinT, NTOK, NP_PAD, 1024}; pg8::StaticOrder S; S.init(NTOK, NP_PAD, G, bx);
        pg8::EpiProj E{QN, KV, ML, GB, SB};
        pg8::gemm_phase<pg8::EpiProj, pg8::StaticOrder, true, true>(lds, g, S, E);
    }
    if (IN(2)) {
        LAS unsigned short* scr = (LAS unsigned short*)(lds + wave * 16384);
        const int gw = vcu * NWAVES + wave, NGW = G * NWAVES;
        const float* kgain = args.in[4];
        for (int it = gw; it < 4096; it += NGW) {
            const int kind = it & 3, bgj = it >> 2, bg = bgj >> 7, j = bgj & 127, b = bg >> 1, g = bg & 1;
            const size_t tok0 = (size_t)b * SEQ + 64 * j;
            if (kind == 0) knorm_item(KV, 256 + 64 * g, kgain + 64, KSN + ((size_t)bg * SEQ + 64 * j) * 64, tok0, lane);
            else if (kind == 1) knorm_item(KV, 512 + 64 * g, kgain + 128, KWN + ((size_t)bg * SEQ + 64 * j) * 64, tok0, lane);
            else if (kind == 2) vtrans_item(KV, 384 + 64 * g, VST + ((size_t)bg * 128 + j) * 4096, tok0, scr, lane);
            else vtrans_item(KV, 640 + 64 * g, VWT + ((size_t)bg * 128 + j) * 4096, tok0, scr, lane);
        }
        __syncthreads();
        for (int u = bx; u < 128; u += G) {
            const int kvs = u & 1;
            compress_unit(u, KV, kvs ? CV1T : CK1T, kvs ? CV2T : CK2T, kvs ? B1V : B1K, args.in[kvs ? 14 : 9], kgain, KCN, VCT, lds, tid);
        }
    }
    if (IN(3)) {
        EngPtrs P{QN, KCN, VCT, KSN, VST, KWN, VWT, SB, args.in[15], args.in[3], BOUNDS, YA};
        unsigned* qctr = (unsigned*)(ws + WS_CTL + CTL_QCTR);
        LAS int* misc = (LAS int*)(lds + ENG_MISC);
        for (;;) {
            __syncthreads();
            if (tid == 0) misc[0] = (int)atomicAdd(qctr, 1u);
            __syncthreads();
            const int u = misc[0];
            if (u >= 1024) break;
            eng_unit(u, P, lds, tid);
        }
    }
    if (IN(4)) {
        pg8::Gemm g{YA, WaT, NTOK, 1024, 512}; pg8::StaticOrder S; S.init(NTOK, 1024, G, bx);
        pg8::EpiGate<false> E{GB, 0, MX};
        pg8::gemm_phase<pg8::EpiGate<false>, pg8::StaticOrder, true, true>(lds, g, S, E);
    }
    if (IN(5)) {
        pg8::Gemm g{YB, WbT, NTOK, 1024, 512}; pg8::StaticOrder S; S.init(NTOK, 1024, G, bx);
        pg8::EpiGate<true> E{GB, 1024, MX};
        pg8::gemm_phase<pg8::EpiGate<true>, pg8::StaticOrder, true, true>(lds, g, S, E);
    }
    if (IN(6)) {
        pg8::Gemm g{MX, WoT, NTOK, 1024, 1024}; pg8::StaticOrder S; S.init(NTOK, 1024, G, bx);
        pg8::EpiOut E{x, args.out, XN, rowss};
        pg8::gemm_phase<pg8::EpiOut, pg8::StaticOrder, true, true>(lds, g, S, E);
    }
    if (IN(7)) {
        pg8::Gemm g{XN, W1T, NTOK, 4096, 1024}; pg8::StaticOrder S; S.init(NTOK, 4096, G, bx);
        pg8::EpiFF1 E{rowss, UB};
        pg8::gemm_phase<pg8::EpiFF1, pg8::StaticOrder, true, true>(lds, g, S, E);
    }
    if (IN(8)) {
        pg8::Gemm g{UB, W2T, NTOK, 1024, 4096}; pg8::StaticOrder S; S.init(NTOK, 1024, G, bx);
        pg8::EpiFF2 E{args.out};
        pg8::gemm_phase<pg8::EpiFF2, pg8::StaticOrder, true, true>(lds, g, S, E);
    }
#undef IN
}
constexpr int C_NQ = 0, C_NKC = 512, C_NVC = 640, C_NKS = 768, C_NVS = 896, C_NKW = 1024, C_NVW = 1152, C_NGATE = 1280;
constexpr int C_MQ = 1304, C_MG = 3360;
constexpr int NSA_W = 1304;
constexpr int ML_W = 2056;
constexpr int P_MQ = 0, P_MK = 512, P_MV = 1024, P_MI = 1536, P_MF = 1540, P_MO = 1544;
constexpr int NCMP = 511, NSLC = 128;

__device__ const unsigned char BUCKET_TAB[129] = {0, 1, 2, 3, 4, 5, 6, 7, 8, 9, 10, 11, 12, 13, 14, 15, 16, 16, 16, 17, 17, 18, 18, 18, 19, 19, 19, 20, 20, 20, 20, 21, 21, 21, 21, 22, 22, 22, 22, 22, 23, 23, 23, 23, 23, 23, 24, 24, 24, 24, 24, 24, 25, 25, 25, 25, 25, 25, 25, 26, 26, 26, 26, 26, 26, 26, 26, 27, 27, 27, 27, 27, 27, 27, 27, 27, 27, 28, 28, 28, 28, 28, 28, 28, 28, 28, 28, 29, 29, 29, 29, 29, 29, 29, 29, 29, 29, 29, 29, 30, 30, 30, 30, 30, 30, 30, 30, 30, 30, 30, 30, 30, 30, 31, 31, 31, 31, 31, 31, 31, 31, 31, 31, 31, 31, 31, 31, 31, 31};
__device__ __forceinline__ int t5_bucket(int dist) { return dist >= 128 ? 31 : (int)BUCKET_TAB[dist < 0 ? 0 : dist]; }

__device__ __forceinline__ float sigmoidf_(float x) { return 1.f / (1.f + expf(-x)); }

__global__ __launch_bounds__(256) void rowstat_k(const float* __restrict__ x, float* __restrict__ rstd, int rows) {
    const int w = (blockIdx.x * 256 + threadIdx.x) >> 6, lane = threadIdx.x & 63;
    if (w >= rows) return;
    const float4* p = (const float4*)(x + (size_t)w * D_MODEL);
    float s = 0.f;
#pragma unroll
    for (int j = 0; j < 4; ++j) { const float4 v = p[lane + 64 * j]; s += v.x * v.x + v.y * v.y + v.z * v.z + v.w * v.w; }
    s = wave_sum(s);
    if (lane == 0) rstd[w] = 1.f / sqrtf(s * (1.f / D_MODEL) + 1e-6f);
}

template <int EPI>
__global__ __launch_bounds__(256) void gemm_f32(const float* __restrict__ A, int lda, const float* __restrict__ gk, const float* __restrict__ Bm, int ldb,
                                                float* C, int ldc, const float* __restrict__ rs, const float* T2, int ldt, int M, int N, int K) {
    __shared__ __attribute__((aligned(16))) float As[16][68];
    __shared__ __attribute__((aligned(16))) float Bs[16][68];
    const int tid = threadIdx.x, tx = tid & 15, ty = tid >> 4;
    const int m0 = blockIdx.y * 64, n0 = blockIdx.x * 64;
    float acc[4][4];
#pragma unroll
    for (int i = 0; i < 4; ++i)
#pragma unroll
        for (int j = 0; j < 4; ++j) acc[i][j] = 0.f;
    for (int k0 = 0; k0 < K; k0 += 16) {
        {
            const int r = tid >> 2, kq = (tid & 3) * 4;
            float4 v = *(const float4*)(A + (size_t)(m0 + r) * lda + k0 + kq);
            if (gk) { const float4 g = *(const float4*)(gk + k0 + kq); v.x *= g.x; v.y *= g.y; v.z *= g.z; v.w *= g.w; }
            As[kq + 0][r] = v.x; As[kq + 1][r] = v.y; As[kq + 2][r] = v.z; As[kq + 3][r] = v.w;
        }
        {
            const int kr = tid >> 4, nq = (tid & 15) * 4;
            float4 v = make_float4(0.f, 0.f, 0.f, 0.f);
            if (n0 + nq < N) v = *(const float4*)(Bm + (size_t)(k0 + kr) * ldb + n0 + nq);
            *(float4*)&Bs[kr][nq] = v;
        }
        __syncthreads();
#pragma unroll
        for (int k = 0; k < 16; ++k) {
            const float4 a = *(const float4*)&As[k][ty * 4];
            const float4 b = *(const float4*)&Bs[k][tx * 4];
            acc[0][0] += a.x * b.x; acc[0][1] += a.x * b.y; acc[0][2] += a.x * b.z; acc[0][3] += a.x * b.w;
            acc[1][0] += a.y * b.x; acc[1][1] += a.y * b.y; acc[1][2] += a.y * b.z; acc[1][3] += a.y * b.w;
            acc[2][0] += a.z * b.x; acc[2][1] += a.z * b.y; acc[2][2] += a.z * b.z; acc[2][3] += a.z * b.w;
            acc[3][0] += a.w * b.x; acc[3][1] += a.w * b.y; acc[3][2] += a.w * b.z; acc[3][3] += a.w * b.w;
        }
        __syncthreads();
    }
#pragma unroll
    for (int i = 0; i < 4; ++i) {
        const int m = m0 + ty * 4 + i;
        const float sc = rs ? rs[m] : 1.f;
#pragma unroll
        for (int j = 0; j < 4; ++j) {
            const int n = n0 + tx * 4 + j;
            if (n < N) {
                const float v = acc[i][j] * sc;
                float* cp = C + (size_t)m * ldc + n;
                if (EPI == 0) *cp = v;
                else if (EPI == 1) *cp = T2[(size_t)m * ldt + n] + v;
                else if (EPI == 2) { const float r = fmaxf(v, 0.f); *cp = r * r; }
                else if (EPI == 3) *cp = sigmoidf_(v) * (*cp);
                else *cp = *cp + sigmoidf_(v) * T2[(size_t)m * ldt + n];
            }
        }
    }
}

__global__ __launch_bounds__(256) void nsa_norm_k(float* PA, const float* __restrict__ qg, const float* __restrict__ kg) {
    const int w = (blockIdx.x * 256 + threadIdx.x) >> 6, lane = threadIdx.x & 63;
    const int row = w / 12, v = w % 12;
    if (row >= NTOK) return;
    int col; const float* gain; float sc = 1.f;
    if (v < 8) { col = C_NQ + v * 64; gain = qg; sc = 0.125f; }
    else if (v < 10) { col = C_NKS + (v - 8) * 64; gain = kg + 64; }
    else { col = C_NKW + (v - 10) * 64; gain = kg + 128; }
    float* p = PA + (size_t)row * NSA_W + col + lane;
    const float x = *p;
    const float ss = wave_sum(x * x);
    *p = x * (1.f / sqrtf(ss * (1.f / 64.f) + 1e-6f)) * gain[lane] * sc;
}

__global__ __launch_bounds__(256) void compress_k(const float* __restrict__ PA, int coloff, const float* __restrict__ pos, const float* __restrict__ w1, const float* __restrict__ b1,
                                                  const float* __restrict__ w2, const float* __restrict__ b2, const float* __restrict__ gain, float* __restrict__ out) {
    __shared__ float in[2048];
    __shared__ float hid[256];
    const int tid = threadIdx.x, blk = blockIdx.x;
    const int g = blk & 1, n = (blk >> 1) % NCMP, b = (blk >> 1) / NCMP;
    for (int i = tid; i < 2048; i += 256) { const int j = i >> 6, d = i & 63; in[i] = PA[(size_t)(b * SEQ + 16 * n + j) * NSA_W + coloff + g * 64 + d] + pos[i]; }
    __syncthreads();
    float a = b1[tid];
    for (int i = 0; i < 2048; ++i) a += in[i] * w1[(size_t)i * 256 + tid];
    { const float x = a; const float u = 0.7978845608028654f * (x + 0.044715f * x * x * x); hid[tid] = 0.5f * x * (1.f + tanhf(u)); }
    __syncthreads();
    if (tid < 64) {
        float o = b2[tid];
        for (int u = 0; u < 256; ++u) o += hid[u] * w2[u * 64 + tid];
        if (gain) { const float ss = wave_sum(o * o); o = o * (1.f / sqrtf(ss * (1.f / 64.f) + 1e-6f)) * gain[tid]; }
        out[((size_t)(b * NCMP + n) * 2 + g) * 64 + tid] = o;
    }
}

__global__ __launch_bounds__(256) void nsa_cmp_k(const float* __restrict__ PA, const float* __restrict__ kcmp, const float* __restrict__ vcmp, const float* __restrict__ rel,
                                                 float* __restrict__ ya, int* __restrict__ selidx) {
    __shared__ float q[256];
    __shared__ float p[4][512];
    __shared__ float Psum[512];
    __shared__ float sc[128];
    const int tid = threadIdx.x, lane = tid & 63, hw = tid >> 6;
    const int bt = blockIdx.x >> 1, g = blockIdx.x & 1, b = bt / SEQ, t = bt % SEQ, c = t >> 6;
    q[tid] = PA[(size_t)bt * NSA_W + C_NQ + g * 256 + tid];
    __syncthreads();
    const int nvalid = (t >= 31) ? ((t - 31) / 16 + 1) : 0;
    for (int n = tid; n < 512; n += 256) {
        float s0 = -INFINITY, s1 = -INFINITY, s2 = -INFINITY, s3 = -INFINITY;
        if (n < nvalid) {
            const float* kr = kcmp + ((size_t)(b * NCMP + n) * 2 + g) * 64;
            float a0 = 0.f, a1 = 0.f, a2 = 0.f, a3 = 0.f;
            for (int d = 0; d < 64; ++d) { const float kv = kr[d]; a0 += q[d] * kv; a1 += q[64 + d] * kv; a2 += q[128 + d] * kv; a3 += q[192 + d] * kv; }
            const int bk = t5_bucket(t - (16 * n + 31));
            s0 = a0 + rel[bk * 8 + 4 * g + 0]; s1 = a1 + rel[bk * 8 + 4 * g + 1]; s2 = a2 + rel[bk * 8 + 4 * g + 2]; s3 = a3 + rel[bk * 8 + 4 * g + 3];
        }
        p[0][n] = s0; p[1][n] = s1; p[2][n] = s2; p[3][n] = s3;
    }
    __syncthreads();
    {
        float m = -INFINITY;
        for (int n = lane; n < nvalid; n += 64) m = fmaxf(m, p[hw][n]);
        m = wave_max(m);
        if (nvalid == 0) m = 0.f;
        float sum = 0.f;
        for (int n = lane; n < 512; n += 64) { const float e = (n < nvalid) ? expf(p[hw][n] - m) : 0.f; p[hw][n] = e; sum += e; }
        sum = wave_sum(sum);
        const float inv = 1.f / fmaxf(sum, 1e-30f);
        for (int n = lane; n < 512; n += 64) p[hw][n] *= inv;
    }
    __syncthreads();
    {
        float o = 0.f;
        for (int n = 0; n < nvalid; ++n) o += p[hw][n] * vcmp[((size_t)(b * NCMP + n) * 2 + g) * 64 + lane];
        const float gate = sigmoidf_(PA[(size_t)bt * NSA_W + C_NGATE + (4 * g + hw) * 3 + 0]);
        ya[(size_t)bt * 512 + (4 * g + hw) * 64 + lane] = gate * o;
    }
    for (int n = tid; n < 512; n += 256) Psum[n] = (n < NCMP) ? ((p[0][n] + p[1][n]) + (p[2][n] + p[3][n])) : 0.f;
    __syncthreads();
    if (tid < 128) {
        const int j = tid;
        float im = 0.f;
        for (int n = 4 * j - 1; n <= 4 * j + 3; ++n) if (n >= 0 && n < NCMP) im += Psum[n];
        float s;
        if (j == 0 || j == c || j == c - 1) s = 1e4f; else if (j <= c) s = im; else s = -1.f;
        sc[j] = s;
    }
    __syncthreads();
    if (tid < 128) {
        const int j = tid; const float s = sc[j]; int rank = 0;
        for (int i = 0; i < 128; ++i) { const float si = sc[i]; rank += ((si > s) || (si == s && i < j)) ? 1 : 0; }
        if (rank < 16) selidx[((size_t)bt * 2 + g) * 16 + rank] = j;
    }
}

template <int MODE>
__global__ __launch_bounds__(256) void nsa_kv_k(const float* __restrict__ PA, const float* __restrict__ rel, const int* __restrict__ selidx, float* __restrict__ ya) {
    constexpr int NK = MODE == 0 ? 1024 : 512;
    constexpr int KOFF = MODE == 0 ? C_NKS : C_NKW, VOFF = MODE == 0 ? C_NVS : C_NVW;
    __shared__ float q[256];
    __shared__ float s[4][NK];
    __shared__ int sel[16];
    const int tid = threadIdx.x, lane = tid & 63, hw = tid >> 6;
    const int bt = blockIdx.x >> 1, g = blockIdx.x & 1, b = bt / SEQ, t = bt % SEQ;
    q[tid] = PA[(size_t)bt * NSA_W + C_NQ + g * 256 + tid];
    if (MODE == 0 && tid < 16) sel[tid] = selidx[((size_t)bt * 2 + g) * 16 + tid];
    __syncthreads();
    for (int m = tid; m < NK; m += 256) {
        const int pos = (MODE == 0) ? (sel[m >> 6] * 64 + (m & 63)) : (t - 511 + m);
        float s0 = -INFINITY, s1 = -INFINITY, s2 = -INFINITY, s3 = -INFINITY;
        if (pos >= 0 && pos <= t) {
            const float4* kr = (const float4*)(PA + (size_t)(b * SEQ + pos) * NSA_W + KOFF + g * 64);
            float a0 = 0.f, a1 = 0.f, a2 = 0.f, a3 = 0.f;
            for (int d4 = 0; d4 < 16; ++d4) {
                const float4 kv = kr[d4]; const int d = d4 * 4;
                a0 += q[d] * kv.x + q[d + 1] * kv.y + q[d + 2] * kv.z + q[d + 3] * kv.w;
                a1 += q[64 + d] * kv.x + q[64 + d + 1] * kv.y + q[64 + d + 2] * kv.z + q[64 + d + 3] * kv.w;
                a2 += q[128 + d] * kv.x + q[128 + d + 1] * kv.y + q[128 + d + 2] * kv.z + q[128 + d + 3] * kv.w;
                a3 += q[192 + d] * kv.x + q[192 + d + 1] * kv.y + q[192 + d + 2] * kv.z + q[192 + d + 3] * kv.w;
            }
            const int bk = t5_bucket(t - pos);
            s0 = a0 + rel[bk * 8 + 4 * g + 0]; s1 = a1 + rel[bk * 8 + 4 * g + 1]; s2 = a2 + rel[bk * 8 + 4 * g + 2]; s3 = a3 + rel[bk * 8 + 4 * g + 3];
        }
        s[0][m] = s0; s[1][m] = s1; s[2][m] = s2; s[3][m] = s3;
    }
    __syncthreads();
    {
        float mx = -INFINITY;
        for (int m = lane; m < NK; m += 64) mx = fmaxf(mx, s[hw][m]);
        mx = wave_max(mx);
        float sum = 0.f;
        for (int m = lane; m < NK; m += 64) { const float e = expf(s[hw][m] - mx); s[hw][m] = e; sum += e; }
        sum = wave_sum(sum);
        const float inv = 1.f / fmaxf(sum, 1e-30f);
        for (int m = lane; m < NK; m += 64) s[hw][m] *= inv;
    }
    __syncthreads();
    {
        float o = 0.f;
        for (int m = 0; m < NK; ++m) {
            const float pm = s[hw][m];
            if (pm != 0.f) {
                const int pos = (MODE == 0) ? (sel[m >> 6] * 64 + (m & 63)) : (t - 511 + m);
                o += pm * PA[(size_t)(b * SEQ + pos) * NSA_W + VOFF + g * 64 + lane];
            }
        }
        const float gate = sigmoidf_(PA[(size_t)bt * NSA_W + C_NGATE + (4 * g + hw) * 3 + (MODE == 0 ? 1 : 2)]);
        ya[(size_t)bt * 512 + (4 * g + hw) * 64 + lane] += gate * o;
    }
}

__global__ __launch_bounds__(256) void ml_conv_k(const float* __restrict__ PB, const float* __restrict__ cw, const float* __restrict__ cb, float* __restrict__ qkc) {
    const size_t idx = (size_t)blockIdx.x * 256 + threadIdx.x;
    const int row = (int)(idx >> 10), c = (int)(idx & 1023), t = row % SEQ;
    float a = cb[c];
#pragma unroll
    for (int j = 0; j < 4; ++j) { const int tt = t - 3 + j; if (tt >= 0) a += PB[(size_t)(row - 3 + j) * ML_W + c] * cw[j * 1024 + c]; }
    float y = a / (1.f + expf(-a));
    if (c < 512) y *= 0.08838834764831845f;
    qkc[idx] = y;
}

__global__ __launch_bounds__(64) void ml_gates_k(const float* __restrict__ PB, const float* __restrict__ ib, const float* __restrict__ fb, double* __restrict__ uD, double* __restrict__ aD, float* __restrict__ mr) {
    const int bh = blockIdx.x, b = bh >> 2, h = bh & 3, lane = threadIdx.x;
    const int t0 = lane * 128;
    const float fbias = fb[h], ibias = ib[h];
    double loc = 0.0;
    for (int i = 0; i < 128; ++i) {
        const float f = PB[(size_t)(b * SEQ + t0 + i) * ML_W + P_MF + h] + fbias;
        const float lf = fminf(f, 0.f) - log1pf(expf(-fabsf(f)));
        loc += (double)lf;
    }
    double inc = loc;
#pragma unroll
    for (int o = 1; o < 64; o <<= 1) { const double v = __shfl_up(inc, o); if (lane >= o) inc += v; }
    const double base = inc - loc;
    double run = base, lmax = -1e300;
    for (int i = 0; i < 128; ++i) {
        const size_t r = (size_t)(b * SEQ + t0 + i) * ML_W;
        const float f = PB[r + P_MF + h] + fbias;
        const float lf = fminf(f, 0.f) - log1pf(expf(-fabsf(f)));
        run += (double)lf;
        const double u = (double)(PB[r + P_MI + h] + ibias) - run;
        uD[(size_t)bh * SEQ + t0 + i] = u;
        lmax = fmax(lmax, u);
    }
    double pm = lmax;
#pragma unroll
    for (int o = 1; o < 64; o <<= 1) { const double v = __shfl_up(pm, o); if (lane >= o) pm = fmax(pm, v); }
    double prev = __shfl_up(pm, 1); if (lane == 0) prev = 0.0;
    double a = fmax(prev, 0.0);
    run = base;
    for (int i = 0; i < 128; ++i) {
        const size_t r = (size_t)(b * SEQ + t0 + i) * ML_W;
        const float f = PB[r + P_MF + h] + fbias;
        const float lf = fminf(f, 0.f) - log1pf(expf(-fabsf(f)));
        run += (double)lf;
        const double u = uD[(size_t)bh * SEQ + t0 + i];
        a = fmax(a, u);
        aD[(size_t)bh * SEQ + t0 + i] = a;
        mr[(size_t)bh * SEQ + t0 + i] = (float)(run + a);
    }
}

__global__ __launch_bounds__(256) void ml_quad_k(const float* __restrict__ qkc, const float* __restrict__ PB, const double* __restrict__ uD, const double* __restrict__ aD,
                                                 const float* __restrict__ mr, float* __restrict__ yb) {
    __shared__ float Qs[64][65];
    __shared__ float Ks[64][65];
    __shared__ float Ws[64][65];
    __shared__ double us[64], as_[64];
    const int tid = threadIdx.x, tx = tid & 15, ty = tid >> 4;
    const int it = blockIdx.x, h = blockIdx.y, b = blockIdx.z, bh = b * 4 + h;
    const int i0 = it * 64;
    float num[2][4][4];
#pragma unroll
    for (int v = 0; v < 2; ++v)
#pragma unroll
        for (int a = 0; a < 4; ++a)
#pragma unroll
            for (int e = 0; e < 4; ++e) num[v][a][e] = 0.f;
    float den[4] = {0.f, 0.f, 0.f, 0.f};
    if (tid < 64) as_[tid] = aD[(size_t)bh * SEQ + i0 + tid];
    for (int jt = 0; jt <= it; ++jt) {
        const int j0 = jt * 64;
        float S[4][4];
#pragma unroll
        for (int a = 0; a < 4; ++a)
#pragma unroll
            for (int e = 0; e < 4; ++e) S[a][e] = 0.f;
        __syncthreads();
        if (tid < 64) us[tid] = uD[(size_t)bh * SEQ + j0 + tid];
        for (int dh = 0; dh < 2; ++dh) {
            if (dh) __syncthreads();
            for (int k = 0; k < 16; ++k) {
                const int r = (tid >> 6) + 4 * k, dd = tid & 63;
                Qs[r][dd] = qkc[(size_t)(b * SEQ + i0 + r) * 1024 + h * 128 + dh * 64 + dd];
                Ks[r][dd] = qkc[(size_t)(b * SEQ + j0 + r) * 1024 + 512 + h * 128 + dh * 64 + dd];
            }
            __syncthreads();
            for (int dd = 0; dd < 64; ++dd) {
                float qa[4], kb[4];
#pragma unroll
                for (int a = 0; a < 4; ++a) { qa[a] = Qs[ty * 4 + a][dd]; kb[a] = Ks[tx * 4 + a][dd]; }
#pragma unroll
                for (int a = 0; a < 4; ++a)
#pragma unroll
                    for (int e = 0; e < 4; ++e) S[a][e] += qa[a] * kb[e];
            }
        }
#pragma unroll
        for (int a = 0; a < 4; ++a)
#pragma unroll
            for (int e = 0; e < 4; ++e) {
                const int il = ty * 4 + a, jl = tx * 4 + e;
                float w = 0.f;
                if (j0 + jl <= i0 + il) w = S[a][e] * expf((float)(us[jl] - as_[il]));
                Ws[il][jl] = w;
            }
        for (int vh = 0; vh < 2; ++vh) {
            __syncthreads();
            for (int k = 0; k < 16; ++k) {
                const int r = (tid >> 6) + 4 * k, dd = tid & 63;
                Ks[r][dd] = PB[(size_t)(b * SEQ + j0 + r) * ML_W + P_MV + h * 128 + vh * 64 + dd];
            }
            __syncthreads();
            for (int jj = 0; jj < 64; ++jj) {
                float wa[4], vv[4];
#pragma unroll
                for (int a = 0; a < 4; ++a) { wa[a] = Ws[ty * 4 + a][jj]; vv[a] = Ks[jj][tx * 4 + a]; }
                if (vh == 0) {
#pragma unroll
                    for (int a = 0; a < 4; ++a) den[a] += wa[a];
                }
#pragma unroll
                for (int a = 0; a < 4; ++a)
#pragma unroll
                    for (int e = 0; e < 4; ++e) {
                        if (vh == 0) num[0][a][e] += wa[a] * vv[e]; else num[1][a][e] += wa[a] * vv[e];
                    }
            }
        }
    }
#pragma unroll
    for (int a = 0; a < 4; ++a) {
        const int i = i0 + ty * 4 + a;
        const float dn = fmaxf(fabsf(den[a]), expf(-mr[(size_t)bh * SEQ + i]));
#pragma unroll
        for (int v = 0; v < 2; ++v)
#pragma unroll
            for (int e = 0; e < 4; ++e) {
                const int col = h * 128 + v * 64 + tx * 4 + e;
                const float o = PB[(size_t)(b * SEQ + i) * ML_W + P_MO + col];
                yb[(size_t)(b * SEQ + i) * 512 + col] = sigmoidf_(o) * (num[v][a][e] / dn);
            }
    }
}

__device__ __forceinline__ float bf2f(bf16 v) { return __uint_as_float((unsigned)v << 16); }
__global__ __launch_bounds__(256) void unpack_nsa_k(const bf16* __restrict__ QN, const bf16* __restrict__ KV, const float* __restrict__ SB, float* __restrict__ PA, int row0) {
    const size_t idx = (size_t)blockIdx.x * 256 + threadIdx.x;
    if (idx >= (size_t)SEQ * NSA_W) return;
    const int t = (int)(idx / NSA_W), c = (int)(idx % NSA_W); const size_t row = (size_t)row0 + t;
    float v;
    if (c < 512) v = bf2f(QN[row * 512 + c]); else if (c < 1280) v = bf2f(KV[row * 768 + (c - 512)]); else v = SB[row * 32 + (c - 1280)];
    PA[idx] = v;
}
__global__ __launch_bounds__(256) void unpack_ml_k(const bf16* __restrict__ ML, const float* __restrict__ SB, float* __restrict__ PB, int row0) {
    const size_t idx = (size_t)blockIdx.x * 256 + threadIdx.x;
    if (idx >= (size_t)SEQ * ML_W) return;
    const int t = (int)(idx / ML_W), c = (int)(idx % ML_W); const size_t row = (size_t)row0 + t;
    float v;
    if (c < 1536) v = bf2f(ML[row * 2048 + c]); else if (c < 1540) v = SB[row * 32 + 24 + (c - 1536)]; else if (c < 1544) v = SB[row * 32 + 28 + (c - 1540)]; else v = bf2f(ML[row * 2048 + 1536 + (c - 1544)]);
    PB[idx] = v;
}
__global__ __launch_bounds__(256) void pack_y_k(const float* __restrict__ y32, bf16* __restrict__ yb, int row0) {
    const size_t idx = (size_t)blockIdx.x * 256 + threadIdx.x;
    yb[(size_t)row0 * 512 + idx] = (bf16)f2bf(y32[idx]);
}

static void launch_phase(hipStream_t st, Args a, int lo, int hi, int grid) {
    a.ph_lo = lo; a.ph_hi = hi;
    hipLaunchKernelGGL(mk_fwd, dim3(grid), dim3(NWAVES * 64), LDS_BYTES, st, a);
}

extern "C" void kernel_launch(void* const* d_in, const int* in_sizes, int n_in, void* d_out, int out_size, void* d_ws, size_t ws_size, hipStream_t stream) {
    static int grid = 0;
    if (grid == 0) {
        int dev = 0, cus = 0;
        if (hipGetDevice(&dev) != hipSuccess || hipDeviceGetAttribute(&cus, hipDeviceAttributeMultiprocessorCount, dev) != hipSuccess) { grid = -1; return; }
        if (hipFuncSetAttribute((const void*)mk_fwd, hipFuncAttributeMaxDynamicSharedMemorySize, LDS_BYTES) != hipSuccess) { fprintf(stderr, "hipFuncSetAttribute failed\n"); grid = -1; return; }
        if (ws_size < WS_END) { fprintf(stderr, "workspace too small: %zu < %zu\n", ws_size, (size_t)WS_END); grid = -1; return; }
        grid = cus;
    }
    if (grid < 0) return;
    (void)hipMemsetAsync((char*)d_ws + WS_CTL, 0, CTL_ZERO_BYTES, stream);
    Args a{};
    for (int i = 0; i < 26; ++i) a.in[i] = (const float*)d_in[i];
    a.out = (float*)d_out; a.ws = (unsigned char*)d_ws;
    char* ws = (char*)d_ws; float* out = (float*)d_out;
    launch_phase(stream, a, 0, 1, grid);
    launch_phase(stream, a, 1, 2, grid);
    launch_phase(stream, a, 2, 3, grid);
    launch_phase(stream, a, 3, 4, grid);
    const float* q_gain = (const float*)d_in[3]; const float* k_gain = (const float*)d_in[4];
    const float* rel = (const float*)d_in[15];
    const bf16* QN = (const bf16*)(ws + WS_QN); const bf16* KVb = (const bf16*)(ws + WS_KV); const bf16* MLb = (const bf16*)(ws + WS_ML); const float* SB = (const float*)(ws + WS_S);
    bf16* YA = (bf16*)(ws + WS_YA); bf16* YB = (bf16*)(ws + WS_YB);
    for (int b = 0; b < BATCH; ++b) {
        const int row0 = b * SEQ;
        float* y32 = (float*)(ws + 80 * MiB);
        float* PB = out; float* qkc = (float*)((char*)out + 66 * MiB);
        double* uD = (double*)(ws + 36 * MiB); double* aD = (double*)(ws + 37 * MiB); float* mrow = (float*)(ws + 38 * MiB);
        hipLaunchKernelGGL(unpack_ml_k, dim3((SEQ * ML_W + 255) / 256), dim3(256), 0, stream, MLb, SB, PB, row0);
        hipLaunchKernelGGL(ml_conv_k, dim3(SEQ * 1024 / 256), dim3(256), 0, stream, (const float*)PB, (const float*)d_in[16], (const float*)d_in[17], qkc);
        hipLaunchKernelGGL(ml_gates_k, dim3(4), dim3(64), 0, stream, (const float*)PB, (const float*)d_in[18], (const float*)d_in[19], uD, aD, mrow);
        hipLaunchKernelGGL(ml_quad_k, dim3(SEQ / 64, 4, 1), dim3(256), 0, stream, (const float*)qkc, (const float*)PB, (const double*)uD, (const double*)aD, (const float*)mrow, y32);
        hipLaunchKernelGGL(pack_y_k, dim3(SEQ * 512 / 256), dim3(256), 0, stream, (const float*)y32, YB, row0);
    }
    launch_phase(stream, a, 4, 5, grid);
    launch_phase(stream, a, 5, 6, grid);
    launch_phase(stream, a, 6, 7, grid);
    launch_phase(stream, a, 7, 8, grid);
    launch_phase(stream, a, 8, 9, grid);
}
```

```cpp
#include <hip/hip_runtime.h>
#include <cstdint>
#include <cstdio>
namespace pg8 {
#define PG8_LAS __attribute__((address_space(3)))
typedef unsigned short bf16_t;
typedef short bf16x8 __attribute__((ext_vector_type(8)));
typedef float f32x4 __attribute__((ext_vector_type(4)));
typedef unsigned u32x4 __attribute__((ext_vector_type(4)));
constexpr int BM = 256, BK = 64, HALF = 128, HTB = HALF * BK * 2  , STAGE_BYTES = 8 * HTB, NXCD = 8, WGM = 8;

__host__ __device__ __forceinline__ int lds_byte(int r, int c) { const int st = (r >> 4) * 2 + (c >> 5), rr = r & 15, cc = c & 31, ob = rr * 64 + cc * 2; return st * 1024 + (ob ^ (((ob >> 9) & 1) << 5)); }
__host__ __device__ __forceinline__ void stage_rc(int b, int& R, int& C) { const int st = b / 1024, sb = b % 1024, swz = sb ^ (((sb >> 9) & 1) << 5); R = (st >> 1) * 16 + swz / 64; C = (st & 1) * 32 + (swz % 64) / 2; }
__host__ __device__ __forceinline__ int perm32(int rho) { const int n = rho >> 4, i = rho & 15; return 8 * (i >> 2) + 4 * n + (i & 3); }

struct Unit { int pm, pn; };
struct Gemm { const bf16_t* A; const bf16_t* Bt; int M, N, K; };

struct StaticOrder {
    int nM, nN, nwg, G, c;
    __host__ __device__ void init(int M, int N, int G_, int c_) { nM = M / BM; nN = N / BM; nwg = nM * nN; G = G_; c = c_; }
    __host__ __device__ bool next(int i, Unit& u) const {
        const long L = (long)i * G + c; if (L >= nwg) return false;
        int wgid = (int)L; { const int q = nwg / NXCD, r = nwg % NXCD, xcd = wgid % NXCD, off = wgid / NXCD; wgid = (xcd < r ? xcd * (q + 1) : r * (q + 1) + (xcd - r) * q) + off; }
        const int nig = WGM * nN, gid = wgid / nig, fm = gid * WGM, gsz = (nM - fm) < WGM ? (nM - fm) : WGM;
        u.pm = fm + ((wgid % nig) % gsz); u.pn = (wgid % nig) / gsz; return true;
    }
    __device__ __forceinline__ void a_ready(const Unit&) const {}
    __device__ __forceinline__ void done(const Unit&) const {}
};
__device__ __forceinline__ unsigned cvt_pk_bf16(float lo, float hi) { unsigned r; asm volatile("v_cvt_pk_bf16_f32 %0, %1, %2" : "=v"(r) : "v"(lo), "v"(hi)); return r; }
__device__ __forceinline__ float bf_lo(unsigned w) { return __uint_as_float(w << 16); }
__device__ __forceinline__ float bf_hi(unsigned w) { return __uint_as_float(w & 0xffff0000u); }
__device__ __forceinline__ float fsigmoid(float v) { return __builtin_amdgcn_rcpf(1.f + __builtin_amdgcn_exp2f(-1.4426950408889634f * v)); }
__device__ __forceinline__ u32x4 pack8(const f32x4 v0, const f32x4 v1) { u32x4 w; w.x = cvt_pk_bf16(v0[0], v0[1]); w.y = cvt_pk_bf16(v0[2], v0[3]); w.z = cvt_pk_bf16(v1[0], v1[1]); w.w = cvt_pk_bf16(v1[2], v1[3]); return w; }

struct EpiProj {
    static constexpr bool PERM = true, AFTER_DRAIN = false;
    bf16_t *Qn, *KV, *ML, *G; float* S;
    __device__ __forceinline__ void operator()(const f32x4 (&acc)[2][2][4][2], const Unit& u, int wr, int wc, int fr, int fq) const {
        const int pn = u.pn, row0 = u.pm * BM + wr * 64 + fr;
        if (pn == 21) {
            if (wc == 0) {
#pragma unroll
                for (int ai = 0; ai < 2; ++ai)
#pragma unroll
                    for (int m = 0; m < 4; ++m) { float* p = S + (size_t)(row0 + ai * HALF + m * 16) * 32 + 8 * fq; *(f32x4*)p = acc[ai][0][m][0]; *(f32x4*)(p + 4) = acc[ai][0][m][1]; }
            }
            return;
        }
        bf16_t* base; int ld, ct; bool sig = false;
        if (pn < 2) { base = Qn; ld = 512; ct = pn; }
        else if (pn < 5) { base = KV; ld = 768; ct = pn - 2; }
        else if (pn < 13) { base = ML; ld = 2048; ct = pn - 5; }
        else { base = G; ld = 2048; ct = pn - 13; sig = true; }
        const int col0 = ct * 256 + wc * 32 + 8 * fq;
#pragma unroll
        for (int ai = 0; ai < 2; ++ai)
#pragma unroll
            for (int m = 0; m < 4; ++m) { bf16_t* rowp = base + (size_t)(row0 + ai * HALF + m * 16) * ld + col0;
#pragma unroll
                for (int bj = 0; bj < 2; ++bj) { f32x4 v0 = acc[ai][bj][m][0], v1 = acc[ai][bj][m][1];
                    if (sig) {
#pragma unroll
                        for (int i = 0; i < 4; ++i) { v0[i] = fsigmoid(v0[i]); v1[i] = fsigmoid(v1[i]); } }
                    *(u32x4*)(rowp + bj * HALF) = pack8(v0, v1); } }
    }
};
template <bool ACCUM> struct EpiGate {
    static constexpr bool PERM = true, AFTER_DRAIN = false;
    const bf16_t* G; int gcol0; bf16_t* Mx;
    __device__ __forceinline__ void operator()(const f32x4 (&acc)[2][2][4][2], const Unit& u, int wr, int wc, int fr, int fq) const {
        const int row0 = u.pm * BM + wr * 64 + fr, col0 = u.pn * BM + wc * 32 + 8 * fq;
#pragma unroll
        for (int ai = 0; ai < 2; ++ai)
#pragma unroll
            for (int m = 0; m < 4; ++m) { const size_t row = (size_t)(row0 + ai * HALF + m * 16);
#pragma unroll
                for (int bj = 0; bj < 2; ++bj) {
                    const u32x4 g = *(const u32x4*)(G + row * 2048 + gcol0 + col0 + bj * HALF);
                    f32x4 v0 = acc[ai][bj][m][0], v1 = acc[ai][bj][m][1];
                    v0[0] *= bf_lo(g.x); v0[1] *= bf_hi(g.x); v0[2] *= bf_lo(g.y); v0[3] *= bf_hi(g.y);
                    v1[0] *= bf_lo(g.z); v1[1] *= bf_hi(g.z); v1[2] *= bf_lo(g.w); v1[3] *= bf_hi(g.w);
                    bf16_t* mp = Mx + row * 1024 + col0 + bj * HALF;
                    if (ACCUM) { const u32x4 o = *(const u32x4*)mp;
                        v0[0] += bf_lo(o.x); v0[1] += bf_hi(o.x); v0[2] += bf_lo(o.y); v0[3] += bf_hi(o.y);
                        v1[0] += bf_lo(o.z); v1[1] += bf_hi(o.z); v1[2] += bf_lo(o.w); v1[3] += bf_hi(o.w); }
                    *(u32x4*)mp = pack8(v0, v1); } }
    }
};
struct EpiOut {
    static constexpr bool PERM = true, AFTER_DRAIN = false;
    const float* x; float* x1; bf16_t* x1b; float* rowss;
    __device__ __forceinline__ void operator()(const f32x4 (&acc)[2][2][4][2], const Unit& u, int wr, int wc, int fr, int fq) const {
        const int row0 = u.pm * BM + wr * 64 + fr, col0 = u.pn * BM + wc * 32 + 8 * fq;
#pragma unroll
        for (int ai = 0; ai < 2; ++ai)
#pragma unroll
            for (int m = 0; m < 4; ++m) { const size_t row = (size_t)(row0 + ai * HALF + m * 16); float ss = 0.f;
#pragma unroll
                for (int bj = 0; bj < 2; ++bj) { const size_t off = row * 1024 + col0 + bj * HALF;
                    const f32x4 v0 = acc[ai][bj][m][0] + *(const f32x4*)(x + off), v1 = acc[ai][bj][m][1] + *(const f32x4*)(x + off + 4);
                    *(f32x4*)(x1 + off) = v0; *(f32x4*)(x1 + off + 4) = v1; *(u32x4*)(x1b + off) = pack8(v0, v1);
                    ss += (v0[0] * v0[0] + v0[1] * v0[1]) + (v0[2] * v0[2] + v0[3] * v0[3]) + (v1[0] * v1[0] + v1[1] * v1[1]) + (v1[2] * v1[2] + v1[3] * v1[3]); }
                ss += __shfl_xor(ss, 16); ss += __shfl_xor(ss, 32);
                if (fq == 0) atomicAdd(rowss + row, ss); }
    }
};
struct EpiFF1 {
    static constexpr bool PERM = true, AFTER_DRAIN = false;
    const float* rowss; bf16_t* U;
    __device__ __forceinline__ void operator()(const f32x4 (&acc)[2][2][4][2], const Unit& u, int wr, int wc, int fr, int fq) const {
        const int row0 = u.pm * BM + wr * 64 + fr, col0 = u.pn * BM + wc * 32 + 8 * fq;
#pragma unroll
        for (int ai = 0; ai < 2; ++ai)
#pragma unroll
            for (int m = 0; m < 4; ++m) { const size_t row = (size_t)(row0 + ai * HALF + m * 16);
                const float rs = 1.0f / sqrtf(rowss[row] * (1.f / 1024.f) + 1e-6f);
#pragma unroll
                for (int bj = 0; bj < 2; ++bj) { f32x4 v0 = acc[ai][bj][m][0] * rs, v1 = acc[ai][bj][m][1] * rs;
#pragma unroll
                    for (int i = 0; i < 4; ++i) { const float a = fmaxf(v0[i], 0.f), b = fmaxf(v1[i], 0.f); v0[i] = a * a; v1[i] = b * b; }
                    *(u32x4*)(U + row * 4096 + col0 + bj * HALF) = pack8(v0, v1); } }
    }
};
struct EpiFF2 {
    static constexpr bool PERM = true, AFTER_DRAIN = false;
    float* out;
    __device__ __forceinline__ void operator()(const f32x4 (&acc)[2][2][4][2], const Unit& u, int wr, int wc, int fr, int fq) const {
        const int row0 = u.pm * BM + wr * 64 + fr, col0 = u.pn * BM + wc * 32 + 8 * fq;
#pragma unroll
        for (int ai = 0; ai < 2; ++ai)
#pragma unroll
            for (int m = 0; m < 4; ++m) { const size_t row = (size_t)(row0 + ai * HALF + m * 16);
#pragma unroll
                for (int bj = 0; bj < 2; ++bj) { float* p = out + row * 1024 + col0 + bj * HALF;
                    const f32x4 v0 = acc[ai][bj][m][0] + *(const f32x4*)p, v1 = acc[ai][bj][m][1] + *(const f32x4*)(p + 4);
                    *(f32x4*)p = v0; *(f32x4*)(p + 4) = v1; } }
    }
};
template <class Epi, class Sched, bool ALIGN_EPI = false, bool SP2 = false>
__device__ __forceinline__ void gemm_phase(PG8_LAS unsigned char* lds, const Gemm g, const Sched& S, const Epi& E) {
    const int tid = threadIdx.x, wid = __builtin_amdgcn_readfirstlane(tid >> 6), lane = tid & 63, wr = wid >> 2, wc = wid & 3, fr = lane & 15, fq = lane >> 4;
    const int K = g.K, nt = K / BK;
    unsigned voffA[2], voffB[2];
#pragma unroll
    for (int i = 0; i < 2; ++i) { int R, C; stage_rc(tid * 16 + i * 8192, R, C); const int Rb = Epi::PERM ? ((R & ~31) + perm32(R & 31)) : R;
        voffA[i] = (unsigned)(R * K + C) * 2u; voffB[i] = (unsigned)(Rb * K + C) * 2u; }
    const size_t kstep = (size_t)(BK * 2);
    const size_t hstep = (size_t)HALF * K * 2;
    const size_t tstep = 2 * hstep;
    const unsigned ldsw = (unsigned)wid * 1024u;
    const int aoff = lds_byte(wr * 64 + fr, fq * 8), boff = lds_byte(wc * 32 + fr, fq * 8);
#define PG8_SA(b, h) (((b) * 2 + (h)) * HTB)
#define PG8_SB(b, h) ((4 + (b) * 2 + (h)) * HTB)
#define PG8_STAGE(bufoff, gbase, voff) do { _Pragma("unroll") for (int _i = 0; _i < 2; ++_i) \
        __builtin_amdgcn_global_load_lds((const unsigned*)((const char*)(gbase) + (voff)[_i]), (PG8_LAS unsigned*)(lds + (bufoff) + ldsw + _i * 8192), 16, 0, 0); } while (0)
#define PG8_LDA(dst, b, h) do { _Pragma("unroll") for (int m = 0; m < 4; ++m) _Pragma("unroll") for (int k = 0; k < 2; ++k) dst[m][k] = *(const PG8_LAS bf16x8*)(lds + PG8_SA(b, h) + aoff + m * 2048 + k * 1024); } while (0)
#define PG8_LDB(dst, b, h) do { _Pragma("unroll") for (int n = 0; n < 2; ++n) _Pragma("unroll") for (int k = 0; k < 2; ++k) dst[n][k] = *(const PG8_LAS bf16x8*)(lds + PG8_SB(b, h) + boff + n * 2048 + k * 1024); } while (0)
#define PG8_MMA(ai, bj, At, Bt) do { __builtin_amdgcn_s_setprio(1); _Pragma("unroll") for (int m = 0; m < 4; ++m) _Pragma("unroll") for (int n = 0; n < 2; ++n) _Pragma("unroll") for (int k = 0; k < 2; ++k) \
        acc[ai][bj][m][n] = __builtin_amdgcn_mfma_f32_16x16x32_bf16(Bt[n][k], At[m][k], acc[ai][bj][m][n], 0, 0, 0); __builtin_amdgcn_s_setprio(0); } while (0)
#define PG8_WAIT_V(n) asm volatile("s_waitcnt vmcnt(" #n ")" ::: "memory")
#define PG8_WAIT_L(n) asm volatile("s_waitcnt lgkmcnt(" #n ")" ::: "memory")
#define PG8_BAR __builtin_amdgcn_s_barrier()
#define PG8_SCHED __builtin_amdgcn_sched_barrier(0)
    Unit cur, nxt; int ui = 0;
    if (!S.next(0, cur)) return;
    f32x4 acc[2][2][4][2];
#pragma unroll
    for (int a = 0; a < 2; ++a)
#pragma unroll
        for (int b = 0; b < 2; ++b)
#pragma unroll
            for (int m = 0; m < 4; ++m)
#pragma unroll
                for (int n = 0; n < 2; ++n) acc[a][b][m][n] = (f32x4){0.f, 0.f, 0.f, 0.f};
    bf16x8 At[4][2], B0[2][2], B1[2][2];
    const char* cA = (const char*)g.A + (size_t)cur.pm * tstep; const char* cB = (const char*)g.Bt + (size_t)cur.pn * tstep;
    S.a_ready(cur);
    if constexpr (SP2) {
        PG8_STAGE(PG8_SB(0, 0), cB, voffB); PG8_STAGE(PG8_SB(0, 1), cB + hstep, voffB); PG8_STAGE(PG8_SA(0, 0), cA, voffA); PG8_STAGE(PG8_SA(0, 1), cA + hstep, voffA);
        if (wr == 1) PG8_BAR;
        PG8_WAIT_V(2); PG8_BAR;
        PG8_STAGE(PG8_SB(1, 0), cB + kstep, voffB); PG8_STAGE(PG8_SA(1, 0), cA + kstep, voffA); PG8_STAGE(PG8_SB(1, 1), cB + hstep + kstep, voffB);
        PG8_WAIT_V(6); PG8_BAR;
    } else {
        PG8_STAGE(PG8_SB(0, 0), cB, voffB); PG8_STAGE(PG8_SA(0, 0), cA, voffA); PG8_STAGE(PG8_SB(0, 1), cB + hstep, voffB); PG8_STAGE(PG8_SA(0, 1), cA + hstep, voffA);
        if (wr == 1) PG8_BAR;
        PG8_WAIT_V(4); PG8_BAR;
        PG8_STAGE(PG8_SB(1, 0), cB + kstep, voffB); PG8_STAGE(PG8_SA(1, 0), cA + kstep, voffA); PG8_STAGE(PG8_SB(1, 1), cB + hstep + kstep, voffB);
        PG8_WAIT_V(6); PG8_BAR;
    }
    for (;;) {
        const bool has_next = S.next(ui + 1, nxt);
        const char* nA = has_next ? (const char*)g.A + (size_t)nxt.pm * tstep : cA; const char* nB = has_next ? (const char*)g.Bt + (size_t)nxt.pn * tstep : cB;
        for (int t = 0; t < nt; t += 2) {
            const bool last = (t == nt - 2);
            const char* a1 = cA + (size_t)(t + 1) * kstep;
            const char* a2 = last ? nA : cA + (size_t)(t + 2) * kstep; const char* b2 = last ? nB : cB + (size_t)(t + 2) * kstep;
            const char* a3 = a2 + kstep; const char* b3 = b2 + kstep;
            if (last && has_next) S.a_ready(nxt);
            if constexpr (SP2) {
            PG8_LDB(B0, 0, 0); PG8_LDB(B1, 0, 1); PG8_SCHED; PG8_LDA(At, 0, 0); PG8_STAGE(PG8_SA(1, 1), a1 + hstep, voffA);
            PG8_WAIT_V(8); PG8_WAIT_L(0); PG8_BAR; PG8_MMA(0, 0, At, B0); PG8_MMA(0, 1, At, B1); PG8_BAR; PG8_SCHED;
            PG8_LDA(At, 0, 1); PG8_STAGE(PG8_SB(0, 0), b2, voffB); PG8_STAGE(PG8_SB(0, 1), b2 + hstep, voffB); PG8_STAGE(PG8_SA(0, 0), a2, voffA);
            PG8_WAIT_V(8); PG8_WAIT_L(0); PG8_BAR; PG8_MMA(1, 0, At, B0); PG8_MMA(1, 1, At, B1); PG8_BAR; PG8_SCHED;
            PG8_LDB(B0, 1, 0); PG8_LDB(B1, 1, 1); PG8_SCHED; PG8_LDA(At, 1, 0); PG8_STAGE(PG8_SA(0, 1), a2 + hstep, voffA);
            PG8_WAIT_V(8); PG8_WAIT_L(0); PG8_BAR; PG8_MMA(0, 0, At, B0); PG8_MMA(0, 1, At, B1); PG8_BAR; PG8_SCHED;
            PG8_LDA(At, 1, 1); PG8_STAGE(PG8_SB(1, 0), b3, voffB); PG8_STAGE(PG8_SB(1, 1), b3 + hstep, voffB); PG8_STAGE(PG8_SA(1, 0), a3, voffA);
            PG8_WAIT_V(8); PG8_WAIT_L(0); PG8_BAR; PG8_MMA(1, 0, At, B0); PG8_MMA(1, 1, At, B1); PG8_BAR; PG8_SCHED;
            } else {
            PG8_LDB(B0, 0, 0); PG8_SCHED; PG8_LDA(At, 0, 0); PG8_STAGE(PG8_SA(1, 1), a1 + hstep, voffA);
            PG8_WAIT_L(8); PG8_BAR; PG8_WAIT_L(0); PG8_MMA(0, 0, At, B0); PG8_BAR; PG8_SCHED;
            PG8_LDB(B1, 0, 1); PG8_STAGE(PG8_SB(0, 0), b2, voffB);
            PG8_BAR; PG8_WAIT_L(0); PG8_MMA(0, 1, At, B1); PG8_BAR;
            PG8_LDA(At, 0, 1); PG8_STAGE(PG8_SA(0, 0), a2, voffA);
            PG8_BAR; PG8_WAIT_L(0); PG8_MMA(1, 0, At, B0); PG8_BAR; PG8_SCHED;
            PG8_STAGE(PG8_SB(0, 1), b2 + hstep, voffB);
            PG8_WAIT_V(6); PG8_BAR; PG8_MMA(1, 1, At, B1); PG8_BAR;
            PG8_LDB(B0, 1, 0); PG8_SCHED; PG8_LDA(At, 1, 0); PG8_STAGE(PG8_SA(0, 1), a2 + hstep, voffA);
            PG8_WAIT_L(8); PG8_BAR; PG8_WAIT_L(0); PG8_MMA(0, 0, At, B0); PG8_BAR; PG8_SCHED;
            PG8_LDB(B1, 1, 1); PG8_STAGE(PG8_SB(1, 0), b3, voffB);
            PG8_BAR; PG8_WAIT_L(0); PG8_MMA(0, 1, At, B1); PG8_BAR;
            PG8_LDA(At, 1, 1); PG8_STAGE(PG8_SA(1, 0), a3, voffA);
            PG8_BAR; PG8_WAIT_L(0); PG8_MMA(1, 0, At, B0); PG8_BAR; PG8_SCHED;
            PG8_STAGE(PG8_SB(1, 1), b3 + hstep, voffB);
            PG8_WAIT_V(6); PG8_BAR; PG8_MMA(1, 1, At, B1); PG8_BAR;
            }
        }
        if constexpr (ALIGN_EPI) { if (wr == 0) PG8_BAR; }
        if constexpr (!Epi::AFTER_DRAIN) { E(acc, cur, wr, wc, fr, fq); S.done(cur); }
        if (!has_next) break;
#pragma unroll
        for (int a = 0; a < 2; ++a)
#pragma unroll
            for (int b = 0; b < 2; ++b)
#pragma unroll
                for (int m = 0; m < 4; ++m)
#pragma unroll
                    for (int n = 0; n < 2; ++n) acc[a][b][m][n] = (f32x4){0.f, 0.f, 0.f, 0.f};
        cur = nxt; cA = nA; cB = nB; ++ui;
        if constexpr (ALIGN_EPI) { if (wr == 1) PG8_BAR; }
    }
    PG8_WAIT_V(0);
    if constexpr (!ALIGN_EPI) { if (wr == 0) PG8_BAR; }
    PG8_BAR;
    if constexpr (Epi::AFTER_DRAIN) { E.fused(acc, cur, wr, wc, fr, fq, lds, wid, lane); S.done(cur); }
#undef PG8_SA
#undef PG8_SB
#undef PG8_STAGE
#undef PG8_LDA
#undef PG8_LDB
#undef PG8_MMA
#undef PG8_WAIT_V
#undef PG8_WAIT_L
#undef PG8_BAR
#undef PG8_SCHED
}
}
constexpr int D_MODEL = 1024, BATCH = 4, SEQ = 8192, NTOK = BATCH * SEQ;
constexpr int D_PROJ = 5408, D_FF = 4096, NP_PAD = 5632;
constexpr int NWAVES = 8;
constexpr size_t MiB = 1u << 20;
constexpr size_t WS_CTL = 0, CTL_ZERO_BYTES = 1 * MiB;
constexpr size_t CTL_ROWSS = 512 * 1024;
constexpr size_t WS_WIN = 2 * MiB, WS_WA = 13 * MiB, WS_WB = 14 * MiB, WS_WO = 15 * MiB, WS_W1 = 17 * MiB, WS_W2 = 25 * MiB, WS_CK1 = 33 * MiB, WS_CV1 = 34 * MiB;
constexpr size_t WS_SMALL = 35 * MiB;
constexpr size_t WS_KSN = 40 * MiB, WS_KWN = 48 * MiB, WS_VST = 56 * MiB, WS_VWT = 64 * MiB, WS_KCN = 72 * MiB, WS_VCT = 73 * MiB;
constexpr size_t WS_GT = 76 * MiB;
constexpr size_t CTL_QCTR = 4096;
constexpr size_t WS_XN = 36 * MiB;
constexpr size_t WS_QN = 100 * MiB, WS_KV = 132 * MiB, WS_ML = 180 * MiB, WS_G = 308 * MiB, WS_S = 436 * MiB;
constexpr size_t WS_YA = 440 * MiB, WS_YB = 472 * MiB;
constexpr size_t WS_MX = 180 * MiB;
constexpr size_t WS_U = 180 * MiB;
constexpr size_t WS_END = 504 * MiB;
constexpr int RING_BYTES = 131072, MISC_OFF = RING_BYTES + 320, LDS_BYTES = 147456;

#define GAS __attribute__((address_space(1)))
#define LAS __attribute__((address_space(3)))
typedef unsigned short bf16;
typedef unsigned v4u __attribute__((ext_vector_type(4)));
typedef float f32x4 __attribute__((ext_vector_type(4)));
#define LDS_WAIT() asm volatile("s_waitcnt lgkmcnt(0)" ::: "memory")
#define VM_WAIT() asm volatile("s_waitcnt vmcnt(0)" ::: "memory")
__device__ __forceinline__ unsigned f2bf(float f) { unsigned u = __builtin_bit_cast(unsigned, f); return (u + 0x7fffu + ((u >> 16) & 1u)) >> 16; }
__device__ __forceinline__ float bf2f(bf16 v) { return __uint_as_float((unsigned)v << 16); }
__device__ __forceinline__ unsigned pk2(float lo, float hi) { return f2bf(lo) | (f2bf(hi) << 16); }
__device__ __forceinline__ float wave_sum(float v) {
#pragma unroll
    for (int o = 1; o < 64; o <<= 1) v += __shfl_xor(v, o);
    return v;
}
__device__ __forceinline__ float wave_max(float v) {
#pragma unroll
    for (int o = 1; o < 64; o <<= 1) v = fmaxf(v, __shfl_xor(v, o));
    return v;
}

__device__ __forceinline__ int proj_src_col(int n) {
    if (n < 1280) return n;
    if (n < 3328) { const int q = (n - 1280) >> 9, r = (n - 1280) & 511; return (q == 0 ? 1304 : q == 1 ? 1816 : q == 2 ? 2328 : 2848) + r; }
    if (n < 5376) return 3360 + (n - 3328);
    if (n < 5400) return 1280 + (n - 5376);
    if (n < 5404) return 2840 + (n - 5400);
    if (n < 5408) return 2844 + (n - 5404);
    return -1;
}
template <bool MAP>
__device__ __forceinline__ void transpose_item(const float* W, int K, int ldw, const float* kscale, bf16* WT, int Nout, LAS float* scr, int item, int lane) {
    const int nblk = Nout / 32, kb = item / nblk, nb = item % nblk, k0 = 64 * kb, n0 = 32 * nb;
    const int sc = MAP ? proj_src_col(n0 + (lane & 31)) : (n0 + (lane & 31));
#pragma unroll 8
    for (int i = 0; i < 32; ++i) { const int kk = 2 * i + (lane >> 5); float v = sc >= 0 ? W[(size_t)(k0 + kk) * ldw + sc] : 0.f; if (kscale) v *= kscale[k0 + kk]; scr[kk * 33 + (lane & 31)] = v; }
    LDS_WAIT(); asm volatile("" ::: "memory");
    const int c = lane & 7;
#pragma unroll
    for (int j = 0; j < 4; ++j) { const int n = (lane >> 3) + 8 * j; const LAS float* s = scr + (8 * c) * 33 + n;
        v4u o; o.x = pk2(s[0 * 33], s[1 * 33]); o.y = pk2(s[2 * 33], s[3 * 33]); o.z = pk2(s[4 * 33], s[5 * 33]); o.w = pk2(s[6 * 33], s[7 * 33]);
        *(GAS v4u*)(WT + (size_t)(n0 + n) * K + k0 + 8 * c) = o; }
    LDS_WAIT(); asm volatile("" ::: "memory");
}
__device__ __forceinline__ void rms_row_to_bf16(const float* xrow, bf16* orow, int lane) {
    const GAS f32x4* xr = (const GAS f32x4*)xrow + lane;
    f32x4 v[4]; float s = 0.f;
#pragma unroll
    for (int j = 0; j < 4; ++j) { v[j] = xr[64 * j]; s += (v[j].x * v[j].x + v[j].y * v[j].y) + (v[j].z * v[j].z + v[j].w * v[j].w); }
    const float rstd = 1.f / sqrtf(wave_sum(s) * (1.f / D_MODEL) + 1e-6f);
    GAS unsigned long long* o8 = (GAS unsigned long long*)orow + lane;
#pragma unroll
    for (int j = 0; j < 4; ++j) o8[64 * j] = (unsigned long long)pk2(v[j].x * rstd, v[j].y * rstd) | ((unsigned long long)pk2(v[j].z * rstd, v[j].w * rstd) << 32);
}

typedef short bf16x8 __attribute__((ext_vector_type(8)));
typedef float f32x16 __attribute__((ext_vector_type(16)));
typedef unsigned u32x4 __attribute__((ext_vector_type(4)));
typedef unsigned u32x2 __attribute__((ext_vector_type(2)));
constexpr float LOG2E = 1.4426950408889634f;
__device__ const unsigned char BUCKET_TAB2[129] = {0, 1, 2, 3, 4, 5, 6, 7, 8, 9, 10, 11, 12, 13, 14, 15, 16, 16, 16, 17, 17, 18, 18, 18, 19, 19, 19, 20, 20, 20, 20, 21, 21, 21, 21, 22, 22, 22, 22, 22, 23, 23, 23, 23, 23, 23, 24, 24, 24, 24, 24, 24, 25, 25, 25, 25, 25, 25, 25, 26, 26, 26, 26, 26, 26, 26, 26, 27, 27, 27, 27, 27, 27, 27, 27, 27, 27, 28, 28, 28, 28, 28, 28, 28, 28, 28, 28, 29, 29, 29, 29, 29, 29, 29, 29, 29, 29, 29, 29, 30, 30, 30, 30, 30, 30, 30, 30, 30, 30, 30, 30, 30, 30, 31, 31, 31, 31, 31, 31, 31, 31, 31, 31, 31, 31, 31, 31, 31, 31};
__device__ __forceinline__ unsigned cvtpk(float lo, float hi) { typedef float f2 __attribute__((ext_vector_type(2))); typedef __bf16 b2 __attribute__((ext_vector_type(2))); f2 v = {lo, hi}; b2 b = __builtin_convertvector(v, b2); return __builtin_bit_cast(unsigned, b); }
__device__ __forceinline__ float bflo(unsigned w) { return __uint_as_float(w << 16); }
__device__ __forceinline__ float bfhi(unsigned w) { return __uint_as_float(w & 0xffff0000u); }
__device__ __forceinline__ int key_off16(int pp) { return (pp & 3) + 8 * ((pp >> 2) & 1) + 4 * (pp >> 3); }
__device__ __forceinline__ int crow(int r, int hi) { return (r & 3) + 8 * (r >> 2) + 4 * hi; }

__device__ __forceinline__ void knorm_item(const bf16* KV, int col0, const float* gain, bf16* dst, size_t tok0, int lane) {
    const int ch = lane & 7;
    float gn[8];
#pragma unroll
    for (int i = 0; i < 8; ++i) gn[i] = gain[8 * ch + i];
#pragma unroll
    for (int it = 0; it < 8; ++it) {
        const int r = 8 * it + (lane >> 3);
        const u32x4 v = *(const u32x4*)(KV + (tok0 + r) * 768 + col0 + 8 * ch);
        float f[8] = {bflo(v.x), bfhi(v.x), bflo(v.y), bfhi(v.y), bflo(v.z), bfhi(v.z), bflo(v.w), bfhi(v.w)};
        float ss = 0.f;
#pragma unroll
        for (int i = 0; i < 8; ++i) ss += f[i] * f[i];
        ss += __shfl_xor(ss, 1); ss += __shfl_xor(ss, 2); ss += __shfl_xor(ss, 4);
        const float rs = 1.f / sqrtf(ss * (1.f / 64.f) + 1e-6f);
        u32x4 o; o.x = cvtpk(f[0] * rs * gn[0], f[1] * rs * gn[1]); o.y = cvtpk(f[2] * rs * gn[2], f[3] * rs * gn[3]); o.z = cvtpk(f[4] * rs * gn[4], f[5] * rs * gn[5]); o.w = cvtpk(f[6] * rs * gn[6], f[7] * rs * gn[7]);
        *(u32x4*)(dst + (size_t)r * 64 + 8 * ch) = o;
    }
}
__device__ __forceinline__ void vtrans_item(const bf16* KV, int col0, bf16* dst, size_t tok0, LAS unsigned short* scr, int lane) {
#pragma unroll
    for (int it = 0; it < 8; ++it) {
        const int r = 8 * it + (lane >> 3), ch = lane & 7;
        const u32x4 v = *(const u32x4*)(KV + (tok0 + r) * 768 + col0 + 8 * ch);
        *(LAS u32x4*)(scr + r * 72 + 8 * ch) = v;
    }
    LDS_WAIT(); asm volatile("" ::: "memory");
    const int d = lane;
#pragma unroll
    for (int oc = 0; oc < 8; ++oc) {
        unsigned w[4];
#pragma unroll
        for (int k2 = 0; k2 < 4; ++k2) {
            const int p0 = 8 * oc + 2 * k2, p1 = p0 + 1;
            const int key0 = 16 * (p0 >> 4) + key_off16(p0 & 15), key1 = 16 * (p1 >> 4) + key_off16(p1 & 15);
            w[k2] = (unsigned)scr[key0 * 72 + d] | ((unsigned)scr[key1 * 72 + d] << 16);
        }
        u32x4 o; o.x = w[0]; o.y = w[1]; o.z = w[2]; o.w = w[3];
        *(u32x4*)(dst + (size_t)d * 64 + 8 * oc) = o;
    }
    LDS_WAIT(); asm volatile("" ::: "memory");
}
__device__ __forceinline__ void compress_unit(int unit, const bf16* KV, const bf16* W1T, const bf16* W2T, const float* b1p, const float* b2, const float* kgain0,
                                              bf16* KCN, bf16* VCT, LAS unsigned char* lds, int tid) {
    const int kv = unit & 1, tl = (unit >> 1) & 7, bg = unit >> 4, b = bg >> 1, g = bg & 1;
    const int lane = tid & 63, w = __builtin_amdgcn_readfirstlane(tid >> 6), r32 = lane & 31, hi = lane >> 5;
    const int colbase = (kv ? 128 : 0) + 64 * g;
    LAS unsigned short* hid = (LAS unsigned short*)lds;
    LAS float* outl = (LAS float*)(lds + 64 * 264 * 2);
    f32x16 acc[2]; acc[0] = f32x16{}; acc[1] = f32x16{};
    const bf16* brow = W1T + (size_t)(32 * w + r32) * 2048 + 8 * hi;
    const bf16* arow[2];
#pragma unroll
    for (int rt = 0; rt < 2; ++rt) arow[rt] = KV + ((size_t)b * SEQ) * 768 + colbase + 8 * hi;
    int n16[2];
#pragma unroll
    for (int rt = 0; rt < 2; ++rt) n16[rt] = 16 * (64 * tl + 32 * rt + r32);
#pragma unroll 4
    for (int s = 0; s < 128; ++s) {
        const int jj = s >> 2, d0 = 16 * (s & 3);
        const bf16x8 bf = *(const bf16x8*)(brow + 16 * s);
#pragma unroll
        for (int rt = 0; rt < 2; ++rt) {
            int tok = n16[rt] + jj; tok = tok > SEQ - 1 ? SEQ - 1 : tok;
            const bf16x8 af = *(const bf16x8*)(arow[rt] + (size_t)tok * 768 + d0);
            acc[rt] = __builtin_amdgcn_mfma_f32_32x32x16_bf16(af, bf, acc[rt], 0, 0, 0);
        }
    }
    {
        const int col = 32 * w + r32; const float bb = b1p[col];
#pragma unroll
        for (int rt = 0; rt < 2; ++rt)
#pragma unroll
            for (int r = 0; r < 16; ++r) {
                const float x = acc[rt][r] + bb;
                const float u = 0.7978845608028654f * (x + 0.044715f * x * x * x);
                const float e = __builtin_amdgcn_exp2f(2.f * LOG2E * u);
                const float th = 1.f - 2.f * __builtin_amdgcn_rcpf(e + 1.f);
                hid[(32 * rt + crow(r, hi)) * 264 + col] = (unsigned short)(cvtpk(0.5f * x * (1.f + th), 0.f) & 0xffffu);
            }
    }
    __syncthreads();
    if (w < 4) {
        const int rt = w >> 1, ct = w & 1;
        f32x16 o = f32x16{};
        const bf16* b2row = W2T + (size_t)(32 * ct + r32) * 256 + 8 * hi;
#pragma unroll
        for (int s = 0; s < 16; ++s) {
            const bf16x8 af = *(const LAS bf16x8*)(hid + (32 * rt + r32) * 264 + 16 * s + 8 * hi);
            const bf16x8 bf = *(const bf16x8*)(b2row + 16 * s);
            o = __builtin_amdgcn_mfma_f32_32x32x16_bf16(af, bf, o, 0, 0, 0);
        }
        const float bb = b2[32 * ct + r32];
#pragma unroll
        for (int r = 0; r < 16; ++r) outl[(32 * rt + crow(r, hi)) * 65 + 32 * ct + r32] = o[r] + bb;
    }
    __syncthreads();
#pragma unroll
    for (int k = 0; k < 8; ++k) {
        const int r = 8 * w + k, n = 64 * tl + r;
        float v = outl[r * 65 + lane];
        if (kv == 0) {
            const float ss = wave_sum(v * v);
            v = v * (1.f / sqrtf(ss * (1.f / 64.f) + 1e-6f)) * kgain0[lane];
            if (n >= 511) v = 0.f;
            KCN[((size_t)bg * 512 + n) * 64 + lane] = (bf16)f2bf(v);
        } else {
            if (n >= 511) v = 0.f;
            const int pos = 16 * (r >> 4) + key_off16(r & 15);
            VCT[(((size_t)bg * 8 + tl) * 64 + lane) * 64 + pos] = (bf16)f2bf(v);
        }
    }
    __syncthreads();
}

constexpr int ENG_BUF = 0;
constexpr int ENG_LUT = 32768;
constexpr int LUTN = 704;
constexpr int ENG_IMP = ENG_LUT + 4 * LUTN * 4;
constexpr int ENG_SELM = ENG_IMP + 64 * 128 * 4;
constexpr int ENG_UNION = ENG_SELM + 64 * 4 * 4;
constexpr int ENG_TLIST = ENG_UNION + 16;
constexpr int ENG_MISC = ENG_TLIST + 132 * 4;
constexpr int ENG_STASH = ENG_MISC + 16;
constexpr int ENG_END = ENG_STASH + 32 * 512 * 4;

struct EngPtrs { const bf16 *QN, *KCN, *VCT, *KSN, *VST, *KWN, *VWT; const float* SB; const float* rel; const float* qgain; const float* bounds; bf16* YA; };

__device__ __forceinline__ int tile_off(int row, int ch) { return row * 128 + ((ch ^ (row & 7)) << 4); }

template <int BR>
__device__ __forceinline__ void eng_branch(LAS unsigned char* lds, const bf16* Kg, const bf16* Vg, int nt, int c, int tid, int lane, int hl, int qh,
                                           const bf16x8 (&qr)[4], float farc, float& lsum, float inv_l, f32x16 (&o)[2]) {
    const int r32 = lane & 31, hi = lane >> 5;
    const LAS int* tlist = (const LAS int*)(lds + ENG_TLIST);
    const LAS float* lut = (const LAS float*)(lds + ENG_LUT) + hl * LUTN;
    LAS float* imp = (LAS float*)(lds + ENG_IMP);
    auto tile_id = [&](int k) -> int { return BR <= 1 ? k : (BR == 2 ? tlist[k] : (c - 8 + k < 0 ? 0 : c - 8 + k)); };
    const int kofs = (BR == 3) ? (c < 8 ? 8 - c : 0) : 0;
    const int srow = tid >> 3, sch = tid & 7, soff = tile_off(srow, sch);
    u32x4 kreg, vreg;
    {
        const int j0 = tile_id(kofs);
        kreg = *(const u32x4*)(Kg + (size_t)j0 * 4096 + tid * 8);
        if (BR != 0) vreg = *(const u32x4*)(Vg + (size_t)j0 * 4096 + tid * 8);
        *(LAS u32x4*)(lds + ENG_BUF + soff) = kreg;
        if (BR != 0) *(LAS u32x4*)(lds + ENG_BUF + 8192 + soff) = vreg;
    }
    __syncthreads();
    for (int k = 0; k < nt; ++k) {
        const int j = tile_id(k + kofs);
        const int bufo = ENG_BUF + (k & 1) * 16384;
        if (k + 1 < nt) {
            const int jn = tile_id(k + 1 + kofs);
            kreg = *(const u32x4*)(Kg + (size_t)jn * 4096 + tid * 8);
            if (BR != 0) vreg = *(const u32x4*)(Vg + (size_t)jn * 4096 + tid * 8);
        }
        bool near_;
        float cinit;
        if (BR <= 1) { const int dmin = 64 * c - 16 * (64 * j + 63) - 31; near_ = dmin < 128; cinit = near_ ? 0.f : farc; }
        else if (BR == 2) { near_ = (j >= c - 2); cinit = near_ ? 0.f : farc; const unsigned wsel = ((const LAS unsigned*)(lds + ENG_SELM))[(32 * qh + r32) * 4 + (j >> 5)]; if (!((wsel >> (j & 31)) & 1u)) cinit = -INFINITY; }
        else { near_ = (j >= c - 2) || (j == c - 8); cinit = near_ ? 0.f : farc; }
        f32x16 p[2];
        {
            f32x16 ci;
#pragma unroll
            for (int r = 0; r < 16; ++r) ci[r] = cinit;
            p[0] = ci; p[1] = ci;
        }
#pragma unroll
        for (int s = 0; s < 4; ++s)
#pragma unroll
            for (int kh = 0; kh < 2; ++kh) {
                const bf16x8 kf = *(const LAS bf16x8*)(lds + bufo + tile_off(32 * kh + r32, 2 * s + hi));
                p[kh] = __builtin_amdgcn_mfma_f32_32x32x16_bf16(kf, qr[s], p[kh], 0, 0, 0);
            }
        if (near_) {
            if (BR <= 1) {
                const int dbase = 64 * c + 32 * qh + r32 - 16 * (64 * j + 4 * hi) - 31;
#pragma unroll
                for (int kh = 0; kh < 2; ++kh)
#pragma unroll
                    for (int r = 0; r < 16; ++r) {
                        const int cr = 32 * kh + (r & 3) + 8 * (r >> 2);
                        const int dist = dbase - 16 * cr;
                        const int idx = (dist > 128 ? 128 : dist) + 64;
                        const float bias = lut[idx < 0 ? 0 : idx];
                        p[kh][r] = dist >= 0 ? p[kh][r] + bias : -INFINITY;
                    }
            } else {
                const LAS float* pb = lut + (64 * (c - j) + 32 * qh + r32 - 4 * hi + 64 - 59);
#pragma unroll
                for (int kh = 0; kh < 2; ++kh)
#pragma unroll
                    for (int r = 0; r < 16; ++r) { const int cr = 32 * kh + (r & 3) + 8 * (r >> 2); p[kh][r] += pb[59 - cr]; }
            }
        }
        float ls = 0.f;
#pragma unroll
        for (int kh = 0; kh < 2; ++kh)
#pragma unroll
            for (int r = 0; r < 16; ++r) { p[kh][r] = __builtin_amdgcn_exp2f(p[kh][r]); ls += p[kh][r]; }
        lsum += ls;
        if (BR == 1) {
#pragma unroll
            for (int kh = 0; kh < 2; ++kh)
#pragma unroll
                for (int r = 0; r < 16; ++r) p[kh][r] *= inv_l;
            if (c >= 16) {
                const int q = 32 * qh + r32;
#pragma unroll
                for (int kh = 0; kh < 2; ++kh)
#pragma unroll
                    for (int a = 0; a < 4; ++a) {
                        const int jb = 16 * j + 8 * kh + 2 * a + hi;
                        const float gs = (p[kh][4 * a] + p[kh][4 * a + 1]) + (p[kh][4 * a + 2] + p[kh][4 * a + 3]);
                        __hip_atomic_fetch_add(&imp[q * 128 + jb], gs, __ATOMIC_RELAXED, __HIP_MEMORY_SCOPE_WORKGROUP);
                        if (jb + 1 < 128) __hip_atomic_fetch_add(&imp[q * 128 + jb + 1], p[kh][4 * a + 3], __ATOMIC_RELAXED, __HIP_MEMORY_SCOPE_WORKGROUP);
                    }
            }
        }
        if (BR != 0) {
#pragma unroll
            for (int ks = 0; ks < 4; ++ks) {
                const int kh = ks >> 1, s2 = ks & 1;
                u32x4 pw; pw.x = cvtpk(p[kh][8 * s2 + 0], p[kh][8 * s2 + 1]); pw.y = cvtpk(p[kh][8 * s2 + 2], p[kh][8 * s2 + 3]); pw.z = cvtpk(p[kh][8 * s2 + 4], p[kh][8 * s2 + 5]); pw.w = cvtpk(p[kh][8 * s2 + 6], p[kh][8 * s2 + 7]);
                const bf16x8 pf = __builtin_bit_cast(bf16x8, pw);
#pragma unroll
                for (int dh = 0; dh < 2; ++dh) {
                    const bf16x8 vf = *(const LAS bf16x8*)(lds + bufo + 8192 + tile_off(32 * dh + r32, 2 * ks + hi));
                    o[dh] = __builtin_amdgcn_mfma_f32_32x32x16_bf16(vf, pf, o[dh], 0, 0, 0);
                }
            }
        }
        if (k + 1 < nt) {
            const int bo = ENG_BUF + ((k + 1) & 1) * 16384;
            *(LAS u32x4*)(lds + bo + soff) = kreg;
            if (BR != 0) *(LAS u32x4*)(lds + bo + 8192 + soff) = vreg;
        }
        __syncthreads();
    }
}

__device__ __forceinline__ void eng_unit(int unit, const EngPtrs& P, LAS unsigned char* lds, int tid) {
    const int c = 127 - (unit >> 3), bg = unit & 7, b = bg >> 1, g = bg & 1;
    const int lane = tid & 63, w = __builtin_amdgcn_readfirstlane(tid >> 6), hl = w >> 1, qh = w & 1, r32 = lane & 31, hi = lane >> 5;
    const int head = 4 * g + hl;
    const int t = 64 * c + 32 * qh + r32;
    const size_t row = (size_t)b * SEQ + t;
    LAS float* lutw = (LAS float*)(lds + ENG_LUT);
    LAS float* imp = (LAS float*)(lds + ENG_IMP);
    LAS unsigned* selm = (LAS unsigned*)(lds + ENG_SELM);
    LAS unsigned* uni = (LAS unsigned*)(lds + ENG_UNION);
    LAS int* tlist = (LAS int*)(lds + ENG_TLIST);
    LAS int* misc = (LAS int*)(lds + ENG_MISC);
    for (int i = tid; i < 4 * LUTN; i += 512) {
        const int h4 = i / LUTN, ii = i % LUTN, dist = ii - 64, hd = 4 * g + h4;
        float v;
        if (dist < 0 || dist >= 512) v = -INFINITY;
        else { const int bk = dist >= 128 ? 31 : (int)BUCKET_TAB2[dist]; v = (P.rel[bk * 8 + hd] - P.bounds[hd]) * LOG2E; }
        lutw[i] = v;
    }
    if (c >= 16) for (int i = tid; i < 64 * 128; i += 512) imp[i] = 0.f;
    if (tid < 4) uni[tid] = 0u;
    bf16x8 qr[4];
    {
        const bf16* qp = P.QN + row * 512 + head * 64 + 8 * hi;
        u32x4 raw[4]; float ss = 0.f;
#pragma unroll
        for (int s = 0; s < 4; ++s) { raw[s] = *(const u32x4*)(qp + 16 * s);
            const float f[8] = {bflo(raw[s].x), bfhi(raw[s].x), bflo(raw[s].y), bfhi(raw[s].y), bflo(raw[s].z), bfhi(raw[s].z), bflo(raw[s].w), bfhi(raw[s].w)};
#pragma unroll
            for (int i = 0; i < 8; ++i) ss += f[i] * f[i]; }
        ss += __shfl_xor(ss, 32);
        const float rs = (1.f / sqrtf(ss * (1.f / 64.f) + 1e-6f)) * 0.125f * LOG2E;
#pragma unroll
        for (int s = 0; s < 4; ++s) {
            const float* gp = P.qgain + 16 * s + 8 * hi;
            u32x4 o4;
            o4.x = cvtpk(bflo(raw[s].x) * rs * gp[0], bfhi(raw[s].x) * rs * gp[1]); o4.y = cvtpk(bflo(raw[s].y) * rs * gp[2], bfhi(raw[s].y) * rs * gp[3]);
            o4.z = cvtpk(bflo(raw[s].z) * rs * gp[4], bfhi(raw[s].z) * rs * gp[5]); o4.w = cvtpk(bflo(raw[s].w) * rs * gp[6], bfhi(raw[s].w) * rs * gp[7]);
            qr[s] = __builtin_bit_cast(bf16x8, o4);
        }
    }
    const float* gl = P.SB + row * 32 + head * 3;
    const float gate0 = 1.f / (1.f + __expf(-gl[0])), gate1 = 1.f / (1.f + __expf(-gl[1])), gate2 = 1.f / (1.f + __expf(-gl[2]));
    const float farc = (P.rel[31 * 8 + head] - P.bounds[head]) * LOG2E;
    LAS float* stash = (LAS float*)(lds + ENG_STASH) + tid;
    __syncthreads();
    {
        const int nvmax = (4 * c + 3 > 511) ? 511 : 4 * c + 3;
        const int ntc = (nvmax + 63) >> 6;
        const bf16* Kg = P.KCN + (size_t)bg * 512 * 64; const bf16* Vg = P.VCT + (size_t)bg * 8 * 4096;
        float l1 = 0.f; f32x16 od[2]; od[0] = f32x16{}; od[1] = f32x16{};
        eng_branch<0>(lds, Kg, Vg, ntc, c, tid, lane, hl, qh, qr, farc, l1, 0.f, od);
        l1 += __shfl_xor(l1, 32);
        const float inv = l1 > 0.f ? 1.f / l1 : 0.f;
        float l2 = 0.f;
        eng_branch<1>(lds, Kg, Vg, ntc, c, tid, lane, hl, qh, qr, farc, l2, inv, od);
#pragma unroll
        for (int dh = 0; dh < 2; ++dh)
#pragma unroll
            for (int r = 0; r < 16; ++r) stash[(dh * 16 + r) * 512] = gate0 * od[dh][r];
    }
    {
        const int q = tid >> 3, part = tid & 7;
        unsigned m16 = 0u;
        if (c >= 16) {
            unsigned key[16];
#pragma unroll
            for (int jj = 0; jj < 16; ++jj) { const int j = part * 16 + jj; key[jj] = (j >= 1 && j <= c - 2) ? (__float_as_uint(imp[q * 128 + j]) + 1u) : 0u; }
            unsigned T = 0u;
            for (int bit = 31; bit >= 0; --bit) {
                const unsigned cand = T | (1u << bit);
                int cnt = 0;
#pragma unroll
                for (int jj = 0; jj < 16; ++jj) cnt += key[jj] >= cand ? 1 : 0;
                cnt += __shfl_xor(cnt, 1); cnt += __shfl_xor(cnt, 2); cnt += __shfl_xor(cnt, 4);
                if (cnt >= 13) T = cand;
            }
            int gt = 0, eq = 0;
#pragma unroll
            for (int jj = 0; jj < 16; ++jj) { gt += key[jj] > T ? 1 : 0; eq += key[jj] == T ? 1 : 0; }
            int gtot = gt; gtot += __shfl_xor(gtot, 1); gtot += __shfl_xor(gtot, 2); gtot += __shfl_xor(gtot, 4);
            int pre = 0;
#pragma unroll
            for (int pp = 0; pp < 8; ++pp) { const int e = __shfl(eq, (lane & ~7) + pp); if (pp < part) pre += e; }
            int quota = 13 - gtot - pre; quota = quota < 0 ? 0 : quota;
#pragma unroll
            for (int jj = 0; jj < 16; ++jj) {
                bool s = key[jj] > T;
                if (key[jj] == T && T != 0u) { if (quota > 0) { s = true; --quota; } }
                m16 |= s ? (1u << jj) : 0u;
            }
        }
        unsigned wd = m16 << (16 * (part & 1));
        wd |= __shfl_xor(wd, 1);
        const int wi = part >> 1;
        if (c >= 16) {
            if (wi == 0) wd |= 1u;
            if (((c - 1) >> 5) == wi) wd |= 1u << ((c - 1) & 31);
            if ((c >> 5) == wi) wd |= 1u << (c & 31);
        } else {
            wd = (wi == 0) ? ((c >= 31) ? 0xffffffffu : ((2u << c) - 1u)) : 0u;
        }
        if ((part & 1) == 0) { selm[q * 4 + wi] = wd; __hip_atomic_fetch_or(&uni[wi], wd, __ATOMIC_RELAXED, __HIP_MEMORY_SCOPE_WORKGROUP); }
    }
    __syncthreads();
    {
        if (tid < 128) { const int j = tid; const unsigned uw = uni[j >> 5];
            if ((uw >> (j & 31)) & 1u) { int pos = __popc(uw & ((1u << (j & 31)) - 1u)); for (int k2 = 0; k2 < (j >> 5); ++k2) pos += __popc(uni[k2]); tlist[pos] = j; } }
        if (tid == 0) misc[1] = __popc(uni[0]) + __popc(uni[1]) + __popc(uni[2]) + __popc(uni[3]);
    }
    __syncthreads();
    {
        const int nts = misc[1];
        float l = 0.f; f32x16 od[2]; od[0] = f32x16{}; od[1] = f32x16{};
        eng_branch<2>(lds, P.KSN + (size_t)bg * SEQ * 64, P.VST + (size_t)bg * 128 * 4096, nts, c, tid, lane, hl, qh, qr, farc, l, 0.f, od);
        l += __shfl_xor(l, 32);
        const float sc = gate1 / l;
#pragma unroll
        for (int dh = 0; dh < 2; ++dh)
#pragma unroll
            for (int r = 0; r < 16; ++r) stash[(dh * 16 + r) * 512] += sc * od[dh][r];
    }
    {
        const int ntw = c < 8 ? c + 1 : 9;
        float l = 0.f; f32x16 od[2]; od[0] = f32x16{}; od[1] = f32x16{};
        eng_branch<3>(lds, P.KWN + (size_t)bg * SEQ * 64, P.VWT + (size_t)bg * 128 * 4096, ntw, c, tid, lane, hl, qh, qr, farc, l, 0.f, od);
        l += __shfl_xor(l, 32);
        const float sc = gate2 / l;
        bf16* yp = P.YA + row * 512 + head * 64;
#pragma unroll
        for (int dh = 0; dh < 2; ++dh)
#pragma unroll
            for (int a = 0; a < 4; ++a) {
                float y4[4];
#pragma unroll
                for (int i = 0; i < 4; ++i) y4[i] = stash[(dh * 16 + 4 * a + i) * 512] + sc * od[dh][4 * a + i];
                u32x2 v; v.x = cvtpk(y4[0], y4[1]); v.y = cvtpk(y4[2], y4[3]);
                *(u32x2*)(yp + 32 * dh + 8 * a + 4 * hi) = v;
            }
    }
}
__device__ __forceinline__ int pos16(int k) { return 16 * (k >> 4) + key_off16(k & 15); }
__device__ __forceinline__ float fsilu(float a) { return a / (1.f + __expf(-a)); }

__device__ __forceinline__ void ml_conv_item(const bf16* ML, const float* cw, const float* cb, int which, int bh, int chunk, bf16* QKC, bf16* KT, LAS unsigned short* scr, int lane) {
    const int b = bh >> 2, h = bh & 3;
    const int t0 = 64 * chunk;
    const size_t rowb = (size_t)b * SEQ;
    const int colb = which * 512 + h * 128;
    float w[2][4], bias[2];
#pragma unroll
    for (int u = 0; u < 2; ++u) { const int ch = colb + lane + 64 * u; bias[u] = cb[ch];
#pragma unroll
        for (int j = 0; j < 4; ++j) w[u][j] = cw[j * 1024 + ch]; }
    float hist[2][3];
#pragma unroll
    for (int u = 0; u < 2; ++u)
#pragma unroll
        for (int j = 0; j < 3; ++j) { const int tt = t0 - 3 + j; hist[u][j] = tt >= 0 ? bf2f(ML[(rowb + tt) * 2048 + colb + lane + 64 * u]) : 0.f; }
    const float sc = which == 0 ? 0.08838834764831845f : 1.f;
    bf16* dst = QKC + ((size_t)bh * 128 + chunk) * 8192;
    for (int r = 0; r < 64; ++r) {
#pragma unroll
        for (int u = 0; u < 2; ++u) {
            const float xc = bf2f(ML[(rowb + t0 + r) * 2048 + colb + lane + 64 * u]);
            const float a = bias[u] + hist[u][0] * w[u][0] + hist[u][1] * w[u][1] + hist[u][2] * w[u][2] + xc * w[u][3];
            hist[u][0] = hist[u][1]; hist[u][1] = hist[u][2]; hist[u][2] = xc;
            const unsigned short v = (unsigned short)f2bf(fsilu(a) * sc);
            const int dk = lane + 64 * u;
            dst[(size_t)r * 128 + pos16(dk)] = v;
            if (which) scr[r * 136 + dk] = v;
        }
    }
    if (which) {
        LDS_WAIT(); asm volatile("" ::: "memory");
        bf16* kt = KT + ((size_t)bh * 128 + chunk) * 8192;
#pragma unroll
        for (int u = 0; u < 2; ++u) {
            const int dk = lane + 64 * u;
#pragma unroll
            for (int oc = 0; oc < 8; ++oc) {
                unsigned wv[4];
#pragma unroll
                for (int k2 = 0; k2 < 4; ++k2) { const int p0 = 8 * oc + 2 * k2; wv[k2] = (unsigned)scr[pos16(p0) * 136 + dk] | ((unsigned)scr[pos16(p0 + 1) * 136 + dk] << 16); }
                u32x4 o; o.x = wv[0]; o.y = wv[1]; o.z = wv[2]; o.w = wv[3];
                *(u32x4*)(kt + (size_t)dk * 64 + 8 * oc) = o;
            }
        }
        LDS_WAIT(); asm volatile("" ::: "memory");
    }
}
__device__ __forceinline__ void ml_vt_item(const bf16* ML, int bh, int chunk, bf16* VT, LAS unsigned short* scr, int lane) {
    const int b = bh >> 2, h = bh & 3;
    const size_t row0 = (size_t)b * SEQ + 64 * chunk;
#pragma unroll
    for (int it = 0; it < 16; ++it) {
        const int r = 4 * it + (lane >> 4), ch = lane & 15;
        const u32x4 v = *(const u32x4*)(ML + (row0 + r) * 2048 + 1024 + h * 128 + 8 * ch);
        *(LAS u32x4*)(scr + r * 136 + 8 * ch) = v;
    }
    LDS_WAIT(); asm volatile("" ::: "memory");
    bf16* vt = VT + ((size_t)bh * 128 + chunk) * 8192;
#pragma unroll
    for (int u = 0; u < 2; ++u) {
        const int e = lane + 64 * u;
#pragma unroll
        for (int oc = 0; oc < 8; ++oc) {
            unsigned wv[4];
#pragma unroll
            for (int k2 = 0; k2 < 4; ++k2) { const int p0 = 8 * oc + 2 * k2; wv[k2] = (unsigned)scr[pos16(p0) * 136 + e] | ((unsigned)scr[pos16(p0 + 1) * 136 + e] << 16); }
            u32x4 o; o.x = wv[0]; o.y = wv[1]; o.z = wv[2]; o.w = wv[3];
            *(u32x4*)(vt + (size_t)e * 64 + 8 * oc) = o;
        }
    }
    LDS_WAIT(); asm volatile("" ::: "memory");
}
__device__ __forceinline__ void ml_gates_unit(int bh, const float* SB, const float* ibias, const float* fbias, float* GT, LAS unsigned char* lds, int tid) {
    const int b = bh >> 2, h = bh & 3;
    LAS float* gs = (LAS float*)lds; LAS float* am = gs + 128; LAS float* mpv = gs + 256;
    const float fb = fbias[h], ib = ibias[h];
    const int c = tid;
    const float* sp = SB + ((size_t)b * SEQ + 64 * c) * 32;
    float g = 0.f, amax = -INFINITY;
    if (tid < 128) {
        for (int i0 = 0; i0 < 64; i0 += 16) {
            float fv[16], iv[16];
#pragma unroll
            for (int k = 0; k < 16; ++k) { fv[k] = sp[(i0 + k) * 32 + 28 + h]; iv[k] = sp[(i0 + k) * 32 + 24 + h]; }
#pragma unroll
            for (int k = 0; k < 16; ++k) { const float f = fv[k] + fb; const float lf = fminf(f, 0.f) - log1pf(__expf(-fabsf(f))); g += lf; amax = fmaxf(amax, iv[k] + ib - g); }
        }
        gs[c] = g; am[c] = amax;
    }
    __syncthreads();
    if (tid == 0) { float m = 0.f; for (int k = 0; k < 128; ++k) { mpv[k] = m; m = gs[k] + fmaxf(m, am[k]); } }
    __syncthreads();
    if (tid < 128) {
        const float mp = mpv[c], mx = fmaxf(mp, amax);
        float* gt = GT + ((size_t)bh * 128 + c) * 384;
        float bc = 0.f, runmax = -INFINITY;
        for (int i0 = 0; i0 < 64; i0 += 16) {
            float fv[16], iv[16];
#pragma unroll
            for (int k = 0; k < 16; ++k) { fv[k] = sp[(i0 + k) * 32 + 28 + h]; iv[k] = sp[(i0 + k) * 32 + 24 + h]; }
#pragma unroll
            for (int k = 0; k < 16; ++k) {
                const int i = i0 + k;
                const float f = fv[k] + fb; const float lf = fminf(f, 0.f) - log1pf(__expf(-fabsf(f))); bc += lf;
                const float d = iv[k] + ib - bc;
                runmax = fmaxf(runmax, d);
                const float ei = -fmaxf(mp, runmax);
                gt[0 * 64 + i] = ei * LOG2E; gt[1 * 64 + i] = d * LOG2E; gt[2 * 64 + i] = __expf(mp + ei); gt[3 * 64 + i] = __expf(-bc + ei);
                gt[4 * 64 + pos16(i)] = __expf(d - mx);
            }
        }
        gt[5 * 64] = __expf(mp - mx);
    }
    __syncthreads();
}

constexpr int CH_Q = 0, CH_K = 16384, CH_KT = 32768, CH_VT = 49152, CH_TAB = 65536, CH_BUFSZ = 67584;
constexpr int CH_NP = 2 * CH_BUFSZ, CH_QN = CH_NP + 512, CH_END = CH_QN + 512;
__device__ __forceinline__ int qk_off(int row, int ch) { return row * 256 + ((ch ^ (row & 15)) << 4); }
__device__ __forceinline__ bf16x8 pack8r(const f32x16& x, int s2) { u32x4 p; p.x = cvtpk(x[8 * s2 + 0], x[8 * s2 + 1]); p.y = cvtpk(x[8 * s2 + 2], x[8 * s2 + 3]); p.z = cvtpk(x[8 * s2 + 4], x[8 * s2 + 5]); p.w = cvtpk(x[8 * s2 + 6], x[8 * s2 + 7]); return __builtin_bit_cast(bf16x8, p); }

struct ChainPtrs { const bf16 *QC, *KC, *KT, *VT; const float* GT; const bf16* ML; bf16* YB; };

__device__ __forceinline__ void ml_chain(int bh, const ChainPtrs& P, LAS unsigned char* lds, int tid) {
    const int lane = tid & 63, w = __builtin_amdgcn_readfirstlane(tid >> 6), r32 = lane & 31, hi = lane >> 5;
    const int b = bh >> 2, h = bh & 3;
    const bool slicew = w < 4;
    f32x16 C[4]; C[0] = f32x16{}; C[1] = f32x16{}; C[2] = f32x16{}; C[3] = f32x16{};
    LAS float* npv = (LAS float*)(lds + CH_NP);
    if (tid < 128) npv[tid] = 0.f;
    const bf16* q0 = P.QC + (size_t)bh * 128 * 8192; const bf16* k0 = P.KC + (size_t)bh * 128 * 8192;
    const bf16* kt0 = P.KT + (size_t)bh * 128 * 8192; const bf16* vt0 = P.VT + (size_t)bh * 128 * 8192;
    const float* gt0 = P.GT + (size_t)bh * 128 * 384;
    const int wl = w - 4;
    const unsigned voq = (unsigned)(((4 * wl + (lane >> 4)) * 128 + (((lane & 15) ^ ((4 * wl + (lane >> 4)) & 15)) << 3)) * 2);
    const unsigned vot = (unsigned)((((lane >> 3)) * 64 + (((lane & 7) ^ (lane >> 3)) << 3)) * 2);
#define CH_DMA(src, dstoff) __builtin_amdgcn_global_load_lds((const unsigned*)(src), (LAS unsigned*)(lds + (dstoff)), 16, 0, 0)
#define CH_LOAD(cc, par) do { if (!slicew) { const int bo_ = (par) * CH_BUFSZ; \
        const char* qb_ = (const char*)q0 + (size_t)(cc) * 16384; const char* kb_ = (const char*)k0 + (size_t)(cc) * 16384; \
        const char* tb_ = (const char*)kt0 + (size_t)(cc) * 16384 + wl * 4096; const char* vb_ = (const char*)vt0 + (size_t)(cc) * 16384 + wl * 4096; \
        _Pragma("unroll") for (int k = 0; k < 4; ++k) { \
            CH_DMA(qb_ + k * 4096 + voq, bo_ + CH_Q + (wl + 4 * k) * 1024); CH_DMA(kb_ + k * 4096 + voq, bo_ + CH_K + (wl + 4 * k) * 1024); \
            CH_DMA(tb_ + k * 1024 + vot, bo_ + CH_KT + (wl * 4 + k) * 1024); CH_DMA(vb_ + k * 1024 + vot, bo_ + CH_VT + (wl * 4 + k) * 1024); } \
        if (wl == 0) { CH_DMA(gt0 + (size_t)(cc) * 384 + lane * 4, bo_ + CH_TAB); if (lane < 32) CH_DMA(gt0 + (size_t)(cc) * 384 + 256 + lane * 4, bo_ + CH_TAB + 1024); } } } while (0)
    CH_LOAD(0, 0);
    __syncthreads();
    for (int c = 0; c < 128; ++c) {
        const int par = c & 1;
        LAS unsigned char* bufp = lds + par * CH_BUFSZ;
        LAS float* tab = (LAS float*)(bufp + CH_TAB);
        LAS float* qnv = (LAS float*)(lds + CH_QN) + par * 64;
        if (c + 1 < 128) CH_LOAD(c + 1, par ^ 1);
        f32x16 acc[2]; float denl[2] = {0.f, 0.f}; float scl[2] = {0.f, 0.f}, clp[2] = {1.f, 1.f};
        acc[0] = f32x16{}; acc[1] = f32x16{};
        if (slicew) {
            const int sl = w;
            f32x16 S00 = f32x16{}, S01 = f32x16{}, S11 = f32x16{};
            bf16x8 qa0 = *(const LAS bf16x8*)(bufp + CH_Q + qk_off(r32, hi)), qa1 = *(const LAS bf16x8*)(bufp + CH_Q + qk_off(32 + r32, hi));
            bf16x8 ka0 = *(const LAS bf16x8*)(bufp + CH_K + qk_off(r32, hi)), ka1 = *(const LAS bf16x8*)(bufp + CH_K + qk_off(32 + r32, hi));
#pragma unroll
            for (int s = 0; s < 8; ++s) {
                bf16x8 qb0 = qa0, qb1 = qa1, kb0 = ka0, kb1 = ka1;
                if (s < 7) {
                    qb0 = *(const LAS bf16x8*)(bufp + CH_Q + qk_off(r32, 2 * (s + 1) + hi)); qb1 = *(const LAS bf16x8*)(bufp + CH_Q + qk_off(32 + r32, 2 * (s + 1) + hi));
                    kb0 = *(const LAS bf16x8*)(bufp + CH_K + qk_off(r32, 2 * (s + 1) + hi)); kb1 = *(const LAS bf16x8*)(bufp + CH_K + qk_off(32 + r32, 2 * (s + 1) + hi));
                }
                const bf16x8 cf = pack8r(C[s >> 1], s & 1);
                acc[0] = __builtin_amdgcn_mfma_f32_32x32x16_bf16(cf, qa0, acc[0], 0, 0, 0);
                acc[1] = __builtin_amdgcn_mfma_f32_32x32x16_bf16(cf, qa1, acc[1], 0, 0, 0);
                S00 = __builtin_amdgcn_mfma_f32_32x32x16_bf16(ka0, qa0, S00, 0, 0, 0);
                S01 = __builtin_amdgcn_mfma_f32_32x32x16_bf16(ka0, qa1, S01, 0, 0, 0);
                S11 = __builtin_amdgcn_mfma_f32_32x32x16_bf16(ka1, qa1, S11, 0, 0, 0);
                __builtin_amdgcn_sched_barrier(0);
                qa0 = qb0; qa1 = qb1; ka0 = kb0; ka1 = kb1;
            }
            scl[0] = tab[2 * 64 + r32]; scl[1] = tab[2 * 64 + 32 + r32]; clp[0] = tab[3 * 64 + r32]; clp[1] = tab[3 * 64 + 32 + r32];
#pragma unroll
            for (int r = 0; r < 16; ++r) { acc[0][r] *= scl[0]; acc[1][r] *= scl[1]; }
            const float ei0 = tab[r32], ei1 = tab[32 + r32];
#pragma unroll
            for (int a = 0; a < 4; ++a) {
                const f32x4 d0 = *(const LAS f32x4*)(tab + 64 + 8 * a + 4 * hi);
                const f32x4 d1 = *(const LAS f32x4*)(tab + 64 + 32 + 8 * a + 4 * hi);
#pragma unroll
                for (int i = 0; i < 4; ++i) {
                    const int r = 4 * a + i, jl = 8 * a + 4 * hi + i;
                    const float w00 = S00[r] * __builtin_amdgcn_exp2f(ei0 + d0[i]);
                    const float w01 = S01[r] * __builtin_amdgcn_exp2f(ei1 + d0[i]);
                    const float w11 = S11[r] * __builtin_amdgcn_exp2f(ei1 + d1[i]);
                    S00[r] = jl <= r32 ? w00 : 0.f; S01[r] = w01; S11[r] = jl <= r32 ? w11 : 0.f;
                    denl[0] += S00[r]; denl[1] += S01[r] + S11[r];
                }
            }
            const float decay = tab[5 * 64];
#pragma unroll
            for (int t4 = 0; t4 < 4; ++t4)
#pragma unroll
                for (int r = 0; r < 16; ++r) C[t4][r] *= decay;
#pragma unroll
            for (int ks = 0; ks < 4; ++ks) {
                const bf16x8 vf = *(const LAS bf16x8*)(bufp + CH_VT + tile_off(32 * sl + r32, 2 * ks + hi));
                if (ks < 2) { acc[0] = __builtin_amdgcn_mfma_f32_32x32x16_bf16(vf, pack8r(S00, ks), acc[0], 0, 0, 0);
                              acc[1] = __builtin_amdgcn_mfma_f32_32x32x16_bf16(vf, pack8r(S01, ks), acc[1], 0, 0, 0); }
                else acc[1] = __builtin_amdgcn_mfma_f32_32x32x16_bf16(vf, pack8r(S11, ks - 2), acc[1], 0, 0, 0);
                const f32x4 sa = *(const LAS f32x4*)(tab + 4 * 64 + 16 * ks + 8 * hi), sb = *(const LAS f32x4*)(tab + 4 * 64 + 16 * ks + 8 * hi + 4);
                const u32x4 vw = __builtin_bit_cast(u32x4, vf);
                u32x4 sv; sv.x = cvtpk(bflo(vw.x) * sa[0], bfhi(vw.x) * sa[1]); sv.y = cvtpk(bflo(vw.y) * sa[2], bfhi(vw.y) * sa[3]);
                sv.z = cvtpk(bflo(vw.z) * sb[0], bfhi(vw.z) * sb[1]); sv.w = cvtpk(bflo(vw.w) * sb[2], bfhi(vw.w) * sb[3]);
                const bf16x8 svf = __builtin_bit_cast(bf16x8, sv);
#pragma unroll
                for (int t4 = 0; t4 < 4; ++t4) {
                    const bf16x8 ktf = *(const LAS bf16x8*)(bufp + CH_KT + tile_off(32 * t4 + r32, 2 * ks + hi));
                    C[t4] = __builtin_amdgcn_mfma_f32_32x32x16_bf16(ktf, svf, C[t4], 0, 0, 0);
                }
                __builtin_amdgcn_sched_barrier(0);
            }
            denl[0] += __shfl_xor(denl[0], 32); denl[1] += __shfl_xor(denl[1], 32);
        } else if (w == 4) {
            float qn = 0.f;
#pragma unroll
            for (int ch = 0; ch < 16; ++ch) {
                const u32x4 qv = *(const LAS u32x4*)(bufp + CH_Q + qk_off(lane, ch));
                const f32x4 n0 = *(const LAS f32x4*)(npv + 8 * ch), n1 = *(const LAS f32x4*)(npv + 8 * ch + 4);
                qn += bflo(qv.x) * n0[0] + bfhi(qv.x) * n0[1] + bflo(qv.y) * n0[2] + bfhi(qv.y) * n0[3] + bflo(qv.z) * n1[0] + bfhi(qv.z) * n1[1] + bflo(qv.w) * n1[2] + bfhi(qv.w) * n1[3];
            }
            qnv[lane] = qn;
            const float decay = tab[5 * 64];
            float nn[2];
#pragma unroll
            for (int u = 0; u < 2; ++u) {
                const int dk = lane + 64 * u;
                float a = 0.f;
#pragma unroll
                for (int ch = 0; ch < 8; ++ch) {
                    const u32x4 kv = *(const LAS u32x4*)(bufp + CH_KT + tile_off(dk, ch));
                    const f32x4 s0 = *(const LAS f32x4*)(tab + 4 * 64 + 8 * ch), s1 = *(const LAS f32x4*)(tab + 4 * 64 + 8 * ch + 4);
                    a += bflo(kv.x) * s0[0] + bfhi(kv.x) * s0[1] + bflo(kv.y) * s0[2] + bfhi(kv.y) * s0[3] + bflo(kv.z) * s1[0] + bfhi(kv.z) * s1[1] + bflo(kv.w) * s1[2] + bfhi(kv.w) * s1[3];
                }
                nn[u] = decay * npv[pos16(dk)] + a;
            }
            LDS_WAIT(); asm volatile("" ::: "memory");
            npv[pos16(lane)] = nn[0]; npv[pos16(lane + 64)] = nn[1];
        }
        __syncthreads();
        if (slicew) {
            const int sl = w;
#pragma unroll
            for (int ih = 0; ih < 2; ++ih) {
                const int i = 32 * ih + r32;
                const float den = denl[ih] + scl[ih] * qnv[i];
                const float rdn = 1.f / fmaxf(fabsf(den), clp[ih]);
                const size_t row = (size_t)b * SEQ + 64 * c + i;
                const bf16* op = P.ML + row * 2048 + 1536 + 128 * h + 32 * sl + 4 * hi;
                bf16* yp = P.YB + row * 512 + 128 * h + 32 * sl + 4 * hi;
#pragma unroll
                for (int a = 0; a < 4; ++a) {
                    const u32x2 ov = *(const u32x2*)(op + 8 * a);
                    const float o0 = 1.f / (1.f + __expf(-bflo(ov.x))), o1 = 1.f / (1.f + __expf(-bfhi(ov.x))), o2 = 1.f / (1.f + __expf(-bflo(ov.y))), o3 = 1.f / (1.f + __expf(-bfhi(ov.y)));
                    u32x2 yv; yv.x = cvtpk(acc[ih][4 * a] * rdn * o0, acc[ih][4 * a + 1] * rdn * o1); yv.y = cvtpk(acc[ih][4 * a + 2] * rdn * o2, acc[ih][4 * a + 3] * rdn * o3);
                    *(u32x2*)(yp + 8 * a) = yv;
                }
            }
        }
    }
    __syncthreads();
#undef CH_LOAD
#undef CH_DMA
}
struct Args { const float* in[26]; float* out; unsigned char* ws; int ph_lo, ph_hi; };

__global__ void __launch_bounds__(NWAVES * 64, 2) mk_fwd(Args args) {
    extern __shared__ __attribute__((aligned(16))) unsigned char lds_raw[];
    LAS unsigned char* lds = (LAS unsigned char*)lds_raw;
    const int tid = threadIdx.x, lane = tid & 63, wave = __builtin_amdgcn_readfirstlane(tid >> 6);
    const int G = gridDim.x; const int bx = blockIdx.x;
    const int vcu = (G % 8 == 0) ? (bx % 8) * (G / 8) + bx / 8 : bx;
    unsigned char* ws = args.ws;
    const float* x = args.in[0];
    bf16* WinT = (bf16*)(ws + WS_WIN); bf16* WaT = (bf16*)(ws + WS_WA); bf16* WbT = (bf16*)(ws + WS_WB); bf16* WoT = (bf16*)(ws + WS_WO);
    bf16* W1T = (bf16*)(ws + WS_W1); bf16* W2T = (bf16*)(ws + WS_W2);
    bf16* XN = (bf16*)(ws + WS_XN); bf16* QN = (bf16*)(ws + WS_QN); bf16* KV = (bf16*)(ws + WS_KV); bf16* ML = (bf16*)(ws + WS_ML); bf16* GB = (bf16*)(ws + WS_G);
    float* SB = (float*)(ws + WS_S); bf16* YA = (bf16*)(ws + WS_YA); bf16* YB = (bf16*)(ws + WS_YB); bf16* MX = (bf16*)(ws + WS_MX); bf16* UB = (bf16*)(ws + WS_U);
    float* rowss = (float*)(ws + WS_CTL + CTL_ROWSS);
    bf16* CK1T = (bf16*)(ws + WS_CK1); bf16* CV1T = (bf16*)(ws + WS_CV1); bf16* CK2T = (bf16*)(ws + WS_SMALL); bf16* CV2T = (bf16*)(ws + WS_SMALL + 32768);
    float* B1K = (float*)(ws + WS_SMALL + 65536); float* B1V = (float*)(ws + WS_SMALL + 65536 + 1024); float* BOUNDS = (float*)(ws + WS_SMALL + 65536 + 2048);
    bf16* KSN = (bf16*)(ws + WS_KSN); bf16* KWN = (bf16*)(ws + WS_KWN); bf16* VST = (bf16*)(ws + WS_VST); bf16* VWT = (bf16*)(ws + WS_VWT); bf16* KCN = (bf16*)(ws + WS_KCN); bf16* VCT = (bf16*)(ws + WS_VCT);
    bf16* QCb = (bf16*)args.out; bf16* KCb = QCb + (size_t)16 * 128 * 8192; bf16* KTb = KCb + (size_t)16 * 128 * 8192; bf16* VTb = KTb + (size_t)16 * 128 * 8192;
    float* GTb = (float*)(ws + WS_GT);
    const int lo = args.ph_lo, hi = args.ph_hi;
#define IN(k) (lo <= (k) && (k) < hi)

    if (IN(0)) {
        LAS float* scr = (LAS float*)(lds + wave * 16384);
        const int gw = vcu * NWAVES + wave, NGW = G * NWAVES;
        constexpr int I_IN = (1024 / 64) * (NP_PAD / 32), I_A = (512 / 64) * (1024 / 32), I_O = (1024 / 64) * (1024 / 32), I_1 = (1024 / 64) * (4096 / 32), I_2 = (4096 / 64) * (1024 / 32);
        constexpr int I_C1 = (2048 / 64) * (256 / 32), I_C2 = (256 / 64) * (64 / 32), I_B1 = 512;
        constexpr int NITEMS = I_IN + 2 * I_A + I_O + I_1 + I_2 + 2 * I_C1 + 2 * I_C2 + I_B1 + 1;
        for (int it = gw; it < NITEMS; it += NGW) {
            int r = it;
            if (r < I_IN) { transpose_item<true>(args.in[2], 1024, D_PROJ, args.in[1], WinT, NP_PAD, scr, r, lane); continue; } r -= I_IN;
            if (r < I_A) { transpose_item<false>(args.in[20], 512, 1024, nullptr, WaT, 1024, scr, r, lane); continue; } r -= I_A;
            if (r < I_A) { transpose_item<false>(args.in[21], 512, 1024, nullptr, WbT, 1024, scr, r, lane); continue; } r -= I_A;
            if (r < I_O) { transpose_item<false>(args.in[22], 1024, 1024, nullptr, WoT, 1024, scr, r, lane); continue; } r -= I_O;
            if (r < I_1) { transpose_item<false>(args.in[24], 1024, 4096, args.in[23], W1T, 4096, scr, r, lane); continue; } r -= I_1;
            if (r < I_2) { transpose_item<false>(args.in[25], 4096, 1024, nullptr, W2T, 1024, scr, r, lane); continue; } r -= I_2;
            if (r < I_C1) { transpose_item<false>(args.in[6], 2048, 256, nullptr, CK1T, 256, scr, r, lane); continue; } r -= I_C1;
            if (r < I_C1) { transpose_item<false>(args.in[11], 2048, 256, nullptr, CV1T, 256, scr, r, lane); continue; } r -= I_C1;
            if (r < I_C2) { transpose_item<false>(args.in[8], 256, 64, nullptr, CK2T, 64, scr, r, lane); continue; } r -= I_C2;
            if (r < I_C2) { transpose_item<false>(args.in[13], 256, 64, nullptr, CV2T, 64, scr, r, lane); continue; } r -= I_C2;
            if (r < I_B1) {
                const int kv = r >> 8, u = r & 255; const float* pos = args.in[kv ? 10 : 5]; const float* w1 = args.in[kv ? 11 : 6]; const float* b1 = args.in[kv ? 12 : 7];
                float a = 0.f;
                for (int i = lane; i < 2048; i += 64) a += pos[i] * w1[(size_t)i * 256 + u];
                a = wave_sum(a);
                if (lane == 0) (kv ? B1V : B1K)[u] = a + b1[u];
                continue; } r -= I_B1;
            {
                float gq = fabsf(args.in[3][lane]); float gk = fmaxf(fmaxf(fabsf(args.in[4][lane]), fabsf(args.in[4][64 + lane])), fabsf(args.in[4][128 + lane]));
                gq = wave_max(gq); gk = wave_max(gk);
                if (lane < 8) { float mb = -1e30f; for (int bk = 0; bk < 32; ++bk) mb = fmaxf(mb, args.in[15][bk * 8 + lane]); BOUNDS[lane] = 8.f * gq * gk + mb; }
            }
        }
        for (int m = gw; m < NTOK; m += NGW) rms_row_to_bf16(x + (size_t)m * D_MODEL, XN + (size_t)m * D_MODEL, lane);
    }
    if (IN(1)) {
        pg8::Gemm g{XN, WinT, NTOK, NP_PAD, 1024}; pg8::StaticOrder S; S.init(NTOK, NP_PAD, G, bx);
        pg8::EpiProj E{QN, KV, ML, GB, SB};
        pg8::gemm_phase<pg8::EpiProj, pg8::StaticOrder, true, true>(lds, g, S, E);
    }
    if (IN(2)) {
        if (bx < 16) ml_gates_unit(bx, SB, args.in[18], args.in[19], GTb, lds, tid);
        LAS unsigned short* scr = (LAS unsigned short*)(lds + wave * 17408);
        const int gw = vcu * NWAVES + wave, NGW = G * NWAVES;
        const float* kgain = args.in[4];
        for (int it = gw; it < 6144; it += NGW) {
            const int kind = it % 3, bc = it / 3, bh = bc >> 7, chunk = bc & 127;
            if (kind < 2) ml_conv_item(ML, args.in[16], args.in[17], kind, bh, chunk, kind ? KCb : QCb, KTb, scr, lane);
            else ml_vt_item(ML, bh, chunk, VTb, scr, lane);
        }
        for (int it = gw; it < 4096; it += NGW) {
            const int kind = it & 3, bgj = it >> 2, bg = bgj >> 7, j = bgj & 127, b = bg >> 1, g = bg & 1;
            const size_t tok0 = (size_t)b * SEQ + 64 * j;
            if (kind == 0) knorm_item(KV, 256 + 64 * g, kgain + 64, KSN + ((size_t)bg * SEQ + 64 * j) * 64, tok0, lane);
            else if (kind == 1) knorm_item(KV, 512 + 64 * g, kgain + 128, KWN + ((size_t)bg * SEQ + 64 * j) * 64, tok0, lane);
            else if (kind == 2) vtrans_item(KV, 384 + 64 * g, VST + ((size_t)bg * 128 + j) * 4096, tok0, scr, lane);
            else vtrans_item(KV, 640 + 64 * g, VWT + ((size_t)bg * 128 + j) * 4096, tok0, scr, lane);
        }
        __syncthreads();
        for (int u = bx; u < 128; u += G) {
            const int kvs = u & 1;
            compress_unit(u, KV, kvs ? CV1T : CK1T, kvs ? CV2T : CK2T, kvs ? B1V : B1K, args.in[kvs ? 14 : 9], kgain, KCN, VCT, lds, tid);
        }
    }
    if (IN(3)) {
        if (bx < 16) { ChainPtrs CP{QCb, KCb, KTb, VTb, GTb, ML, YB}; ml_chain(bx, CP, lds, tid); }
        EngPtrs P{QN, KCN, VCT, KSN, VST, KWN, VWT, SB, args.in[15], args.in[3], BOUNDS, YA};
        unsigned* qctr = (unsigned*)(ws + WS_CTL + CTL_QCTR);
        LAS int* misc = (LAS int*)(lds + ENG_MISC);
        for (;;) {
            __syncthreads();
            if (tid == 0) misc[0] = (int)atomicAdd(qctr, 1u);
            __syncthreads();
            const int u = misc[0];
            if (u >= 1024) break;
            eng_unit(u, P, lds, tid);
        }
    }
    if (IN(4)) {
        pg8::Gemm g{YA, WaT, NTOK, 1024, 512}; pg8::StaticOrder S; S.init(NTOK, 1024, G, bx);
        pg8::EpiGate<false> E{GB, 0, MX};
        pg8::gemm_phase<pg8::EpiGate<false>, pg8::StaticOrder, true, true>(lds, g, S, E);
    }
    if (IN(5)) {
        pg8::Gemm g{YB, WbT, NTOK, 1024, 512}; pg8::StaticOrder S; S.init(NTOK, 1024, G, bx);
        pg8::EpiGate<true> E{GB, 1024, MX};
        pg8::gemm_phase<pg8::EpiGate<true>, pg8::StaticOrder, true, true>(lds, g, S, E);
    }
    if (IN(6)) {
        pg8::Gemm g{MX, WoT, NTOK, 1024, 1024}; pg8::StaticOrder S; S.init(NTOK, 1024, G, bx);
        pg8::EpiOut E{x, args.out, XN, rowss};
        pg8::gemm_phase<pg8::EpiOut, pg8::StaticOrder, true, true>(lds, g, S, E);
    }
    if (IN(7)) {
        pg8::Gemm g{XN, W1T, NTOK, 4096, 1024}; pg8::StaticOrder S; S.init(NTOK, 4096, G, bx);
        pg8::EpiFF1 E{rowss, UB};
        pg8::gemm_phase<pg8::EpiFF1, pg8::StaticOrder, true, true>(lds, g, S, E);
    }
    if (IN(8)) {
        pg8::Gemm g{UB, W2T, NTOK, 1024, 4096}; pg8::StaticOrder S; S.init(NTOK, 1024, G, bx);
        pg8::EpiFF2 E{args.out};
        pg8::gemm_phase<pg8::EpiFF2, pg8::StaticOrder, true, true>(lds, g, S, E);
    }
#undef IN
}

static void launch_phase(hipStream_t st, Args a, int lo, int hi, int grid) {
    a.ph_lo = lo; a.ph_hi = hi;
    hipLaunchKernelGGL(mk_fwd, dim3(grid), dim3(NWAVES * 64), LDS_BYTES, st, a);
}

extern "C" void kernel_launch(void* const* d_in, const int* in_sizes, int n_in, void* d_out, int out_size, void* d_ws, size_t ws_size, hipStream_t stream) {
    static int grid = 0;
    if (grid == 0) {
        int dev = 0, cus = 0;
        if (hipGetDevice(&dev) != hipSuccess || hipDeviceGetAttribute(&cus, hipDeviceAttributeMultiprocessorCount, dev) != hipSuccess) { grid = -1; return; }
        if (hipFuncSetAttribute((const void*)mk_fwd, hipFuncAttributeMaxDynamicSharedMemorySize, LDS_BYTES) != hipSuccess) { fprintf(stderr, "hipFuncSetAttribute failed\n"); grid = -1; return; }
        if (ws_size < WS_END) { fprintf(stderr, "workspace too small: %zu < %zu\n", ws_size, (size_t)WS_END); grid = -1; return; }
        grid = cus;
    }
    if (grid < 0) return;
    (void)hipMemsetAsync((char*)d_ws + WS_CTL, 0, CTL_ZERO_BYTES, stream);
    Args a{};
    for (int i = 0; i < 26; ++i) a.in[i] = (const float*)d_in[i];
    a.out = (float*)d_out; a.ws = (unsigned char*)d_ws;
    for (int ph = 0; ph < 9; ++ph) launch_phase(stream, a, ph, ph + 1, grid);
}
```

```cpp
#include <hip/hip_runtime.h>
#include <cstdint>
#include <cstdio>
#include <hip/hip_cooperative_groups.h>
namespace cg = cooperative_groups;
namespace pg8 {
#define PG8_LAS __attribute__((address_space(3)))
typedef unsigned short bf16_t;
typedef short bf16x8 __attribute__((ext_vector_type(8)));
typedef float f32x4 __attribute__((ext_vector_type(4)));
typedef unsigned u32x4 __attribute__((ext_vector_type(4)));
constexpr int BM = 256, BK = 64, HALF = 128, HTB = HALF * BK * 2  , STAGE_BYTES = 8 * HTB, NXCD = 8, WGM = 8;

__host__ __device__ __forceinline__ int lds_byte(int r, int c) { const int st = (r >> 4) * 2 + (c >> 5), rr = r & 15, cc = c & 31, ob = rr * 64 + cc * 2; return st * 1024 + (ob ^ (((ob >> 9) & 1) << 5)); }
__host__ __device__ __forceinline__ void stage_rc(int b, int& R, int& C) { const int st = b / 1024, sb = b % 1024, swz = sb ^ (((sb >> 9) & 1) << 5); R = (st >> 1) * 16 + swz / 64; C = (st & 1) * 32 + (swz % 64) / 2; }
__host__ __device__ __forceinline__ int perm32(int rho) { const int n = rho >> 4, i = rho & 15; return 8 * (i >> 2) + 4 * n + (i & 3); }

struct Unit { int pm, pn; };
struct Gemm { const bf16_t* A; const bf16_t* Bt; int M, N, K; };

struct StaticOrder {
    int nM, nN, nwg, G, c;
    __host__ __device__ void init(int M, int N, int G_, int c_) { nM = M / BM; nN = N / BM; nwg = nM * nN; G = G_; c = c_; }
    __host__ __device__ bool next(int i, Unit& u) const {
        const long L = (long)i * G + c; if (L >= nwg) return false;
        int wgid = (int)L; { const int q = nwg / NXCD, r = nwg % NXCD, xcd = wgid % NXCD, off = wgid / NXCD; wgid = (xcd < r ? xcd * (q + 1) : r * (q + 1) + (xcd - r) * q) + off; }
        const int nig = WGM * nN, gid = wgid / nig, fm = gid * WGM, gsz = (nM - fm) < WGM ? (nM - fm) : WGM;
        u.pm = fm + ((wgid % nig) % gsz); u.pn = (wgid % nig) / gsz; return true;
    }
    __device__ __forceinline__ void a_ready(const Unit&) const {}
    __device__ __forceinline__ void done(const Unit&) const {}
};
__device__ __forceinline__ unsigned cvt_pk_bf16(float lo, float hi) { unsigned r; asm volatile("v_cvt_pk_bf16_f32 %0, %1, %2" : "=v"(r) : "v"(lo), "v"(hi)); return r; }
__device__ __forceinline__ float bf_lo(unsigned w) { return __uint_as_float(w << 16); }
__device__ __forceinline__ float bf_hi(unsigned w) { return __uint_as_float(w & 0xffff0000u); }
__device__ __forceinline__ float fsigmoid(float v) { return __builtin_amdgcn_rcpf(1.f + __builtin_amdgcn_exp2f(-1.4426950408889634f * v)); }
__device__ __forceinline__ u32x4 pack8(const f32x4 v0, const f32x4 v1) { u32x4 w; w.x = cvt_pk_bf16(v0[0], v0[1]); w.y = cvt_pk_bf16(v0[2], v0[3]); w.z = cvt_pk_bf16(v1[0], v1[1]); w.w = cvt_pk_bf16(v1[2], v1[3]); return w; }

struct EpiProj {
    static constexpr bool PERM = true, AFTER_DRAIN = false;
    bf16_t *Qn, *KV, *ML, *G; float* S;
    __device__ __forceinline__ void operator()(const f32x4 (&acc)[2][2][4][2], const Unit& u, int wr, int wc, int fr, int fq) const {
        const int pn = u.pn, row0 = u.pm * BM + wr * 64 + fr;
        if (pn == 21) {
            if (wc == 0) {
#pragma unroll
                for (int ai = 0; ai < 2; ++ai)
#pragma unroll
                    for (int m = 0; m < 4; ++m) { float* p = S + (size_t)(row0 + ai * HALF + m * 16) * 32 + 8 * fq; *(f32x4*)p = acc[ai][0][m][0]; *(f32x4*)(p + 4) = acc[ai][0][m][1]; }
            }
            return;
        }
        bf16_t* base; int ld, ct; bool sig = false;
        if (pn < 2) { base = Qn; ld = 512; ct = pn; }
        else if (pn < 5) { base = KV; ld = 768; ct = pn - 2; }
        else if (pn < 13) { base = ML; ld = 2048; ct = pn - 5; sig = (pn >= 11); }
        else { base = G; ld = 2048; ct = pn - 13; sig = true; }
        const int col0 = ct * 256 + wc * 32 + 8 * fq;
#pragma unroll
        for (int ai = 0; ai < 2; ++ai)
#pragma unroll
            for (int m = 0; m < 4; ++m) { bf16_t* rowp = base + (size_t)(row0 + ai * HALF + m * 16) * ld + col0;
#pragma unroll
                for (int bj = 0; bj < 2; ++bj) { f32x4 v0 = acc[ai][bj][m][0], v1 = acc[ai][bj][m][1];
                    if (sig) {
#pragma unroll
                        for (int i = 0; i < 4; ++i) { v0[i] = fsigmoid(v0[i]); v1[i] = fsigmoid(v1[i]); } }
                    *(u32x4*)(rowp + bj * HALF) = pack8(v0, v1); } }
    }
};
template <bool ACCUM> struct EpiGate {
    static constexpr bool PERM = true, AFTER_DRAIN = false;
    const bf16_t* G; int gcol0; bf16_t* Mx;
    __device__ __forceinline__ void operator()(const f32x4 (&acc)[2][2][4][2], const Unit& u, int wr, int wc, int fr, int fq) const {
        const int row0 = u.pm * BM + wr * 64 + fr, col0 = u.pn * BM + wc * 32 + 8 * fq;
#pragma unroll
        for (int ai = 0; ai < 2; ++ai)
#pragma unroll
            for (int m = 0; m < 4; ++m) { const size_t row = (size_t)(row0 + ai * HALF + m * 16);
#pragma unroll
                for (int bj = 0; bj < 2; ++bj) {
                    const u32x4 g = *(const u32x4*)(G + row * 2048 + gcol0 + col0 + bj * HALF);
                    f32x4 v0 = acc[ai][bj][m][0], v1 = acc[ai][bj][m][1];
                    v0[0] *= bf_lo(g.x); v0[1] *= bf_hi(g.x); v0[2] *= bf_lo(g.y); v0[3] *= bf_hi(g.y);
                    v1[0] *= bf_lo(g.z); v1[1] *= bf_hi(g.z); v1[2] *= bf_lo(g.w); v1[3] *= bf_hi(g.w);
                    bf16_t* mp = Mx + row * 1024 + col0 + bj * HALF;
                    if (ACCUM) { const u32x4 o = *(const u32x4*)mp;
                        v0[0] += bf_lo(o.x); v0[1] += bf_hi(o.x); v0[2] += bf_lo(o.y); v0[3] += bf_hi(o.y);
                        v1[0] += bf_lo(o.z); v1[1] += bf_hi(o.z); v1[2] += bf_lo(o.w); v1[3] += bf_hi(o.w); }
                    *(u32x4*)mp = pack8(v0, v1); } }
    }
};
struct EpiOut {
    static constexpr bool PERM = true, AFTER_DRAIN = false;
    const float* x; float* x1; bf16_t* x1b; float* rowss;
    __device__ __forceinline__ void operator()(const f32x4 (&acc)[2][2][4][2], const Unit& u, int wr, int wc, int fr, int fq) const {
        const int row0 = u.pm * BM + wr * 64 + fr, col0 = u.pn * BM + wc * 32 + 8 * fq;
#pragma unroll
        for (int ai = 0; ai < 2; ++ai)
#pragma unroll
            for (int m = 0; m < 4; ++m) { const size_t row = (size_t)(row0 + ai * HALF + m * 16); float ss = 0.f;
#pragma unroll
                for (int bj = 0; bj < 2; ++bj) { const size_t off = row * 1024 + col0 + bj * HALF;
                    const f32x4 v0 = acc[ai][bj][m][0] + *(const f32x4*)(x + off), v1 = acc[ai][bj][m][1] + *(const f32x4*)(x + off + 4);
                    *(f32x4*)(x1 + off) = v0; *(f32x4*)(x1 + off + 4) = v1; *(u32x4*)(x1b + off) = pack8(v0, v1);
                    ss += (v0[0] * v0[0] + v0[1] * v0[1]) + (v0[2] * v0[2] + v0[3] * v0[3]) + (v1[0] * v1[0] + v1[1] * v1[1]) + (v1[2] * v1[2] + v1[3] * v1[3]); }
                ss += __shfl_xor(ss, 16); ss += __shfl_xor(ss, 32);
                if (fq == 0) atomicAdd(rowss + row, ss); }
    }
};
struct EpiFF1 {
    static constexpr bool PERM = true, AFTER_DRAIN = false;
    const float* rowss; bf16_t* U;
    __device__ __forceinline__ void operator()(const f32x4 (&acc)[2][2][4][2], const Unit& u, int wr, int wc, int fr, int fq) const {
        const int row0 = u.pm * BM + wr * 64 + fr, col0 = u.pn * BM + wc * 32 + 8 * fq;
#pragma unroll
        for (int ai = 0; ai < 2; ++ai)
#pragma unroll
            for (int m = 0; m < 4; ++m) { const size_t row = (size_t)(row0 + ai * HALF + m * 16);
                const float rs = 1.0f / sqrtf(rowss[row] * (1.f / 1024.f) + 1e-6f);
#pragma unroll
                for (int bj = 0; bj < 2; ++bj) { f32x4 v0 = acc[ai][bj][m][0] * rs, v1 = acc[ai][bj][m][1] * rs;
#pragma unroll
                    for (int i = 0; i < 4; ++i) { const float a = fmaxf(v0[i], 0.f), b = fmaxf(v1[i], 0.f); v0[i] = a * a; v1[i] = b * b; }
                    *(u32x4*)(U + row * 4096 + col0 + bj * HALF) = pack8(v0, v1); } }
    }
};
struct EpiFF2 {
    static constexpr bool PERM = true, AFTER_DRAIN = false;
    float* out;
    __device__ __forceinline__ void operator()(const f32x4 (&acc)[2][2][4][2], const Unit& u, int wr, int wc, int fr, int fq) const {
        const int row0 = u.pm * BM + wr * 64 + fr, col0 = u.pn * BM + wc * 32 + 8 * fq;
#pragma unroll
        for (int ai = 0; ai < 2; ++ai)
#pragma unroll
            for (int m = 0; m < 4; ++m) { const size_t row = (size_t)(row0 + ai * HALF + m * 16);
#pragma unroll
                for (int bj = 0; bj < 2; ++bj) { float* p = out + row * 1024 + col0 + bj * HALF;
                    const f32x4 v0 = acc[ai][bj][m][0] + *(const f32x4*)p, v1 = acc[ai][bj][m][1] + *(const f32x4*)(p + 4);
                    *(f32x4*)p = v0; *(f32x4*)(p + 4) = v1; } }
    }
};
template <class Epi, class Sched, bool ALIGN_EPI = false, bool SP2 = false>
__device__ __forceinline__ void gemm_phase(PG8_LAS unsigned char* lds, const Gemm g, const Sched& S, const Epi& E) {
    const int tid = threadIdx.x, wid = __builtin_amdgcn_readfirstlane(tid >> 6), lane = tid & 63, wr = wid >> 2, wc = wid & 3, fr = lane & 15, fq = lane >> 4;
    const int K = g.K, nt = K / BK;
    unsigned voffA[2], voffB[2];
#pragma unroll
    for (int i = 0; i < 2; ++i) { int R, C; stage_rc(tid * 16 + i * 8192, R, C); const int Rb = Epi::PERM ? ((R & ~31) + perm32(R & 31)) : R;
        voffA[i] = (unsigned)(R * K + C) * 2u; voffB[i] = (unsigned)(Rb * K + C) * 2u; }
    const size_t kstep = (size_t)(BK * 2);
    const size_t hstep = (size_t)HALF * K * 2;
    const size_t tstep = 2 * hstep;
    const unsigned ldsw = (unsigned)wid * 1024u;
    const int aoff = lds_byte(wr * 64 + fr, fq * 8), boff = lds_byte(wc * 32 + fr, fq * 8);
#define PG8_SA(b, h) (((b) * 2 + (h)) * HTB)
#define PG8_SB(b, h) ((4 + (b) * 2 + (h)) * HTB)
#define PG8_STAGE(bufoff, gbase, voff) do { _Pragma("unroll") for (int _i = 0; _i < 2; ++_i) \
        __builtin_amdgcn_global_load_lds((const unsigned*)((const char*)(gbase) + (voff)[_i]), (PG8_LAS unsigned*)(lds + (bufoff) + ldsw + _i * 8192), 16, 0, 0); } while (0)
#define PG8_LDA(dst, b, h) do { _Pragma("unroll") for (int m = 0; m < 4; ++m) _Pragma("unroll") for (int k = 0; k < 2; ++k) dst[m][k] = *(const PG8_LAS bf16x8*)(lds + PG8_SA(b, h) + aoff + m * 2048 + k * 1024); } while (0)
#define PG8_LDB(dst, b, h) do { _Pragma("unroll") for (int n = 0; n < 2; ++n) _Pragma("unroll") for (int k = 0; k < 2; ++k) dst[n][k] = *(const PG8_LAS bf16x8*)(lds + PG8_SB(b, h) + boff + n * 2048 + k * 1024); } while (0)
#define PG8_MMA(ai, bj, At, Bt) do { __builtin_amdgcn_s_setprio(1); _Pragma("unroll") for (int m = 0; m < 4; ++m) _Pragma("unroll") for (int n = 0; n < 2; ++n) _Pragma("unroll") for (int k = 0; k < 2; ++k) \
        acc[ai][bj][m][n] = __builtin_amdgcn_mfma_f32_16x16x32_bf16(Bt[n][k], At[m][k], acc[ai][bj][m][n], 0, 0, 0); __builtin_amdgcn_s_setprio(0); } while (0)
#define PG8_WAIT_V(n) asm volatile("s_waitcnt vmcnt(" #n ")" ::: "memory")
#define PG8_WAIT_L(n) asm volatile("s_waitcnt lgkmcnt(" #n ")" ::: "memory")
#define PG8_BAR __builtin_amdgcn_s_barrier()
#define PG8_SCHED __builtin_amdgcn_sched_barrier(0)
    Unit cur, nxt; int ui = 0;
    if (!S.next(0, cur)) return;
    f32x4 acc[2][2][4][2];
#pragma unroll
    for (int a = 0; a < 2; ++a)
#pragma unroll
        for (int b = 0; b < 2; ++b)
#pragma unroll
            for (int m = 0; m < 4; ++m)
#pragma unroll
                for (int n = 0; n < 2; ++n) acc[a][b][m][n] = (f32x4){0.f, 0.f, 0.f, 0.f};
    bf16x8 At[4][2], B0[2][2], B1[2][2];
    const char* cA = (const char*)g.A + (size_t)cur.pm * tstep; const char* cB = (const char*)g.Bt + (size_t)cur.pn * tstep;
    S.a_ready(cur);
    if constexpr (SP2) {
        PG8_STAGE(PG8_SB(0, 0), cB, voffB); PG8_STAGE(PG8_SB(0, 1), cB + hstep, voffB); PG8_STAGE(PG8_SA(0, 0), cA, voffA); PG8_STAGE(PG8_SA(0, 1), cA + hstep, voffA);
        if (wr == 1) PG8_BAR;
        PG8_WAIT_V(2); PG8_BAR;
        PG8_STAGE(PG8_SB(1, 0), cB + kstep, voffB); PG8_STAGE(PG8_SA(1, 0), cA + kstep, voffA); PG8_STAGE(PG8_SB(1, 1), cB + hstep + kstep, voffB);
        PG8_WAIT_V(6); PG8_BAR;
    } else {
        PG8_STAGE(PG8_SB(0, 0), cB, voffB); PG8_STAGE(PG8_SA(0, 0), cA, voffA); PG8_STAGE(PG8_SB(0, 1), cB + hstep, voffB); PG8_STAGE(PG8_SA(0, 1), cA + hstep, voffA);
        if (wr == 1) PG8_BAR;
        PG8_WAIT_V(4); PG8_BAR;
        PG8_STAGE(PG8_SB(1, 0), cB + kstep, voffB); PG8_STAGE(PG8_SA(1, 0), cA + kstep, voffA); PG8_STAGE(PG8_SB(1, 1), cB + hstep + kstep, voffB);
        PG8_WAIT_V(6); PG8_BAR;
    }
    for (;;) {
        const bool has_next = S.next(ui + 1, nxt);
        const char* nA = has_next ? (const char*)g.A + (size_t)nxt.pm * tstep : cA; const char* nB = has_next ? (const char*)g.Bt + (size_t)nxt.pn * tstep : cB;
        for (int t = 0; t < nt; t += 2) {
            const bool last = (t == nt - 2);
            const char* a1 = cA + (size_t)(t + 1) * kstep;
            const char* a2 = last ? nA : cA + (size_t)(t + 2) * kstep; const char* b2 = last ? nB : cB + (size_t)(t + 2) * kstep;
            const char* a3 = a2 + kstep; const char* b3 = b2 + kstep;
            if (last && has_next) S.a_ready(nxt);
            if constexpr (SP2) {
            PG8_LDB(B0, 0, 0); PG8_LDB(B1, 0, 1); PG8_SCHED; PG8_LDA(At, 0, 0); PG8_STAGE(PG8_SA(1, 1), a1 + hstep, voffA);
            PG8_WAIT_V(8); PG8_WAIT_L(0); PG8_BAR; PG8_MMA(0, 0, At, B0); PG8_MMA(0, 1, At, B1); PG8_BAR; PG8_SCHED;
            PG8_LDA(At, 0, 1); PG8_STAGE(PG8_SB(0, 0), b2, voffB); PG8_STAGE(PG8_SB(0, 1), b2 + hstep, voffB); PG8_STAGE(PG8_SA(0, 0), a2, voffA);
            PG8_WAIT_V(8); PG8_WAIT_L(0); PG8_BAR; PG8_MMA(1, 0, At, B0); PG8_MMA(1, 1, At, B1); PG8_BAR; PG8_SCHED;
            PG8_LDB(B0, 1, 0); PG8_LDB(B1, 1, 1); PG8_SCHED; PG8_LDA(At, 1, 0); PG8_STAGE(PG8_SA(0, 1), a2 + hstep, voffA);
            PG8_WAIT_V(8); PG8_WAIT_L(0); PG8_BAR; PG8_MMA(0, 0, At, B0); PG8_MMA(0, 1, At, B1); PG8_BAR; PG8_SCHED;
            PG8_LDA(At, 1, 1); PG8_STAGE(PG8_SB(1, 0), b3, voffB); PG8_STAGE(PG8_SB(1, 1), b3 + hstep, voffB); PG8_STAGE(PG8_SA(1, 0), a3, voffA);
            PG8_WAIT_V(8); PG8_WAIT_L(0); PG8_BAR; PG8_MMA(1, 0, At, B0); PG8_MMA(1, 1, At, B1); PG8_BAR; PG8_SCHED;
            } else {
            PG8_LDB(B0, 0, 0); PG8_SCHED; PG8_LDA(At, 0, 0); PG8_STAGE(PG8_SA(1, 1), a1 + hstep, voffA);
            PG8_WAIT_L(8); PG8_BAR; PG8_WAIT_L(0); PG8_MMA(0, 0, At, B0); PG8_BAR; PG8_SCHED;
            PG8_LDB(B1, 0, 1); PG8_STAGE(PG8_SB(0, 0), b2, voffB);
            PG8_BAR; PG8_WAIT_L(0); PG8_MMA(0, 1, At, B1); PG8_BAR;
            PG8_LDA(At, 0, 1); PG8_STAGE(PG8_SA(0, 0), a2, voffA);
            PG8_BAR; PG8_WAIT_L(0); PG8_MMA(1, 0, At, B0); PG8_BAR; PG8_SCHED;
            PG8_STAGE(PG8_SB(0, 1), b2 + hstep, voffB);
            PG8_WAIT_V(6); PG8_BAR; PG8_MMA(1, 1, At, B1); PG8_BAR;
            PG8_LDB(B0, 1, 0); PG8_SCHED; PG8_LDA(At, 1, 0); PG8_STAGE(PG8_SA(0, 1), a2 + hstep, voffA);
            PG8_WAIT_L(8); PG8_BAR; PG8_WAIT_L(0); PG8_MMA(0, 0, At, B0); PG8_BAR; PG8_SCHED;
            PG8_LDB(B1, 1, 1); PG8_STAGE(PG8_SB(1, 0), b3, voffB);
            PG8_BAR; PG8_WAIT_L(0); PG8_MMA(0, 1, At, B1); PG8_BAR;
            PG8_LDA(At, 1, 1); PG8_STAGE(PG8_SA(1, 0), a3, voffA);
            PG8_BAR; PG8_WAIT_L(0); PG8_MMA(1, 0, At, B0); PG8_BAR; PG8_SCHED;
            PG8_STAGE(PG8_SB(1, 1), b3 + hstep, voffB);
            PG8_WAIT_V(6); PG8_BAR; PG8_MMA(1, 1, At, B1); PG8_BAR;
            }
        }
        if constexpr (ALIGN_EPI) { if (wr == 0) PG8_BAR; }
        if constexpr (!Epi::AFTER_DRAIN) { E(acc, cur, wr, wc, fr, fq); S.done(cur); }
        if (!has_next) break;
#pragma unroll
        for (int a = 0; a < 2; ++a)
#pragma unroll
            for (int b = 0; b < 2; ++b)
#pragma unroll
                for (int m = 0; m < 4; ++m)
#pragma unroll
                    for (int n = 0; n < 2; ++n) acc[a][b][m][n] = (f32x4){0.f, 0.f, 0.f, 0.f};
        cur = nxt; cA = nA; cB = nB; ++ui;
        if constexpr (ALIGN_EPI) { if (wr == 1) PG8_BAR; }
    }
    PG8_WAIT_V(0);
    if constexpr (!ALIGN_EPI) { if (wr == 0) PG8_BAR; }
    PG8_BAR;
    if constexpr (Epi::AFTER_DRAIN) { E.fused(acc, cur, wr, wc, fr, fq, lds, wid, lane); S.done(cur); }
#undef PG8_SA
#undef PG8_SB
#undef PG8_STAGE
#undef PG8_LDA
#undef PG8_LDB
#undef PG8_MMA
#undef PG8_WAIT_V
#undef PG8_WAIT_L
#undef PG8_BAR
#undef PG8_SCHED
}
}
constexpr int D_MODEL = 1024, BATCH = 4, SEQ = 8192, NTOK = BATCH * SEQ;
constexpr int D_PROJ = 5408, D_FF = 4096, NP_PAD = 5632;
constexpr int NWAVES = 8;
constexpr size_t MiB = 1u << 20;
constexpr size_t WS_CTL = 0, CTL_ZERO_BYTES = 1 * MiB;
constexpr size_t CTL_ROWSS = 512 * 1024;
constexpr size_t WS_WIN = 2 * MiB, WS_WA = 13 * MiB, WS_WB = 14 * MiB, WS_WO = 15 * MiB, WS_W1 = 17 * MiB, WS_W2 = 25 * MiB, WS_CK1 = 33 * MiB, WS_CV1 = 34 * MiB;
constexpr size_t WS_SMALL = 35 * MiB;
constexpr size_t WS_KSN = 40 * MiB, WS_KWN = 48 * MiB, WS_VST = 56 * MiB, WS_VWT = 64 * MiB, WS_KCN = 72 * MiB, WS_VCT = 73 * MiB;
constexpr size_t WS_GT = 76 * MiB;
constexpr size_t WS_RD = 79 * MiB + 512 * 1024;
constexpr size_t CTL_QCTR = 4096;
constexpr size_t CTL_BAR = 16384;
constexpr int XB_LDS_OFF = 147392;
constexpr size_t WS_XN = 36 * MiB;
constexpr size_t WS_QN = 100 * MiB, WS_KV = 132 * MiB, WS_ML = 180 * MiB, WS_G = 308 * MiB, WS_S = 436 * MiB;
constexpr size_t WS_YA = 440 * MiB, WS_YB = 472 * MiB;
constexpr size_t WS_MX = 180 * MiB;
constexpr size_t WS_U = 180 * MiB;
constexpr size_t WS_END = 504 * MiB;
constexpr int RING_BYTES = 131072, MISC_OFF = RING_BYTES + 320, LDS_BYTES = 147456;

#define GAS __attribute__((address_space(1)))
#define LAS __attribute__((address_space(3)))
typedef unsigned short bf16;
typedef unsigned v4u __attribute__((ext_vector_type(4)));
typedef float f32x4 __attribute__((ext_vector_type(4)));
#define LDS_WAIT() asm volatile("s_waitcnt lgkmcnt(0)" ::: "memory")
#define VM_WAIT() asm volatile("s_waitcnt vmcnt(0)" ::: "memory")
__device__ __forceinline__ unsigned f2bf(float f) { unsigned u = __builtin_bit_cast(unsigned, f); return (u + 0x7fffu + ((u >> 16) & 1u)) >> 16; }
__device__ __forceinline__ float bf2f(bf16 v) { return __uint_as_float((unsigned)v << 16); }
__device__ __forceinline__ unsigned pk2(float lo, float hi) { return f2bf(lo) | (f2bf(hi) << 16); }
__device__ __forceinline__ float wave_sum(float v) {
#pragma unroll
    for (int o = 1; o < 64; o <<= 1) v += __shfl_xor(v, o);
    return v;
}
__device__ __forceinline__ float wave_max(float v) {
#pragma unroll
    for (int o = 1; o < 64; o <<= 1) v = fmaxf(v, __shfl_xor(v, o));
    return v;
}

__device__ __forceinline__ int proj_src_col(int n) {
    if (n < 1280) return n;
    if (n < 3328) { const int q = (n - 1280) >> 9, r = (n - 1280) & 511; return (q == 0 ? 1304 : q == 1 ? 1816 : q == 2 ? 2328 : 2848) + r; }
    if (n < 5376) return 3360 + (n - 3328);
    if (n < 5400) return 1280 + (n - 5376);
    if (n < 5404) return 2840 + (n - 5400);
    if (n < 5408) return 2844 + (n - 5404);
    return -1;
}
template <bool MAP>
__device__ __forceinline__ void transpose_item(const float* W, int K, int ldw, const float* kscale, bf16* WT, int Nout, LAS float* scr, int item, int lane) {
    const int nblk = Nout / 32, kb = item / nblk, nb = item % nblk, k0 = 64 * kb, n0 = 32 * nb;
    const int sc = MAP ? proj_src_col(n0 + (lane & 31)) : (n0 + (lane & 31));
#pragma unroll 8
    for (int i = 0; i < 32; ++i) { const int kk = 2 * i + (lane >> 5); float v = sc >= 0 ? W[(size_t)(k0 + kk) * ldw + sc] : 0.f; if (kscale) v *= kscale[k0 + kk]; scr[kk * 33 + (lane & 31)] = v; }
    LDS_WAIT(); asm volatile("" ::: "memory");
    const int c = lane & 7;
#pragma unroll
    for (int j = 0; j < 4; ++j) { const int n = (lane >> 3) + 8 * j; const LAS float* s = scr + (8 * c) * 33 + n;
        v4u o; o.x = pk2(s[0 * 33], s[1 * 33]); o.y = pk2(s[2 * 33], s[3 * 33]); o.z = pk2(s[4 * 33], s[5 * 33]); o.w = pk2(s[6 * 33], s[7 * 33]);
        *(GAS v4u*)(WT + (size_t)(n0 + n) * K + k0 + 8 * c) = o; }
    LDS_WAIT(); asm volatile("" ::: "memory");
}
__device__ __forceinline__ void rms_row_to_bf16(const float* xrow, bf16* orow, int lane) {
    const GAS f32x4* xr = (const GAS f32x4*)xrow + lane;
    f32x4 v[4]; float s = 0.f;
#pragma unroll
    for (int j = 0; j < 4; ++j) { v[j] = xr[64 * j]; s += (v[j].x * v[j].x + v[j].y * v[j].y) + (v[j].z * v[j].z + v[j].w * v[j].w); }
    const float rstd = 1.f / sqrtf(wave_sum(s) * (1.f / D_MODEL) + 1e-6f);
    GAS unsigned long long* o8 = (GAS unsigned long long*)orow + lane;
#pragma unroll
    for (int j = 0; j < 4; ++j) o8[64 * j] = (unsigned long long)pk2(v[j].x * rstd, v[j].y * rstd) | ((unsigned long long)pk2(v[j].z * rstd, v[j].w * rstd) << 32);
}

#define XB_TMO      128
#define XB_XCNT(j)  (256  + 64 * (j))
#define XB_XSUB(j)  (1280 + 64 * (j))
#define XB_XGEN(j)  (2304 + 64 * (j))
#define XB_TOP      3328
#define XB_TOPGEN   3392
#define XCD_BAR_WORDS 3456
#define XB_SPIN_CAP (1u << 18)

__device__ __forceinline__ unsigned xb_ld(unsigned* p)              { return __hip_atomic_load(p, __ATOMIC_RELAXED, __HIP_MEMORY_SCOPE_AGENT); }
__device__ __forceinline__ unsigned xb_add(unsigned* p, unsigned v) { return __hip_atomic_fetch_add(p, v, __ATOMIC_RELAXED, __HIP_MEMORY_SCOPE_AGENT); }
__device__ __forceinline__ unsigned xb_xcc_id() { return (unsigned)__builtin_amdgcn_s_getreg((3 << 11) | 20) & 0xFu; }
#define XB_SPIN(cond, bar) do { unsigned _sp = 0; while (cond) { __builtin_amdgcn_s_sleep(1); \
    if ((++_sp & 255u) == 0u) { if (xb_ld(&(bar)[XB_TMO])) break; if (_sp > XB_SPIN_CAP) { atomicAdd(&(bar)[XB_TMO], 1u); break; } } } } while (0)

struct XcdBarrier {
    unsigned* bar; unsigned x;
    volatile LAS unsigned* st;
};

__device__ __forceinline__ XcdBarrier xcd_barrier_post(unsigned* bar, volatile LAS unsigned* st) {
    XcdBarrier b; b.bar = bar; b.x = xb_xcc_id(); b.st = st;
    if (threadIdx.x == 0) (void)xb_add(&bar[XB_XCNT(b.x)], 1u);
    return b;
}
__device__ __forceinline__ void xcd_barrier_complete(unsigned* bar, unsigned x, unsigned& nloc, unsigned& nx) {
    const unsigned G = gridDim.x * gridDim.y * gridDim.z;
    unsigned sum, cnt, mine, sp = 0u;
    for (;;) {
        sum = 0u; cnt = 0u; mine = 0u;
#pragma unroll
        for (unsigned j = 0; j < 16; ++j) { const unsigned c = xb_ld(&bar[XB_XCNT(j)]); sum += c; cnt += (c > 0u) ? 1u : 0u; mine = (j == x) ? c : mine; }
        if (sum == G) break;
        __builtin_amdgcn_s_sleep(1);
        if ((++sp & 255u) == 0u) { if (xb_ld(&bar[XB_TMO])) break; if (sp > XB_SPIN_CAP) { atomicAdd(&bar[XB_TMO], 1u); break; } }
    }
    nloc = mine > 0u ? mine : 1u; nx = cnt > 0u ? cnt : 1u;
}

__device__ __forceinline__ void xcd_barrier(const XcdBarrier& b) {
    asm volatile("s_waitcnt vmcnt(0)" ::: "memory");
    __syncthreads();
    if (threadIdx.x == 0) {
        unsigned* bar = b.bar;
        __builtin_amdgcn_s_waitcnt(0);
        unsigned nloc = b.st[0], nx = b.st[1];
        if (nloc == 0u) { xcd_barrier_complete(bar, b.x, nloc, nx); b.st[0] = nloc; b.st[1] = nx; }
        const unsigned old = xb_add(&bar[XB_XSUB(b.x)], 1u);
        const unsigned gen = old / nloc;
        if (old + 1u == (gen + 1u) * nloc) {
            __builtin_amdgcn_fence(__ATOMIC_RELEASE, "agent");
            asm volatile("s_waitcnt vmcnt(0)" ::: "memory");
            const unsigned og = xb_add(&bar[XB_TOP], 1u);
            const unsigned tg = og / nx;
            if (og + 1u == (tg + 1u) * nx) xb_add(&bar[XB_TOPGEN], 1u);
            else XB_SPIN(xb_ld(&bar[XB_TOPGEN]) == tg, bar);
            __builtin_amdgcn_fence(__ATOMIC_ACQUIRE, "agent");
            xb_add(&bar[XB_XGEN(b.x)], 1u);
            asm volatile("s_waitcnt vmcnt(0)" ::: "memory");
        } else {
            XB_SPIN(xb_ld(&bar[XB_XGEN(b.x)]) == gen, bar);
            __builtin_amdgcn_fence(__ATOMIC_ACQUIRE, "agent");
            asm volatile("s_waitcnt vmcnt(0)" ::: "memory");
        }
    }
    __syncthreads();
}
typedef short bf16x8 __attribute__((ext_vector_type(8)));
typedef float f32x16 __attribute__((ext_vector_type(16)));
typedef unsigned u32x4 __attribute__((ext_vector_type(4)));
typedef unsigned u32x2 __attribute__((ext_vector_type(2)));
constexpr float LOG2E = 1.4426950408889634f;
__device__ const unsigned char BUCKET_TAB2[129] = {0, 1, 2, 3, 4, 5, 6, 7, 8, 9, 10, 11, 12, 13, 14, 15, 16, 16, 16, 17, 17, 18, 18, 18, 19, 19, 19, 20, 20, 20, 20, 21, 21, 21, 21, 22, 22, 22, 22, 22, 23, 23, 23, 23, 23, 23, 24, 24, 24, 24, 24, 24, 25, 25, 25, 25, 25, 25, 25, 26, 26, 26, 26, 26, 26, 26, 26, 27, 27, 27, 27, 27, 27, 27, 27, 27, 27, 28, 28, 28, 28, 28, 28, 28, 28, 28, 28, 29, 29, 29, 29, 29, 29, 29, 29, 29, 29, 29, 29, 30, 30, 30, 30, 30, 30, 30, 30, 30, 30, 30, 30, 30, 30, 31, 31, 31, 31, 31, 31, 31, 31, 31, 31, 31, 31, 31, 31, 31, 31};
__device__ __forceinline__ unsigned cvtpk(float lo, float hi) { typedef float f2 __attribute__((ext_vector_type(2))); typedef __bf16 b2 __attribute__((ext_vector_type(2))); f2 v = {lo, hi}; b2 b = __builtin_convertvector(v, b2); return __builtin_bit_cast(unsigned, b); }
__device__ __forceinline__ float bflo(unsigned w) { return __uint_as_float(w << 16); }
__device__ __forceinline__ float bfhi(unsigned w) { return __uint_as_float(w & 0xffff0000u); }
__device__ __forceinline__ int key_off16(int pp) { return (pp & 3) + 8 * ((pp >> 2) & 1) + 4 * (pp >> 3); }
__device__ __forceinline__ int crow(int r, int hi) { return (r & 3) + 8 * (r >> 2) + 4 * hi; }

__device__ __forceinline__ void knorm_item(const bf16* KV, int col0, const float* gain, bf16* dst, size_t tok0, int lane) {
    const int ch = lane & 7;
    float gn[8];
#pragma unroll
    for (int i = 0; i < 8; ++i) gn[i] = gain[8 * ch + i];
#pragma unroll
    for (int it = 0; it < 8; ++it) {
        const int r = 8 * it + (lane >> 3);
        const u32x4 v = *(const u32x4*)(KV + (tok0 + r) * 768 + col0 + 8 * ch);
        float f[8] = {bflo(v.x), bfhi(v.x), bflo(v.y), bfhi(v.y), bflo(v.z), bfhi(v.z), bflo(v.w), bfhi(v.w)};
        float ss = 0.f;
#pragma unroll
        for (int i = 0; i < 8; ++i) ss += f[i] * f[i];
        ss += __shfl_xor(ss, 1); ss += __shfl_xor(ss, 2); ss += __shfl_xor(ss, 4);
        const float rs = 1.f / sqrtf(ss * (1.f / 64.f) + 1e-6f);
        u32x4 o; o.x = cvtpk(f[0] * rs * gn[0], f[1] * rs * gn[1]); o.y = cvtpk(f[2] * rs * gn[2], f[3] * rs * gn[3]); o.z = cvtpk(f[4] * rs * gn[4], f[5] * rs * gn[5]); o.w = cvtpk(f[6] * rs * gn[6], f[7] * rs * gn[7]);
        *(u32x4*)(dst + (size_t)r * 64 + 8 * ch) = o;
    }
}
__device__ __forceinline__ void vtrans_item(const bf16* KV, int col0, bf16* dst, size_t tok0, LAS unsigned short* scr, int lane) {
#pragma unroll
    for (int it = 0; it < 8; ++it) {
        const int r = 8 * it + (lane >> 3), ch = lane & 7;
        const u32x4 v = *(const u32x4*)(KV + (tok0 + r) * 768 + col0 + 8 * ch);
        *(LAS u32x4*)(scr + r * 72 + 8 * ch) = v;
    }
    LDS_WAIT(); asm volatile("" ::: "memory");
    const int d = lane;
#pragma unroll
    for (int oc = 0; oc < 8; ++oc) {
        unsigned w[4];
#pragma unroll
        for (int k2 = 0; k2 < 4; ++k2) {
            const int p0 = 8 * oc + 2 * k2, p1 = p0 + 1;
            const int key0 = 16 * (p0 >> 4) + key_off16(p0 & 15), key1 = 16 * (p1 >> 4) + key_off16(p1 & 15);
            w[k2] = (unsigned)scr[key0 * 72 + d] | ((unsigned)scr[key1 * 72 + d] << 16);
        }
        u32x4 o; o.x = w[0]; o.y = w[1]; o.z = w[2]; o.w = w[3];
        *(u32x4*)(dst + (size_t)d * 64 + 8 * oc) = o;
    }
    LDS_WAIT(); asm volatile("" ::: "memory");
}
__device__ __forceinline__ void compress_unit(int unit, const bf16* KV, const bf16* W1T, const bf16* W2T, const float* b1p, const float* b2, const float* kgain0,
                                              bf16* KCN, bf16* VCT, LAS unsigned char* lds, int tid) {
    const int kv = unit & 1, tl = (unit >> 1) & 7, bg = unit >> 4, b = bg >> 1, g = bg & 1;
    const int lane = tid & 63, w = __builtin_amdgcn_readfirstlane(tid >> 6), r32 = lane & 31, hi = lane >> 5;
    const int colbase = (kv ? 128 : 0) + 64 * g;
    LAS unsigned short* hid = (LAS unsigned short*)lds;
    LAS float* outl = (LAS float*)(lds + 64 * 264 * 2);
    f32x16 acc[2]; acc[0] = f32x16{}; acc[1] = f32x16{};
    const bf16* brow = W1T + (size_t)(32 * w + r32) * 2048 + 8 * hi;
    LAS unsigned char* strip = lds + 51200;
    const bf16* kvb = KV + ((size_t)b * SEQ) * 768 + colbase;
#pragma unroll 1
    for (int rt = 0; rt < 2; ++rt) {
        const int T0 = 16 * (64 * tl + 32 * rt);
        for (int pi = tid; pi < 528 * 8; pi += 512) {
            const int tk = pi >> 3, ch = pi & 7; int tok = T0 + tk; tok = tok > SEQ - 1 ? SEQ - 1 : tok;
            *(LAS u32x4*)(strip + tk * 128 + ((ch ^ ((tk >> 4) & 7)) << 4)) = *(const u32x4*)(kvb + (size_t)tok * 768 + 8 * ch);
        }
        __syncthreads();
        f32x16 a = f32x16{};
#pragma unroll 8
        for (int s = 0; s < 128; ++s) {
            const int jj = s >> 2, ch = 2 * (s & 3) + hi, tk = 16 * r32 + jj;
            const bf16x8 bf = *(const bf16x8*)(brow + 16 * s);
            const bf16x8 af = *(const LAS bf16x8*)(strip + tk * 128 + ((ch ^ ((tk >> 4) & 7)) << 4));
            a = __builtin_amdgcn_mfma_f32_32x32x16_bf16(af, bf, a, 0, 0, 0);
        }
        if (rt == 0) acc[0] = a; else acc[1] = a;
        __syncthreads();
    }
    {
        const int col = 32 * w + r32; const float bb = b1p[col];
#pragma unroll
        for (int rt = 0; rt < 2; ++rt)
#pragma unroll
            for (int r = 0; r < 16; ++r) {
                const float x = acc[rt][r] + bb;
                const float u = 0.7978845608028654f * (x + 0.044715f * x * x * x);
                const float e = __builtin_amdgcn_exp2f(2.f * LOG2E * u);
                const float th = 1.f - 2.f * __builtin_amdgcn_rcpf(e + 1.f);
                hid[(32 * rt + crow(r, hi)) * 264 + col] = (unsigned short)(cvtpk(0.5f * x * (1.f + th), 0.f) & 0xffffu);
            }
    }
    __syncthreads();
    if (w < 4) {
        const int rt = w >> 1, ct = w & 1;
        f32x16 o = f32x16{};
        const bf16* b2row = W2T + (size_t)(32 * ct + r32) * 256 + 8 * hi;
#pragma unroll
        for (int s = 0; s < 16; ++s) {
            const bf16x8 af = *(const LAS bf16x8*)(hid + (32 * rt + r32) * 264 + 16 * s + 8 * hi);
            const bf16x8 bf = *(const bf16x8*)(b2row + 16 * s);
            o = __builtin_amdgcn_mfma_f32_32x32x16_bf16(af, bf, o, 0, 0, 0);
        }
        const float bb = b2[32 * ct + r32];
#pragma unroll
        for (int r = 0; r < 16; ++r) outl[(32 * rt + crow(r, hi)) * 65 + 32 * ct + r32] = o[r] + bb;
    }
    __syncthreads();
#pragma unroll
    for (int k = 0; k < 8; ++k) {
        const int r = 8 * w + k, n = 64 * tl + r;
        float v = outl[r * 65 + lane];
        if (kv == 0) {
            const float ss = wave_sum(v * v);
            v = v * (1.f / sqrtf(ss * (1.f / 64.f) + 1e-6f)) * kgain0[lane];
            if (n >= 511) v = 0.f;
            KCN[((size_t)bg * 512 + n) * 64 + lane] = (bf16)f2bf(v);
        } else {
            if (n >= 511) v = 0.f;
            const int pos = 16 * (r >> 4) + key_off16(r & 15);
            VCT[(((size_t)bg * 8 + tl) * 64 + lane) * 64 + pos] = (bf16)f2bf(v);
        }
    }
    __syncthreads();
}

constexpr int ENG_BUF = 0;
constexpr int ENG_LUT = 32768;
constexpr int LUTN = 256;
constexpr int ENG_EDGE = ENG_LUT + 8 * LUTN * 4;
constexpr int ENG_IMP = 45056;
constexpr int ENG_SELM = ENG_IMP + 64 * 128 * 4;
constexpr int ENG_UNION = ENG_SELM + 64 * 4 * 4;
constexpr int ENG_TLIST = ENG_UNION + 16;
constexpr int ENG_MISC = ENG_TLIST + 132 * 4;
constexpr int ENG_RING2 = ENG_MISC + 16;
constexpr int ENG_END = ENG_RING2 + 4 * 16384;

struct EngPtrs { const bf16 *QN, *KCN, *VCT, *KSN, *VST, *KWN, *VWT; const float* SB; const float* rel; const float* qgain; const float* bounds; bf16* YA; };

__device__ __forceinline__ int swz7(int row) { return ((row >> 1) ^ ((row >> 4) & 1)) & 7; }
__device__ __forceinline__ int tile_off(int row, int ch) { return row * 128 + ((ch ^ swz7(row)) << 4); }

template <int BR>
__device__ __forceinline__ void eng_branch(LAS unsigned char* lds, const bf16* Kg, const bf16* Vg, int nt, int c, int tid, int lane, int hq, int qloc, int headl,
                                           const bf16x8 (&qr)[4], float& lsum, float inv_l, f32x16 (&o)[2]) {
    const int r32 = lane & 31, hi = lane >> 5;
    const LAS float* lut = (const LAS float*)(lds + ENG_LUT) + headl * LUTN;
    const LAS float* edge = (const LAS float*)(lds + ENG_EDGE);
    LAS float* imp = (LAS float*)(lds + ENG_IMP);
    unsigned sm0 = 0u, sm1 = 0u, sm2 = 0u, sm3 = 0u;
    if (BR == 2) { const LAS unsigned* selm = (const LAS unsigned*)(lds + ENG_SELM) + qloc * 4; sm0 = selm[0]; sm1 = selm[1]; sm2 = selm[2]; sm3 = selm[3]; }
    auto tile_id = [&](int k) -> int { return BR <= 2 ? k : (c - 8 + k < 0 ? 0 : c - 8 + k); };
    const int kofs = (BR == 3) ? (c < 8 ? 8 - c : 0) : 0;
    constexpr int NST = (BR <= 1) ? 6 : 8;
    const int wv = __builtin_amdgcn_readfirstlane(tid >> 6);
    const unsigned vot = (unsigned)((((lane >> 3)) * 64 + (((lane & 7) ^ swz7(8 * wv + (lane >> 3))) << 3)) * 2) + (unsigned)wv * 1024u;
    auto stage_off = [&](int sidx) -> int {
        if (sidx < 2) return ENG_BUF + sidx * 16384;
        if (BR <= 1) return ENG_RING2 + (sidx - 2) * 16384;
        return sidx < 4 ? ENG_IMP + (sidx - 2) * 16384 : ENG_RING2 + (sidx - 4) * 16384; };
#define ENG_DMA(src, dstoff) __builtin_amdgcn_global_load_lds((const unsigned*)(src), (LAS unsigned*)(lds + (dstoff)), 16, 0, 0)
#define ENG_ISSUE(kk) do { int kq_ = (kk) < nt ? (kk) : nt - 1; const int jq_ = tile_id(kq_ + kofs); const int so_ = stage_off((kk) % NST) + wv * 1024; \
        ENG_DMA((const char*)Kg + (size_t)jq_ * 8192 + vot, so_); if (BR != 0) ENG_DMA((const char*)Vg + (size_t)jq_ * 8192 + vot, so_ + 8192); } while (0)
#define ENG_WAIT(n) asm volatile("s_waitcnt vmcnt(%0)" :: "n"(n) : "memory")
    constexpr int DPT = (BR == 0) ? 1 : 2;
    unsigned koff[4];
#pragma unroll
    for (int s = 0; s < 4; ++s) koff[s] = (unsigned)tile_off(r32, 2 * s + hi);
    auto frag8 = [&](unsigned base, bf16x8 (&f)[8]) {
        const unsigned a0 = base + koff[0], a1 = base + koff[1], a2 = base + koff[2], a3 = base + koff[3];
        asm volatile("ds_read_b128 %0, %8\n\tds_read_b128 %1, %8 offset:4096\n\tds_read_b128 %2, %9\n\tds_read_b128 %3, %9 offset:4096\n\t"
                     "ds_read_b128 %4, %10\n\tds_read_b128 %5, %10 offset:4096\n\tds_read_b128 %6, %11\n\tds_read_b128 %7, %11 offset:4096\n\ts_waitcnt lgkmcnt(0)"
                     : "=&v"(f[0]), "=&v"(f[1]), "=&v"(f[2]), "=&v"(f[3]), "=&v"(f[4]), "=&v"(f[5]), "=&v"(f[6]), "=&v"(f[7])
                     : "v"(a0), "v"(a1), "v"(a2), "v"(a3) : "memory");
    };
    auto qk_mfma = [&](int so, int j, f32x16& p0, f32x16& p1) {
        bf16x8 kf[8];
        frag8((unsigned)so, kf);
        p0 = __builtin_amdgcn_mfma_f32_32x32x16_bf16(kf[0], qr[0], f32x16{}, 0, 0, 0);
        p1 = __builtin_amdgcn_mfma_f32_32x32x16_bf16(kf[1], qr[0], f32x16{}, 0, 0, 0);
#pragma unroll
        for (int s = 1; s < 4; ++s) {
            p0 = __builtin_amdgcn_mfma_f32_32x32x16_bf16(kf[2 * s], qr[s], p0, 0, 0, 0);
            p1 = __builtin_amdgcn_mfma_f32_32x32x16_bf16(kf[2 * s + 1], qr[s], p1, 0, 0, 0);
        }
    };
    auto qk_fix = [&](int j, f32x16& p0, f32x16& p1) {
        bool near_;
        if (BR <= 1) { const int dmin = 64 * c - 16 * (64 * j + 63) - 31; near_ = dmin < 128; }
        else if (BR == 2) near_ = (j >= c - 2);
        else near_ = (j >= c - 2) || (j == c - 8);
        if (near_) {
            if (BR <= 1) {
                const int dbase = 64 * c + qloc - 16 * (64 * j + 4 * hi) - 31;
#pragma unroll
                for (int r = 0; r < 16; ++r) {
                    const int cr0 = (r & 3) + 8 * (r >> 2);
                    const int d0 = dbase - 16 * cr0, d1 = dbase - 16 * (32 + cr0);
                    int i0 = (d0 > 128 ? 128 : d0) + 64, i1 = (d1 > 128 ? 128 : d1) + 64;
                    i0 = i0 < 0 ? 0 : i0; i1 = i1 < 0 ? 0 : i1;
                    float b0 = lut[i0], b1 = lut[i1];
                    asm volatile("" : "+v"(b0), "+v"(b1));
                    p0[r] += b0; p1[r] += b1;
                }
            } else {
                const LAS float* pb = (BR == 3 && j == c - 8) ? edge + (64 + qloc - 4 * hi - 59) : lut + (64 * (c - j) + qloc - 4 * hi + 64 - 59);
#pragma unroll
                for (int r = 0; r < 16; ++r) { const int cr0 = (r & 3) + 8 * (r >> 2); p0[r] += pb[59 - cr0]; p1[r] += pb[59 - 32 - cr0]; }
            }
        }
    };
#pragma unroll
    for (int i = 0; i < NST - 1; ++i) ENG_ISSUE(i);
    f32x16 pA0, pA1, pB0, pB1;
    {
        ENG_WAIT((NST - 2) * DPT);
        __builtin_amdgcn_s_barrier(); asm volatile("" ::: "memory");
        const int j0 = tile_id(kofs);
        qk_mfma(stage_off(0), j0, pA0, pA1); qk_fix(j0, pA0, pA1);
    }
#define ENG_STEP(k, pc0, pc1, pn0, pn1) do { \
        const int j = tile_id((k) + kofs); \
          \
        unsigned selbit_ = 1u; bool dc_ = true; \
        if (BR == 2) { selbit_ = sm0 & 1u; dc_ = __builtin_amdgcn_ballot_w64(selbit_ != 0u) != 0ull; } \
          \
        ENG_WAIT((NST - 3) * DPT); \
        __builtin_amdgcn_s_barrier(); asm volatile("" ::: "memory"); \
        ENG_ISSUE((k) + NST - 1); \
        eng_step_body(k, j, pc0, pc1, pn0, pn1, dc_, selbit_); \
        if (BR == 2) { sm0 = (sm0 >> 1) | (sm1 << 31); sm1 = (sm1 >> 1) | (sm2 << 31); sm2 = (sm2 >> 1) | (sm3 << 31); sm3 >>= 1; } } while (0)
    auto eng_step_body = [&](int k, int j, f32x16& pc0, f32x16& pc1, f32x16& pn0, f32x16& pn1, const bool dopv, const unsigned selbit) {
        const int bufo = stage_off(k % NST);
        const int kn = (k + 1 < nt) ? k + 1 : nt - 1;
        const int jn = tile_id(kn + kofs);
        qk_mfma(stage_off((k + 1) % NST), jn, pn0, pn1);
        float ls = 0.f;
        u32x4 pw[4];
        {
#pragma unroll
            for (int r = 0; r < 16; ++r) { pc0[r] = __builtin_amdgcn_exp2f(pc0[r]); pc1[r] = __builtin_amdgcn_exp2f(pc1[r]); ls += pc0[r] + pc1[r]; }
            if (BR == 1) {
#pragma unroll
                for (int r = 0; r < 16; ++r) { pc0[r] *= inv_l; pc1[r] *= inv_l; }
            }
            unsigned selmask = 0xffffffffu;
            if (BR == 2) { selmask = selbit ? 0xffffffffu : 0u; ls = selbit ? ls : 0.f; }
            if (BR != 0) {
#pragma unroll
                for (int s2 = 0; s2 < 2; ++s2) {
                    pw[s2].x = cvtpk(pc0[8 * s2 + 0], pc0[8 * s2 + 1]); pw[s2].y = cvtpk(pc0[8 * s2 + 2], pc0[8 * s2 + 3]); pw[s2].z = cvtpk(pc0[8 * s2 + 4], pc0[8 * s2 + 5]); pw[s2].w = cvtpk(pc0[8 * s2 + 6], pc0[8 * s2 + 7]);
                    pw[2 + s2].x = cvtpk(pc1[8 * s2 + 0], pc1[8 * s2 + 1]); pw[2 + s2].y = cvtpk(pc1[8 * s2 + 2], pc1[8 * s2 + 3]); pw[2 + s2].z = cvtpk(pc1[8 * s2 + 4], pc1[8 * s2 + 5]); pw[2 + s2].w = cvtpk(pc1[8 * s2 + 6], pc1[8 * s2 + 7]);
                }
                if (BR == 2) {
#pragma unroll
                    for (int i = 0; i < 4; ++i) { pw[i].x &= selmask; pw[i].y &= selmask; pw[i].z &= selmask; pw[i].w &= selmask; }
                }
            }
            if (BR != 0) asm volatile("" : "+v"(pw[0]), "+v"(pw[1]), "+v"(pw[2]), "+v"(pw[3]), "+v"(ls)); else asm volatile("" : "+v"(ls));
            if (BR == 1 && c >= 16) {
                const int q = qloc;
#pragma unroll
                for (int a = 0; a < 4; ++a) {
                    float g0 = (pc0[4 * a] + pc0[4 * a + 1]) + (pc0[4 * a + 2] + pc0[4 * a + 3]), s0 = pc0[4 * a + 3];
                    float g1 = (pc1[4 * a] + pc1[4 * a + 1]) + (pc1[4 * a + 2] + pc1[4 * a + 3]), s1 = pc1[4 * a + 3];
                    g0 += __shfl_xor(g0, 1); s0 += __shfl_xor(s0, 1); g1 += __shfl_xor(g1, 1); s1 += __shfl_xor(s1, 1);
                    g0 += __shfl_xor(g0, 2); s0 += __shfl_xor(s0, 2); g1 += __shfl_xor(g1, 2); s1 += __shfl_xor(s1, 2);
                    if (hq == 0) {
                        const int jb0 = 16 * j + 2 * a + hi, jb1 = jb0 + 8;
                        imp[q * 128 + (jb0 ^ (q & 31))] += g0;
                        imp[q * 128 + (jb1 ^ (q & 31))] += g1;
                        asm volatile("" ::: "memory");
                        if (jb0 + 1 < 128) imp[q * 128 + ((jb0 + 1) ^ (q & 31))] += s0;
                        if (jb1 + 1 < 128) imp[q * 128 + ((jb1 + 1) ^ (q & 31))] += s1;
                        asm volatile("" ::: "memory");
                    }
                }
            }
            lsum += ls;
        }
        qk_fix(jn, pn0, pn1);
        if (BR != 0 && (BR != 2 || dopv)) {
            bf16x8 vf[8];
            frag8((unsigned)(bufo + 8192), vf);
#pragma unroll
            for (int ks = 0; ks < 4; ++ks) {
                const bf16x8 pf = __builtin_bit_cast(bf16x8, pw[ks]);
                o[0] = __builtin_amdgcn_mfma_f32_32x32x16_bf16(vf[2 * ks], pf, o[0], 0, 0, 0);
                o[1] = __builtin_amdgcn_mfma_f32_32x32x16_bf16(vf[2 * ks + 1], pf, o[1], 0, 0, 0);
            }
        }
    };
    int k = 0;
    for (; k + 1 < nt; k += 2) { ENG_STEP(k, pA0, pA1, pB0, pB1); ENG_STEP(k + 1, pB0, pB1, pA0, pA1); }
    if (k < nt) ENG_STEP(k, pA0, pA1, pB0, pB1);
#undef ENG_STEP
#undef ENG_WAIT
    asm volatile("s_waitcnt vmcnt(0)" ::: "memory");
    __syncthreads();
#undef ENG_ISSUE
#undef ENG_DMA
}

__device__ __forceinline__ void eng_tables(const float* rel, LAS unsigned char* lds, int tid) {
    LAS float* lutw = (LAS float*)(lds + ENG_LUT);
    for (int i = tid; i < 8 * LUTN; i += 512) {
        const int hd = i >> 8, dist = (i & 255) - 64;
        float v = -INFINITY;
        if (dist >= 0) { const int bk = dist >= 128 ? 31 : (int)BUCKET_TAB2[dist]; v = (rel[bk * 8 + hd] - rel[31 * 8 + hd]) * LOG2E; }
        lutw[i] = v;
    }
    if (tid < 128) ((LAS float*)(lds + ENG_EDGE))[tid] = (tid + 448 < 512) ? 0.f : -INFINITY;
}
__device__ __forceinline__ void eng_unit(int unit, const EngPtrs& P, LAS unsigned char* lds, int tid) {
    const int c = 127 - (unit >> 3), bg = unit & 7, b = bg >> 1, g = bg & 1;
    const int lane = tid & 63, w = __builtin_amdgcn_readfirstlane(tid >> 6), r32 = lane & 31, hi = lane >> 5;
    const int hq = r32 & 3, qloc = 8 * w + (r32 >> 2);
    const int head = 4 * g + hq;
    const int t = 64 * c + qloc;
    const size_t row = (size_t)b * SEQ + t;
    LAS float* imp = (LAS float*)(lds + ENG_IMP);
    LAS unsigned* selm = (LAS unsigned*)(lds + ENG_SELM);
    LAS unsigned* uni = (LAS unsigned*)(lds + ENG_UNION);
    LAS int* tlist = (LAS int*)(lds + ENG_TLIST);
    LAS int* misc = (LAS int*)(lds + ENG_MISC);
    if (c >= 16) for (int i = tid; i < 64 * 128; i += 512) imp[i] = 0.f;
    if (tid < 4) uni[tid] = 0u;
    bf16x8 qr[4];
    {
        const bf16* qp = P.QN + row * 512 + head * 64 + 8 * hi;
        u32x4 raw[4]; float ss = 0.f;
#pragma unroll
        for (int s = 0; s < 4; ++s) { raw[s] = *(const u32x4*)(qp + 16 * s);
            const float f[8] = {bflo(raw[s].x), bfhi(raw[s].x), bflo(raw[s].y), bfhi(raw[s].y), bflo(raw[s].z), bfhi(raw[s].z), bflo(raw[s].w), bfhi(raw[s].w)};
#pragma unroll
            for (int i = 0; i < 8; ++i) ss += f[i] * f[i]; }
        ss += __shfl_xor(ss, 32);
        const float rs = (1.f / sqrtf(ss * (1.f / 64.f) + 1e-6f)) * 0.125f * LOG2E;
#pragma unroll
        for (int s = 0; s < 4; ++s) {
            const float* gp = P.qgain + 16 * s + 8 * hi;
            u32x4 o4;
            o4.x = cvtpk(bflo(raw[s].x) * rs * gp[0], bfhi(raw[s].x) * rs * gp[1]); o4.y = cvtpk(bflo(raw[s].y) * rs * gp[2], bfhi(raw[s].y) * rs * gp[3]);
            o4.z = cvtpk(bflo(raw[s].z) * rs * gp[4], bfhi(raw[s].z) * rs * gp[5]); o4.w = cvtpk(bflo(raw[s].w) * rs * gp[6], bfhi(raw[s].w) * rs * gp[7]);
            qr[s] = __builtin_bit_cast(bf16x8, o4);
        }
    }
    const float* gl = P.SB + row * 32 + head * 3;
    const float gate0 = 1.f / (1.f + __expf(-gl[0])), gate1 = 1.f / (1.f + __expf(-gl[1])), gate2 = 1.f / (1.f + __expf(-gl[2]));
    bf16* const yp = P.YA + row * 512 + head * 64 + 4 * hi;
    __syncthreads();
    {
        const int nvmax = (4 * c + 3 > 511) ? 511 : 4 * c + 3;
        const int ntc = (nvmax + 63) >> 6;
        const bf16* Kg = P.KCN + (size_t)bg * 512 * 64; const bf16* Vg = P.VCT + (size_t)bg * 8 * 4096;
        float l1 = 0.f; f32x16 od[2]; od[0] = f32x16{}; od[1] = f32x16{};
        eng_branch<0>(lds, Kg, Vg, ntc, c, tid, lane, hq, qloc, head, qr, l1, 0.f, od);
        l1 += __shfl_xor(l1, 32);
        const float inv = l1 > 0.f ? 1.f / l1 : 0.f;
        float l2 = 0.f;
        eng_branch<1>(lds, Kg, Vg, ntc, c, tid, lane, hq, qloc, head, qr, l2, inv, od);
#pragma unroll
        for (int dh = 0; dh < 2; ++dh)
#pragma unroll
            for (int a = 0; a < 4; ++a) { u32x2 v; v.x = cvtpk(gate0 * od[dh][4 * a], gate0 * od[dh][4 * a + 1]); v.y = cvtpk(gate0 * od[dh][4 * a + 2], gate0 * od[dh][4 * a + 3]); *(u32x2*)(yp + 32 * dh + 8 * a) = v; }
    }
    {
        const int q = tid >> 3, part = tid & 7;
        unsigned m16 = 0u;
        if (c >= 16) {
            unsigned key[16];
#pragma unroll
            for (int jj = 0; jj < 16; ++jj) { const int j = part * 16 + jj; key[jj] = (j >= 1 && j <= c - 2) ? (__float_as_uint(imp[q * 128 + (j ^ (q & 31))]) + 1u) : 0u; }
            unsigned T = 0u;
            for (int bit = 31; bit >= 0; --bit) {
                const unsigned cand = T | (1u << bit);
                int cnt = 0;
#pragma unroll
                for (int jj = 0; jj < 16; ++jj) cnt += key[jj] >= cand ? 1 : 0;
                cnt += __shfl_xor(cnt, 1); cnt += __shfl_xor(cnt, 2); cnt += __shfl_xor(cnt, 4);
                if (cnt >= 13) T = cand;
            }
            int gt = 0, eq = 0;
#pragma unroll
            for (int jj = 0; jj < 16; ++jj) { gt += key[jj] > T ? 1 : 0; eq += key[jj] == T ? 1 : 0; }
            int gtot = gt; gtot += __shfl_xor(gtot, 1); gtot += __shfl_xor(gtot, 2); gtot += __shfl_xor(gtot, 4);
            int pre = 0;
#pragma unroll
            for (int pp = 0; pp < 8; ++pp) { const int e = __shfl(eq, (lane & ~7) + pp); if (pp < part) pre += e; }
            int quota = 13 - gtot - pre; quota = quota < 0 ? 0 : quota;
#pragma unroll
            for (int jj = 0; jj < 16; ++jj) {
                bool s = key[jj] > T;
                if (key[jj] == T && T != 0u) { if (quota > 0) { s = true; --quota; } }
                m16 |= s ? (1u << jj) : 0u;
            }
        }
        unsigned wd = m16 << (16 * (part & 1));
        wd |= __shfl_xor(wd, 1);
        const int wi = part >> 1;
        if (c >= 16) {
            if (wi == 0) wd |= 1u;
            if (((c - 1) >> 5) == wi) wd |= 1u << ((c - 1) & 31);
            if ((c >> 5) == wi) wd |= 1u << (c & 31);
        } else {
            wd = (wi == 0) ? ((c >= 31) ? 0xffffffffu : ((2u << c) - 1u)) : 0u;
        }
        if ((part & 1) == 0) selm[q * 4 + wi] = wd;
    }
    __syncthreads();
    {
        const int nts = c + 1;
        float l = 0.f; f32x16 od[2]; od[0] = f32x16{}; od[1] = f32x16{};
        eng_branch<2>(lds, P.KSN + (size_t)bg * SEQ * 64, P.VST + (size_t)bg * 128 * 4096, nts, c, tid, lane, hq, qloc, head, qr, l, 0.f, od);
        l += __shfl_xor(l, 32);
        const float sc = gate1 / l;
#pragma unroll
        for (int dh = 0; dh < 2; ++dh)
#pragma unroll
            for (int a = 0; a < 4; ++a) { const u32x2 y = *(const u32x2*)(yp + 32 * dh + 8 * a);
                u32x2 v; v.x = cvtpk(bflo(y.x) + sc * od[dh][4 * a], bfhi(y.x) + sc * od[dh][4 * a + 1]); v.y = cvtpk(bflo(y.y) + sc * od[dh][4 * a + 2], bfhi(y.y) + sc * od[dh][4 * a + 3]); *(u32x2*)(yp + 32 * dh + 8 * a) = v; }
    }
    {
        const int ntw = c < 8 ? c + 1 : 9;
        float l = 0.f; f32x16 od[2]; od[0] = f32x16{}; od[1] = f32x16{};
        eng_branch<3>(lds, P.KWN + (size_t)bg * SEQ * 64, P.VWT + (size_t)bg * 128 * 4096, ntw, c, tid, lane, hq, qloc, head, qr, l, 0.f, od);
        l += __shfl_xor(l, 32);
        const float sc = gate2 / l;
#pragma unroll
        for (int dh = 0; dh < 2; ++dh)
#pragma unroll
            for (int a = 0; a < 4; ++a) { const u32x2 y = *(const u32x2*)(yp + 32 * dh + 8 * a);
                u32x2 v; v.x = cvtpk(bflo(y.x) + sc * od[dh][4 * a], bfhi(y.x) + sc * od[dh][4 * a + 1]); v.y = cvtpk(bflo(y.y) + sc * od[dh][4 * a + 2], bfhi(y.y) + sc * od[dh][4 * a + 3]); *(u32x2*)(yp + 32 * dh + 8 * a) = v; }
    }
}
__device__ __forceinline__ int pos16(int k) { return 16 * (k >> 4) + key_off16(k & 15); }
__device__ __forceinline__ float fsilu(float a) { return a / (1.f + __expf(-a)); }

constexpr int MLP_ROWB = 272;
constexpr int MLP_QIN = 0, MLP_KIN = 67 * MLP_ROWB, MLP_VIN = 2 * 67 * MLP_ROWB, MLP_QOUT = MLP_VIN + 64 * MLP_ROWB, MLP_KOUT = MLP_QOUT + 64 * MLP_ROWB, MLP_END = MLP_KOUT + 64 * MLP_ROWB;
__device__ __forceinline__ void ml_prep_unit(int unit, const bf16* ML, const float* cw, const float* cb, bf16* QC, bf16* KC, bf16* KT, bf16* VT, LAS unsigned char* lds, int tid) {
    const int bh = unit >> 7, chunk = unit & 127, b = bh >> 2, h = bh & 3;
    const int t0 = 64 * chunk;
    const size_t rowb = (size_t)b * SEQ;
    for (int pi = tid; pi < 67 * 16; pi += 512) {
        const int r = pi >> 4, ch = pi & 15, t = t0 - 3 + r;
        u32x4 qv = {0u, 0u, 0u, 0u}, kv = {0u, 0u, 0u, 0u};
        if (t >= 0) { const bf16* rp = ML + (rowb + t) * 2048 + h * 128 + 8 * ch; qv = *(const u32x4*)rp; kv = *(const u32x4*)(rp + 512); }
        *(LAS u32x4*)(lds + MLP_QIN + r * MLP_ROWB + 16 * ch) = qv; *(LAS u32x4*)(lds + MLP_KIN + r * MLP_ROWB + 16 * ch) = kv;
    }
    for (int pi = tid; pi < 64 * 16; pi += 512) {
        const int r = pi >> 4, ch = pi & 15;
        *(LAS u32x4*)(lds + MLP_VIN + r * MLP_ROWB + 16 * ch) = *(const u32x4*)(ML + (rowb + t0 + r) * 2048 + 1024 + h * 128 + 8 * ch);
    }
    __syncthreads();
    {
        const int ch = tid & 127, seg = tid >> 7;
#pragma unroll
        for (int which = 0; which < 2; ++which) {
            const int gc = which * 512 + h * 128 + ch;
            const float w0 = cw[gc], w1 = cw[1024 + gc], w2 = cw[2048 + gc], w3 = cw[3072 + gc], bias = cb[gc];
            const float sc = which == 0 ? 0.08838834764831845f : 1.f;
            const LAS unsigned short* in = (const LAS unsigned short*)(lds + (which ? MLP_KIN : MLP_QIN)) + ch;
            LAS unsigned short* out = (LAS unsigned short*)(lds + (which ? MLP_KOUT : MLP_QOUT)) + ch;
            float x0 = bf2f(in[(16 * seg + 0) * (MLP_ROWB / 2)]), x1 = bf2f(in[(16 * seg + 1) * (MLP_ROWB / 2)]), x2 = bf2f(in[(16 * seg + 2) * (MLP_ROWB / 2)]);
#pragma unroll
            for (int r = 0; r < 16; ++r) {
                const float x3 = bf2f(in[(16 * seg + r + 3) * (MLP_ROWB / 2)]);
                const float a = bias + x0 * w0 + x1 * w1 + x2 * w2 + x3 * w3;
                out[(16 * seg + r) * (MLP_ROWB / 2)] = (unsigned short)f2bf(fsilu(a) * sc);
                x0 = x1; x1 = x2; x2 = x3;
            }
        }
    }
    __syncthreads();
    const size_t cbase = ((size_t)bh * 128 + chunk) * 8192;
    for (int pi = tid; pi < 1024; pi += 512) {
        {
            const int r = pi >> 4, pc = pi & 15;
            const LAS unsigned short* qo = (const LAS unsigned short*)(lds + MLP_QOUT + r * MLP_ROWB);
            const LAS unsigned short* ko = (const LAS unsigned short*)(lds + MLP_KOUT + r * MLP_ROWB);
            unsigned qw[4], kw[4];
#pragma unroll
            for (int k2 = 0; k2 < 4; ++k2) { const int d0 = pos16(8 * pc + 2 * k2), d1 = pos16(8 * pc + 2 * k2 + 1); qw[k2] = (unsigned)qo[d0] | ((unsigned)qo[d1] << 16); kw[k2] = (unsigned)ko[d0] | ((unsigned)ko[d1] << 16); }
            u32x4 qv; qv.x = qw[0]; qv.y = qw[1]; qv.z = qw[2]; qv.w = qw[3];
            u32x4 kv; kv.x = kw[0]; kv.y = kw[1]; kv.z = kw[2]; kv.w = kw[3];
            *(u32x4*)(QC + cbase + (size_t)r * 128 + 8 * pc) = qv; *(u32x4*)(KC + cbase + (size_t)r * 128 + 8 * pc) = kv;
        }
        {
            const int d = pi >> 3, tc = pi & 7;
            const LAS unsigned short* ko = (const LAS unsigned short*)(lds + MLP_KOUT) + d;
            const LAS unsigned short* vo = (const LAS unsigned short*)(lds + MLP_VIN) + d;
            unsigned kw[4], vw[4];
#pragma unroll
            for (int k2 = 0; k2 < 4; ++k2) { const int r0 = pos16(8 * tc + 2 * k2), r1 = pos16(8 * tc + 2 * k2 + 1);
                kw[k2] = (unsigned)ko[r0 * (MLP_ROWB / 2)] | ((unsigned)ko[r1 * (MLP_ROWB / 2)] << 16); vw[k2] = (unsigned)vo[r0 * (MLP_ROWB / 2)] | ((unsigned)vo[r1 * (MLP_ROWB / 2)] << 16); }
            u32x4 kv; kv.x = kw[0]; kv.y = kw[1]; kv.z = kw[2]; kv.w = kw[3];
            u32x4 vv; vv.x = vw[0]; vv.y = vw[1]; vv.z = vw[2]; vv.w = vw[3];
            *(u32x4*)(KT + cbase + (size_t)d * 64 + 8 * tc) = kv; *(u32x4*)(VT + cbase + (size_t)d * 64 + 8 * tc) = vv;
        }
    }
    __syncthreads();
}
__device__ __forceinline__ void ml_gates_unit(int bh, const float* SB, const float* ibias, const float* fbias, float* GT, LAS unsigned char* lds, int tid) {
    const int b = bh >> 2, h = bh & 3;
    LAS float* gs = (LAS float*)lds; LAS float* am = gs + 128; LAS float* mpv = gs + 256;
    const float fb = fbias[h], ib = ibias[h];
    const int c = tid;
    const float* sp = SB + ((size_t)b * SEQ + 64 * c) * 32;
    float g = 0.f, amax = -INFINITY;
    if (tid < 128) {
        for (int i0 = 0; i0 < 64; i0 += 16) {
            float fv[16], iv[16];
#pragma unroll
            for (int k = 0; k < 16; ++k) { fv[k] = sp[(i0 + k) * 32 + 28 + h]; iv[k] = sp[(i0 + k) * 32 + 24 + h]; }
#pragma unroll
            for (int k = 0; k < 16; ++k) { const float f = fv[k] + fb; const float lf = fminf(f, 0.f) - log1pf(__expf(-fabsf(f))); g += lf; amax = fmaxf(amax, iv[k] + ib - g); }
        }
        gs[c] = g; am[c] = amax;
    }
    __syncthreads();
    if (tid == 0) { float m = 0.f; for (int k = 0; k < 128; ++k) { mpv[k] = m; m = gs[k] + fmaxf(m, am[k]); } }
    __syncthreads();
    if (tid < 128) {
        const float mp = mpv[c], mx = fmaxf(mp, amax);
        float* gt = GT + ((size_t)bh * 128 + c) * 384;
        float bc = 0.f, runmax = -INFINITY;
        for (int i0 = 0; i0 < 64; i0 += 16) {
            float fv[16], iv[16];
#pragma unroll
            for (int k = 0; k < 16; ++k) { fv[k] = sp[(i0 + k) * 32 + 28 + h]; iv[k] = sp[(i0 + k) * 32 + 24 + h]; }
#pragma unroll
            for (int k = 0; k < 16; ++k) {
                const int i = i0 + k;
                const float f = fv[k] + fb; const float lf = fminf(f, 0.f) - log1pf(__expf(-fabsf(f))); bc += lf;
                const float d = iv[k] + ib - bc;
                runmax = fmaxf(runmax, d);
                const float ei = -fmaxf(mp, runmax);
                gt[0 * 64 + i] = ei * LOG2E; gt[1 * 64 + i] = d * LOG2E; gt[2 * 64 + i] = __expf(mp + ei); gt[3 * 64 + i] = __expf(-bc + ei);
                gt[4 * 64 + pos16(i)] = __expf(d - mx);
            }
        }
        gt[5 * 64] = __expf(mp - mx);
    }
    __syncthreads();
}

constexpr int CH_Q = 0, CH_K = 16384, CH_KT = 32768, CH_VT = 49152, CH_TAB = 65536, CH_BUFSZ = 67584;
constexpr int CH_NP = 2 * CH_BUFSZ, CH_WB = CH_NP + 512, CH_DP = CH_WB + 6144, CH_RD = CH_DP + 768, CH_END = CH_RD + 512;
__device__ __forceinline__ int ct_off(int row, int ch) { return row * 128 + ((ch ^ (row & 7)) << 4); }
__device__ __forceinline__ int qk_off(int row, int ch) { return row * 256 + ((ch ^ (row & 15)) << 4); }
__device__ __forceinline__ bf16x8 pack8r(const f32x16& x, int s2) { u32x4 p; p.x = cvtpk(x[8 * s2 + 0], x[8 * s2 + 1]); p.y = cvtpk(x[8 * s2 + 2], x[8 * s2 + 3]); p.z = cvtpk(x[8 * s2 + 4], x[8 * s2 + 5]); p.w = cvtpk(x[8 * s2 + 6], x[8 * s2 + 7]); return __builtin_bit_cast(bf16x8, p); }

template <int OFF2>
__device__ __forceinline__ void lds_read8(unsigned a0, unsigned a1, unsigned a2, unsigned a3, bf16x8 (&f)[8]) {
    asm volatile("ds_read_b128 %0, %8\n\tds_read_b128 %1, %8 offset:%c12\n\tds_read_b128 %2, %9\n\tds_read_b128 %3, %9 offset:%c12\n\t"
                 "ds_read_b128 %4, %10\n\tds_read_b128 %5, %10 offset:%c12\n\tds_read_b128 %6, %11\n\tds_read_b128 %7, %11 offset:%c12\n\ts_waitcnt lgkmcnt(0)"
                 : "=&v"(f[0]), "=&v"(f[1]), "=&v"(f[2]), "=&v"(f[3]), "=&v"(f[4]), "=&v"(f[5]), "=&v"(f[6]), "=&v"(f[7])
                 : "v"(a0), "v"(a1), "v"(a2), "v"(a3), "i"(OFF2) : "memory");
}
struct ChainPtrs { const bf16 *QC, *KC, *KT, *VT; const float* GT; const bf16* ML; bf16* YB; float* RD; };

__device__ __forceinline__ void ml_chain(int bh, const ChainPtrs& P, LAS unsigned char* lds, int tid) {
    const int lane_ = tid & 63, w = __builtin_amdgcn_readfirstlane(tid >> 6);
    const int b = bh >> 2, h = bh & 3;
    const bool slicew = w < 5;
    f32x16 C[4]; C[0] = f32x16{}; C[1] = f32x16{}; C[2] = f32x16{}; C[3] = f32x16{};
    const bf16* q0 = P.QC + (size_t)bh * 128 * 8192; const bf16* k0 = P.KC + (size_t)bh * 128 * 8192;
    const bf16* kt0 = P.KT + (size_t)bh * 128 * 8192; const bf16* vt0 = P.VT + (size_t)bh * 128 * 8192;
    const float* gt0 = P.GT + (size_t)bh * 128 * 384;
    const int wl = w - 4;
#define CH_DMA(src, dstoff) __builtin_amdgcn_global_load_lds((const unsigned*)(src), (LAS unsigned*)(lds + (dstoff)), 16, 0, 0)
#define CH_LOAD(cc, par) do { if (w >= 4) { const int bo_ = (par) * CH_BUFSZ; \
        const unsigned voq = (unsigned)(((4 * wl + (lane >> 4)) * 128 + (((lane & 15) ^ ((4 * wl + (lane >> 4)) & 15)) << 3)) * 2); \
        const unsigned vot = (unsigned)((((lane >> 3)) * 64 + (((lane & 7) ^ (lane >> 3)) << 3)) * 2); \
        const char* qb_ = (const char*)q0 + (size_t)(cc) * 16384; const char* kb_ = (const char*)k0 + (size_t)(cc) * 16384; \
        const char* tb_ = (const char*)kt0 + (size_t)(cc) * 16384 + wl * 4096; const char* vb_ = (const char*)vt0 + (size_t)(cc) * 16384 + wl * 4096; \
        _Pragma("unroll") for (int k = 0; k < 4; ++k) { \
            CH_DMA(qb_ + k * 4096 + voq, bo_ + CH_Q + (wl + 4 * k) * 1024); CH_DMA(kb_ + k * 4096 + voq, bo_ + CH_K + (wl + 4 * k) * 1024); \
            CH_DMA(tb_ + k * 1024 + vot, bo_ + CH_KT + (wl * 4 + k) * 1024); CH_DMA(vb_ + k * 1024 + vot, bo_ + CH_VT + (wl * 4 + k) * 1024); } \
        if (wl == 0) { CH_DMA(gt0 + (size_t)(cc) * 384 + lane * 4, bo_ + CH_TAB); if (lane < 32) CH_DMA(gt0 + (size_t)(cc) * 384 + 256 + lane * 4, bo_ + CH_TAB + 1024); } } } while (0)
#define CH_STOREOUT(cc, par) do { if (w >= 4) { \
        u32x4 y_[4]; \
        _Pragma("unroll") for (int n = 0; n < 4; ++n) { const int row = 16 * n + 4 * wl + (lane >> 4), ch = lane & 15; y_[n] = *(const LAS u32x4*)(lds + (par) * CH_BUFSZ + CH_Q + row * 256 + ((ch ^ (row & 15)) << 4)); } \
        asm volatile("s_waitcnt lgkmcnt(0)" : "+v"(y_[0]), "+v"(y_[1]), "+v"(y_[2]), "+v"(y_[3]) :: "memory"); \
        _Pragma("unroll") for (int n = 0; n < 4; ++n) { const int row = 16 * n + 4 * wl + (lane >> 4), ch = lane & 15; \
            *(u32x4*)(P.YB + ((size_t)b * SEQ + 64 * (cc) + row) * 512 + 128 * h + 8 * ch) = y_[n]; } } } while (0)
    { const int lane = lane_; CH_LOAD(0, 0); }
    __syncthreads();
    for (int c = 0; c < 128; ++c) {
        const int par = c & 1;
        int oz; asm volatile("v_mov_b32 %0, 0" : "=v"(oz));
        const int lane = lane_ + oz, r32 = lane & 31, hi = lane >> 5;
        LAS unsigned char* bufp = lds + par * CH_BUFSZ;
        LAS float* tab = (LAS float*)(bufp + CH_TAB);
        if (c >= 1) CH_STOREOUT(c - 1, par ^ 1);
        if (c + 1 < 128) CH_LOAD(c + 1, par ^ 1);
        f32x16 acc[2]; acc[0] = f32x16{}; acc[1] = f32x16{};
        if (slicew) {
            const unsigned qb_ = (unsigned)(par * CH_BUFSZ + CH_Q);
#pragma unroll
            for (int hb = 0; hb < 2; ++hb) {
                bf16x8 qf[8];
                lds_read8<8192>(qb_ + qk_off(r32, 2 * (4 * hb + 0) + hi), qb_ + qk_off(r32, 2 * (4 * hb + 1) + hi), qb_ + qk_off(r32, 2 * (4 * hb + 2) + hi), qb_ + qk_off(r32, 2 * (4 * hb + 3) + hi), qf);
#pragma unroll
                for (int i = 0; i < 4; ++i) {
                    const int s = 4 * hb + i;
                    const bf16x8 cf = pack8r(C[s >> 1], s & 1);
                    acc[0] = __builtin_amdgcn_mfma_f32_32x32x16_bf16(cf, qf[2 * i], acc[0], 0, 0, 0);
                    acc[1] = __builtin_amdgcn_mfma_f32_32x32x16_bf16(cf, qf[2 * i + 1], acc[1], 0, 0, 0);
                }
            }
            const float sc0 = tab[2 * 64 + r32], sc1 = tab[2 * 64 + 32 + r32];
#pragma unroll
            for (int r = 0; r < 16; ++r) { acc[0][r] *= sc0; acc[1][r] *= sc1; }
        } else {
            const int jh = (w == 7) ? 1 : 0, ih = (w == 5) ? 0 : 1;
            f32x16 S = f32x16{};
            const unsigned kb2 = (unsigned)(par * CH_BUFSZ + CH_K + 8192 * jh), qb2 = (unsigned)(par * CH_BUFSZ + CH_Q + 8192 * ih);
#pragma unroll
            for (int hb = 0; hb < 2; ++hb) {
                bf16x8 kf8[8], qf8[8];
                lds_read8<0>(kb2 + qk_off(r32, 2 * (4 * hb + 0) + hi), kb2 + qk_off(r32, 2 * (4 * hb + 1) + hi), kb2 + qk_off(r32, 2 * (4 * hb + 2) + hi), kb2 + qk_off(r32, 2 * (4 * hb + 3) + hi), kf8);
                lds_read8<0>(qb2 + qk_off(r32, 2 * (4 * hb + 0) + hi), qb2 + qk_off(r32, 2 * (4 * hb + 1) + hi), qb2 + qk_off(r32, 2 * (4 * hb + 2) + hi), qb2 + qk_off(r32, 2 * (4 * hb + 3) + hi), qf8);
#pragma unroll
                for (int i = 0; i < 4; ++i) S = __builtin_amdgcn_mfma_f32_32x32x16_bf16(kf8[2 * i], qf8[2 * i], S, 0, 0, 0);
            }
            const float ei = tab[32 * ih + r32];
            const bool diag = (jh == ih);
#pragma unroll
            for (int a = 0; a < 4; ++a) {
                const f32x4 d = *(const LAS f32x4*)(tab + 64 + 32 * jh + 8 * a + 4 * hi);
#pragma unroll
                for (int i = 0; i < 4; ++i) {
                    const int r = 4 * a + i, jl = 8 * a + 4 * hi + i;
                    float wv = S[r] * __builtin_amdgcn_exp2f(ei + d[i]);
                    if (diag && jl > r32) wv = 0.f;
                    S[r] = wv;
                }
            }
            const int tix = w - 5;
            *(LAS bf16x8*)(lds + CH_WB + (tix * 2 + 0) * 1024 + lane * 16) = pack8r(S, 0);
            *(LAS bf16x8*)(lds + CH_WB + (tix * 2 + 1) * 1024 + lane * 16) = pack8r(S, 1);
        }
        asm volatile("s_waitcnt lgkmcnt(0)" ::: "memory"); __builtin_amdgcn_s_barrier(); asm volatile("" ::: "memory");
        if (slicew) {
            const int sl = w;
            const float decay = tab[5 * 64];
#pragma unroll
            for (int t4 = 0; t4 < 4; ++t4)
#pragma unroll
                for (int r = 0; r < 16; ++r) C[t4][r] *= decay;
            const unsigned vb_ = (unsigned)(par * CH_BUFSZ + CH_VT), tb_ = (unsigned)(par * CH_BUFSZ + CH_KT), wb_ = (unsigned)CH_WB + lane * 16;
            bf16x8 vfr[4], wpk[6];
            {
                const int vrow = sl < 4 ? 32 * sl + r32 : r32;
                bf16x8 t8[8];
                lds_read8<1024>(wb_ + 0 * 2048, wb_ + 1 * 2048, wb_ + 2 * 2048, vb_ + ct_off(vrow, hi), t8);
                wpk[0] = t8[0]; wpk[1] = t8[1]; wpk[2] = t8[2]; wpk[3] = t8[3]; wpk[4] = t8[4]; wpk[5] = t8[5]; vfr[0] = t8[6];
                bf16x8 u8[8];
                lds_read8<0>(vb_ + ct_off(vrow, 2 + hi), vb_ + ct_off(vrow, 4 + hi), vb_ + ct_off(vrow, 6 + hi), vb_ + ct_off(vrow, 6 + hi), u8);
                vfr[1] = u8[0]; vfr[2] = u8[2]; vfr[3] = u8[4];
                if (sl == 4) { const short one = (r32 == 0) ? (short)0x3F80 : (short)0; const bf16x8 o8 = {one, one, one, one, one, one, one, one}; vfr[0] = o8; vfr[1] = o8; vfr[2] = o8; vfr[3] = o8; }
            }
            bf16x8 svf[4];
#pragma unroll
            for (int ks = 0; ks < 4; ++ks) {
                const bf16x8 vf = vfr[ks];
                if (ks < 2) { acc[0] = __builtin_amdgcn_mfma_f32_32x32x16_bf16(vf, wpk[0 * 2 + ks], acc[0], 0, 0, 0);
                              acc[1] = __builtin_amdgcn_mfma_f32_32x32x16_bf16(vf, wpk[1 * 2 + ks], acc[1], 0, 0, 0); }
                else acc[1] = __builtin_amdgcn_mfma_f32_32x32x16_bf16(vf, wpk[2 * 2 + (ks - 2)], acc[1], 0, 0, 0);
                const f32x4 sa = *(const LAS f32x4*)(tab + 4 * 64 + 16 * ks + 8 * hi), sb = *(const LAS f32x4*)(tab + 4 * 64 + 16 * ks + 8 * hi + 4);
                const u32x4 vx = __builtin_bit_cast(u32x4, vf);
                u32x4 sv; sv.x = cvtpk(bflo(vx.x) * sa[0], bfhi(vx.x) * sa[1]); sv.y = cvtpk(bflo(vx.y) * sa[2], bfhi(vx.y) * sa[3]);
                sv.z = cvtpk(bflo(vx.z) * sb[0], bfhi(vx.z) * sb[1]); sv.w = cvtpk(bflo(vx.w) * sb[2], bfhi(vx.w) * sb[3]);
                svf[ks] = __builtin_bit_cast(bf16x8, sv);
            }
#pragma unroll
            for (int kp = 0; kp < 2; ++kp) {
                bf16x8 kt8[8];
                lds_read8<4096>(tb_ + ct_off(r32, 2 * (2 * kp) + hi), tb_ + ct_off(64 + r32, 2 * (2 * kp) + hi), tb_ + ct_off(r32, 2 * (2 * kp + 1) + hi), tb_ + ct_off(64 + r32, 2 * (2 * kp + 1) + hi), kt8);
                C[0] = __builtin_amdgcn_mfma_f32_32x32x16_bf16(kt8[0], svf[2 * kp], C[0], 0, 0, 0);
                C[1] = __builtin_amdgcn_mfma_f32_32x32x16_bf16(kt8[1], svf[2 * kp], C[1], 0, 0, 0);
                C[2] = __builtin_amdgcn_mfma_f32_32x32x16_bf16(kt8[2], svf[2 * kp], C[2], 0, 0, 0);
                C[3] = __builtin_amdgcn_mfma_f32_32x32x16_bf16(kt8[3], svf[2 * kp], C[3], 0, 0, 0);
                C[0] = __builtin_amdgcn_mfma_f32_32x32x16_bf16(kt8[4], svf[2 * kp + 1], C[0], 0, 0, 0);
                C[1] = __builtin_amdgcn_mfma_f32_32x32x16_bf16(kt8[5], svf[2 * kp + 1], C[1], 0, 0, 0);
                C[2] = __builtin_amdgcn_mfma_f32_32x32x16_bf16(kt8[6], svf[2 * kp + 1], C[2], 0, 0, 0);
                C[3] = __builtin_amdgcn_mfma_f32_32x32x16_bf16(kt8[7], svf[2 * kp + 1], C[3], 0, 0, 0);
            }
            if (sl < 4) {
#pragma unroll
                for (int ih = 0; ih < 2; ++ih) {
                    const int i = 32 * ih + r32;
#pragma unroll
                    for (int a = 0; a < 4; ++a) {
                        u32x2 yv; yv.x = cvtpk(acc[ih][4 * a], acc[ih][4 * a + 1]); yv.y = cvtpk(acc[ih][4 * a + 2], acc[ih][4 * a + 3]);
                        *(LAS u32x2*)(bufp + CH_Q + i * 256 + (((4 * sl + a) ^ (i & 15)) << 4) + 8 * hi) = yv;
                    }
                }
            } else if (hi == 0) {
                const float d0 = acc[0][0], d1 = acc[1][0];
                float* rp = P.RD + ((size_t)b * SEQ + 64 * c) * 4 + h;
                rp[(size_t)r32 * 4] = 1.f / fmaxf(fabsf(d0), tab[3 * 64 + r32]);
                rp[(size_t)(32 + r32) * 4] = 1.f / fmaxf(fabsf(d1), tab[3 * 64 + 32 + r32]);
            }
        }
        __syncthreads();
    }
    { const int lane = lane_; CH_STOREOUT(127, 1); }
    __syncthreads();
#undef CH_LOAD
#undef CH_DMA
#undef CH_STOREOUT
}
struct Args { const float* in[26]; float* out; unsigned char* ws; int ph_lo, ph_hi; };

__global__ void __launch_bounds__(NWAVES * 64, 2) mk_fwd(Args args) {
    extern __shared__ __attribute__((aligned(16))) unsigned char lds_raw[];
    LAS unsigned char* lds = (LAS unsigned char*)lds_raw;
    const int tid = threadIdx.x, lane = tid & 63, wave = __builtin_amdgcn_readfirstlane(tid >> 6);
    const int G = gridDim.x; const int bx = blockIdx.x;
    const int vcu = (G % 8 == 0) ? (bx % 8) * (G / 8) + bx / 8 : bx;
    unsigned char* ws = args.ws;
    const float* x = args.in[0];
    bf16* WinT = (bf16*)(ws + WS_WIN); bf16* WaT = (bf16*)(ws + WS_WA); bf16* WbT = (bf16*)(ws + WS_WB); bf16* WoT = (bf16*)(ws + WS_WO);
    bf16* W1T = (bf16*)(ws + WS_W1); bf16* W2T = (bf16*)(ws + WS_W2);
    bf16* XN = (bf16*)(ws + WS_XN); bf16* QN = (bf16*)(ws + WS_QN); bf16* KV = (bf16*)(ws + WS_KV); bf16* ML = (bf16*)(ws + WS_ML); bf16* GB = (bf16*)(ws + WS_G);
    float* SB = (float*)(ws + WS_S); bf16* YA = (bf16*)(ws + WS_YA); bf16* YB = (bf16*)(ws + WS_YB); bf16* MX = (bf16*)(ws + WS_MX); bf16* UB = (bf16*)(ws + WS_U);
    float* rowss = (float*)(ws + WS_CTL + CTL_ROWSS);
    bf16* CK1T = (bf16*)(ws + WS_CK1); bf16* CV1T = (bf16*)(ws + WS_CV1); bf16* CK2T = (bf16*)(ws + WS_SMALL); bf16* CV2T = (bf16*)(ws + WS_SMALL + 32768);
    float* B1K = (float*)(ws + WS_SMALL + 65536); float* B1V = (float*)(ws + WS_SMALL + 65536 + 1024); float* BOUNDS = (float*)(ws + WS_SMALL + 65536 + 2048);
    bf16* KSN = (bf16*)(ws + WS_KSN); bf16* KWN = (bf16*)(ws + WS_KWN); bf16* VST = (bf16*)(ws + WS_VST); bf16* VWT = (bf16*)(ws + WS_VWT); bf16* KCN = (bf16*)(ws + WS_KCN); bf16* VCT = (bf16*)(ws + WS_VCT);
    bf16* QCb = (bf16*)args.out; bf16* KCb = QCb + (size_t)16 * 128 * 8192; bf16* KTb = KCb + (size_t)16 * 128 * 8192; bf16* VTb = KTb + (size_t)16 * 128 * 8192;
    float* GTb = (float*)(ws + WS_GT); float* RDb = (float*)(ws + WS_RD);
    volatile LAS unsigned* xbst = (volatile LAS unsigned*)(lds + XB_LDS_OFF);
    if (tid < 2) xbst[tid] = 0u;
    __syncthreads();
    XcdBarrier xbar = xcd_barrier_post((unsigned*)(ws + WS_CTL + CTL_BAR), xbst);
    const int lo = args.ph_lo, hi = args.ph_hi;
#define IN(k) (lo <= (k) && (k) < hi)
#define SEAM(k) do { if (IN(k) && IN((k) + 1)) { xcd_barrier(xbar); } } while (0)

    if (IN(0)) {
        LAS float* scr = (LAS float*)(lds + wave * 16384);
        const int gw = vcu * NWAVES + wave, NGW = G * NWAVES;
        constexpr int I_IN = (1024 / 64) * (NP_PAD / 32), I_A = (512 / 64) * (1024 / 32), I_O = (1024 / 64) * (1024 / 32), I_1 = (1024 / 64) * (4096 / 32), I_2 = (4096 / 64) * (1024 / 32);
        constexpr int I_C1 = (2048 / 64) * (256 / 32), I_C2 = (256 / 64) * (64 / 32), I_B1 = 512;
        constexpr int NITEMS = I_IN + 2 * I_A + I_O + I_1 + I_2 + 2 * I_C1 + 2 * I_C2 + I_B1 + 1;
        for (int it = gw; it < NITEMS; it += NGW) {
            int r = it;
            if (r < I_IN) { transpose_item<true>(args.in[2], 1024, D_PROJ, args.in[1], WinT, NP_PAD, scr, r, lane); continue; } r -= I_IN;
            if (r < I_A) { transpose_item<false>(args.in[20], 512, 1024, nullptr, WaT, 1024, scr, r, lane); continue; } r -= I_A;
            if (r < I_A) { transpose_item<false>(args.in[21], 512, 1024, nullptr, WbT, 1024, scr, r, lane); continue; } r -= I_A;
            if (r < I_O) { transpose_item<false>(args.in[22], 1024, 1024, nullptr, WoT, 1024, scr, r, lane); continue; } r -= I_O;
            if (r < I_1) { transpose_item<false>(args.in[24], 1024, 4096, args.in[23], W1T, 4096, scr, r, lane); continue; } r -= I_1;
            if (r < I_2) { transpose_item<false>(args.in[25], 4096, 1024, nullptr, W2T, 1024, scr, r, lane); continue; } r -= I_2;
            if (r < I_C1) { transpose_item<false>(args.in[6], 2048, 256, nullptr, CK1T, 256, scr, r, lane); continue; } r -= I_C1;
            if (r < I_C1) { transpose_item<false>(args.in[11], 2048, 256, nullptr, CV1T, 256, scr, r, lane); continue; } r -= I_C1;
            if (r < I_C2) { transpose_item<false>(args.in[8], 256, 64, nullptr, CK2T, 64, scr, r, lane); continue; } r -= I_C2;
            if (r < I_C2) { transpose_item<false>(args.in[13], 256, 64, nullptr, CV2T, 64, scr, r, lane); continue; } r -= I_C2;
            if (r < I_B1) {
                const int kv = r >> 8, u = r & 255; const float* pos = args.in[kv ? 10 : 5]; const float* w1 = args.in[kv ? 11 : 6]; const float* b1 = args.in[kv ? 12 : 7];
                float a = 0.f;
                for (int i = lane; i < 2048; i += 64) a += pos[i] * w1[(size_t)i * 256 + u];
                a = wave_sum(a);
                if (lane == 0) (kv ? B1V : B1K)[u] = a + b1[u];
                continue; } r -= I_B1;
            {
                float gq = fabsf(args.in[3][lane]); float gk = fmaxf(fmaxf(fabsf(args.in[4][lane]), fabsf(args.in[4][64 + lane])), fabsf(args.in[4][128 + lane]));
                gq = wave_max(gq); gk = wave_max(gk);
                if (lane < 8) { float mb = -1e30f; for (int bk = 0; bk < 32; ++bk) mb = fmaxf(mb, args.in[15][bk * 8 + lane] - args.in[15][31 * 8 + lane]);
                    const float top = (8.f * gq * gk + mb) * 1.4426950408889634f;
                    BOUNDS[lane] = top > 100.f ? 100.f - top : 0.f; }
            }
        }
        for (int m = gw; m < NTOK; m += NGW) rms_row_to_bf16(x + (size_t)m * D_MODEL, XN + (size_t)m * D_MODEL, lane);
    }
    SEAM(0);
    if (IN(1)) {
        pg8::Gemm g{XN, WinT, NTOK, NP_PAD, 1024}; pg8::StaticOrder S; S.init(NTOK, NP_PAD, G, bx);
        pg8::EpiProj E{QN, KV, ML, GB, SB};
        pg8::gemm_phase<pg8::EpiProj, pg8::StaticOrder, true, true>(lds, g, S, E);
    }
    SEAM(1);
    if (IN(2)) {
        const float* kgain = args.in[4];
        if (bx < 128) { const int kvs = bx & 1; compress_unit(bx, KV, kvs ? CV1T : CK1T, kvs ? CV2T : CK2T, kvs ? B1V : B1K, args.in[kvs ? 14 : 9], kgain, KCN, VCT, lds, tid); }
        else if (bx < 144) ml_gates_unit(bx - 128, SB, args.in[18], args.in[19], GTb, lds, tid);
        unsigned* pctr = (unsigned*)(ws + WS_CTL + CTL_QCTR) + 64;
        LAS int* pm = (LAS int*)(lds + 147000);
        LAS unsigned short* scr = (LAS unsigned short*)(lds + wave * 17408);
        for (;;) {
            __syncthreads();
            if (tid == 0) pm[0] = (int)atomicAdd(pctr, 1u);
            __syncthreads();
            const int u = pm[0];
            if (u >= 2048 + 512) break;
            if (u < 2048) ml_prep_unit(u, ML, args.in[16], args.in[17], QCb, KCb, KTb, VTb, lds, tid);
            else {
                const int it = (u - 2048) * 8 + wave;
                const int kind = it & 3, bgj = it >> 2, bg = bgj >> 7, j = bgj & 127, b = bg >> 1, g = bg & 1;
                const size_t tok0 = (size_t)b * SEQ + 64 * j;
                if (kind == 0) knorm_item(KV, 256 + 64 * g, kgain + 64, KSN + ((size_t)bg * SEQ + 64 * j) * 64, tok0, lane);
                else if (kind == 1) knorm_item(KV, 512 + 64 * g, kgain + 128, KWN + ((size_t)bg * SEQ + 64 * j) * 64, tok0, lane);
                else if (kind == 2) vtrans_item(KV, 384 + 64 * g, VST + ((size_t)bg * 128 + j) * 4096, tok0, scr, lane);
                else vtrans_item(KV, 640 + 64 * g, VWT + ((size_t)bg * 128 + j) * 4096, tok0, scr, lane);
            }
        }
    }
    SEAM(2);
    if (IN(3)) {
        if (bx < 16) { ChainPtrs CP{QCb, KCb, KTb, VTb, GTb, ML, YB, RDb}; ml_chain(bx, CP, lds, tid); }
        EngPtrs P{QN, KCN, VCT, KSN, VST, KWN, VWT, SB, args.in[15], args.in[3], BOUNDS, YA};
        unsigned* qctr = (unsigned*)(ws + WS_CTL + CTL_QCTR);
        LAS int* misc = (LAS int*)(lds + ENG_MISC);
        __syncthreads();
        eng_tables(args.in[15], lds, tid);
        if (tid == 0) misc[0] = (int)atomicAdd(qctr, 1u);
        __syncthreads();
        for (;;) {
            const int u = misc[0];
            if (u >= 1024) break;
            int nxt = 0;
            if (tid == 0) nxt = (int)atomicAdd(qctr, 1u);
            eng_unit(u, P, lds, tid);
            if (tid == 0) misc[0] = nxt;
            __syncthreads();
        }
    }
    SEAM(3);
    if (IN(4)) {
        {
            const int gt_ = bx * (NWAVES * 64) + tid, GT_ = G * NWAVES * 64;
            for (int i = gt_; i < NTOK * 64; i += GT_) {
                const int row = i >> 6, c8 = (i & 63) * 8;
                const v4u y = *(const v4u*)(YB + (size_t)row * 512 + c8), o = *(const v4u*)(ML + (size_t)row * 2048 + 1536 + c8);
                const float rd = RDb[(size_t)row * 4 + (c8 >> 7)];
                v4u r;
                r.x = pg8::cvt_pk_bf16(pg8::bf_lo(y.x) * pg8::bf_lo(o.x) * rd, pg8::bf_hi(y.x) * pg8::bf_hi(o.x) * rd); r.y = pg8::cvt_pk_bf16(pg8::bf_lo(y.y) * pg8::bf_lo(o.y) * rd, pg8::bf_hi(y.y) * pg8::bf_hi(o.y) * rd);
                r.z = pg8::cvt_pk_bf16(pg8::bf_lo(y.z) * pg8::bf_lo(o.z) * rd, pg8::bf_hi(y.z) * pg8::bf_hi(o.z) * rd); r.w = pg8::cvt_pk_bf16(pg8::bf_lo(y.w) * pg8::bf_lo(o.w) * rd, pg8::bf_hi(y.w) * pg8::bf_hi(o.w) * rd);
                *(v4u*)(YB + (size_t)row * 512 + c8) = r;
            }
        }
        pg8::Gemm g{YA, WaT, NTOK, 1024, 512}; pg8::StaticOrder S; S.init(NTOK, 1024, G, bx);
        pg8::EpiGate<false> E{GB, 0, MX};
        pg8::gemm_phase<pg8::EpiGate<false>, pg8::StaticOrder, true, true>(lds, g, S, E);
    }
    SEAM(4);
    if (IN(5)) {
        pg8::Gemm g{YB, WbT, NTOK, 1024, 512}; pg8::StaticOrder S; S.init(NTOK, 1024, G, bx);
        pg8::EpiGate<true> E{GB, 1024, MX};
        pg8::gemm_phase<pg8::EpiGate<true>, pg8::StaticOrder, true, true>(lds, g, S, E);
    }
    SEAM(5);
    if (IN(6)) {
        pg8::Gemm g{MX, WoT, NTOK, 1024, 1024}; pg8::StaticOrder S; S.init(NTOK, 1024, G, bx);
        pg8::EpiOut E{x, args.out, XN, rowss};
        pg8::gemm_phase<pg8::EpiOut, pg8::StaticOrder, true, true>(lds, g, S, E);
    }
    SEAM(6);
    if (IN(7)) {
        pg8::Gemm g{XN, W1T, NTOK, 4096, 1024}; pg8::StaticOrder S; S.init(NTOK, 4096, G, bx);
        pg8::EpiFF1 E{rowss, UB};
        pg8::gemm_phase<pg8::EpiFF1, pg8::StaticOrder, true, true>(lds, g, S, E);
    }
    SEAM(7);
    if (IN(8)) {
        pg8::Gemm g{UB, W2T, NTOK, 1024, 4096}; pg8::StaticOrder S; S.init(NTOK, 1024, G, bx);
        pg8::EpiFF2 E{args.out};
        pg8::gemm_phase<pg8::EpiFF2, pg8::StaticOrder, true, true>(lds, g, S, E);
    }
#undef IN
#undef SEAM
}

extern "C" void kernel_launch(void* const* d_in, const int* in_sizes, int n_in, void* d_out, int out_size, void* d_ws, size_t ws_size, hipStream_t stream) {
    static int grid = 0;
    if (grid == 0) {
        int dev = 0, cus = 0, per_cu = 0;
        if (hipGetDevice(&dev) != hipSuccess || hipDeviceGetAttribute(&cus, hipDeviceAttributeMultiprocessorCount, dev) != hipSuccess) { grid = -1; return; }
        if (hipFuncSetAttribute((const void*)mk_fwd, hipFuncAttributeMaxDynamicSharedMemorySize, LDS_BYTES) != hipSuccess) { fprintf(stderr, "hipFuncSetAttribute failed\n"); grid = -1; return; }
        if (hipOccupancyMaxActiveBlocksPerMultiprocessor(&per_cu, (const void*)mk_fwd, NWAVES * 64, LDS_BYTES) != hipSuccess || per_cu < 1) { fprintf(stderr, "occupancy query failed (%d)\n", per_cu); grid = -1; return; }
        if (ws_size < WS_END) { fprintf(stderr, "workspace too small: %zu < %zu\n", ws_size, (size_t)WS_END); grid = -1; return; }
        grid = cus;
    }
    if (grid < 0) return;
    (void)hipMemsetAsync((char*)d_ws + WS_CTL, 0, CTL_ZERO_BYTES, stream);
    Args a{};
    for (int i = 0; i < 26; ++i) a.in[i] = (const float*)d_in[i];
    a.out = (float*)d_out; a.ws = (unsigned char*)d_ws; a.ph_lo = 0; a.ph_hi = 9;
    void* kargs[] = {&a};
    hipError_t e = hipLaunchCooperativeKernel((const void*)mk_fwd, dim3(grid), dim3(NWAVES * 64), kargs, LDS_BYTES, stream);
    if (e != hipSuccess) fprintf(stderr, "cooperative launch failed: %s (grid %d)\n", hipGetErrorString(e), grid);
}
```

```cpp
#include <hip/hip_runtime.h>
#include <cstdint>
#include <cstdio>
#include <hip/hip_cooperative_groups.h>
namespace cg = cooperative_groups;
namespace pg8 {
#define PG8_LAS __attribute__((address_space(3)))
typedef unsigned short bf16_t;
typedef short bf16x8 __attribute__((ext_vector_type(8)));
typedef float f32x4 __attribute__((ext_vector_type(4)));
typedef unsigned u32x4 __attribute__((ext_vector_type(4)));
constexpr int BM = 256, BK = 64, HALF = 128, HTB = HALF * BK * 2  , STAGE_BYTES = 8 * HTB, NXCD = 8, WGM = 8;

__host__ __device__ __forceinline__ int lds_byte(int r, int c) { const int st = (r >> 4) * 2 + (c >> 5), rr = r & 15, cc = c & 31, ob = rr * 64 + cc * 2; return st * 1024 + (ob ^ (((ob >> 9) & 1) << 5)); }
__host__ __device__ __forceinline__ void stage_rc(int b, int& R, int& C) { const int st = b / 1024, sb = b % 1024, swz = sb ^ (((sb >> 9) & 1) << 5); R = (st >> 1) * 16 + swz / 64; C = (st & 1) * 32 + (swz % 64) / 2; }
__host__ __device__ __forceinline__ int perm32(int rho) { const int n = rho >> 4, i = rho & 15; return 8 * (i >> 2) + 4 * n + (i & 3); }

struct Unit { int pm, pn; };
struct Gemm { const bf16_t* A; const bf16_t* Bt; int M, N, K; };

struct StaticOrder {
    int nM, nN, nwg, G, c;
    __host__ __device__ void init(int M, int N, int G_, int c_) { nM = M / BM; nN = N / BM; nwg = nM * nN; G = G_; c = c_; }
    __host__ __device__ bool next(int i, Unit& u) const {
        const long L = (long)i * G + c; if (L >= nwg) return false;
        int wgid = (int)L; { const int q = nwg / NXCD, r = nwg % NXCD, xcd = wgid % NXCD, off = wgid / NXCD; wgid = (xcd < r ? xcd * (q + 1) : r * (q + 1) + (xcd - r) * q) + off; }
        const int nig = WGM * nN, gid = wgid / nig, fm = gid * WGM, gsz = (nM - fm) < WGM ? (nM - fm) : WGM;
        u.pm = fm + ((wgid % nig) % gsz); u.pn = (wgid % nig) / gsz; return true;
    }
    __device__ __forceinline__ void a_ready(const Unit&) const {}
    __device__ __forceinline__ void done(const Unit&) const {}
};
__device__ __forceinline__ unsigned cvt_pk_bf16(float lo, float hi) { unsigned r; asm volatile("v_cvt_pk_bf16_f32 %0, %1, %2" : "=v"(r) : "v"(lo), "v"(hi)); return r; }
__device__ __forceinline__ float bf_lo(unsigned w) { return __uint_as_float(w << 16); }
__device__ __forceinline__ float bf_hi(unsigned w) { return __uint_as_float(w & 0xffff0000u); }
__device__ __forceinline__ float fsigmoid(float v) { return __builtin_amdgcn_rcpf(1.f + __builtin_amdgcn_exp2f(-1.4426950408889634f * v)); }
__device__ __forceinline__ u32x4 pack8(const f32x4 v0, const f32x4 v1) { u32x4 w; w.x = cvt_pk_bf16(v0[0], v0[1]); w.y = cvt_pk_bf16(v0[2], v0[3]); w.z = cvt_pk_bf16(v1[0], v1[1]); w.w = cvt_pk_bf16(v1[2], v1[3]); return w; }

struct EpiProj {
    static constexpr bool PERM = true, AFTER_DRAIN = false;
    bf16_t *Qn, *KV, *ML, *G; float* S;
    __device__ __forceinline__ void operator()(const f32x4 (&acc)[2][2][4][2], const Unit& u, int wr, int wc, int fr, int fq) const {
        const int pn = u.pn, row0 = u.pm * BM + wr * 64 + fr;
        if (pn == 21) {
            if (wc == 0) {
#pragma unroll
                for (int ai = 0; ai < 2; ++ai)
#pragma unroll
                    for (int m = 0; m < 4; ++m) { float* p = S + (size_t)(row0 + ai * HALF + m * 16) * 32 + 8 * fq; *(f32x4*)p = acc[ai][0][m][0]; *(f32x4*)(p + 4) = acc[ai][0][m][1]; }
            }
            return;
        }
        bf16_t* base; int ld, ct; bool sig = false;
        if (pn < 2) { base = Qn; ld = 512; ct = pn; }
        else if (pn < 5) { base = KV; ld = 768; ct = pn - 2; }
        else if (pn < 13) { base = ML; ld = 2048; ct = pn - 5; sig = (pn >= 11); }
        else { base = G; ld = 2048; ct = pn - 13; sig = true; }
        const int col0 = ct * 256 + wc * 32 + 8 * fq;
#pragma unroll
        for (int ai = 0; ai < 2; ++ai)
#pragma unroll
            for (int m = 0; m < 4; ++m) { bf16_t* rowp = base + (size_t)(row0 + ai * HALF + m * 16) * ld + col0;
#pragma unroll
                for (int bj = 0; bj < 2; ++bj) { f32x4 v0 = acc[ai][bj][m][0], v1 = acc[ai][bj][m][1];
                    if (sig) {
#pragma unroll
                        for (int i = 0; i < 4; ++i) { v0[i] = fsigmoid(v0[i]); v1[i] = fsigmoid(v1[i]); } }
                    *(u32x4*)(rowp + bj * HALF) = pack8(v0, v1); } }
    }
};
template <bool ACCUM> struct EpiGate {
    static constexpr bool PERM = true, AFTER_DRAIN = false;
    const bf16_t* G; int gcol0; bf16_t* Mx;
    __device__ __forceinline__ void operator()(const f32x4 (&acc)[2][2][4][2], const Unit& u, int wr, int wc, int fr, int fq) const {
        const int row0 = u.pm * BM + wr * 64 + fr, col0 = u.pn * BM + wc * 32 + 8 * fq;
#pragma unroll
        for (int ai = 0; ai < 2; ++ai)
#pragma unroll
            for (int m = 0; m < 4; ++m) { const size_t row = (size_t)(row0 + ai * HALF + m * 16);
#pragma unroll
                for (int bj = 0; bj < 2; ++bj) {
                    const u32x4 g = *(const u32x4*)(G + row * 2048 + gcol0 + col0 + bj * HALF);
                    f32x4 v0 = acc[ai][bj][m][0], v1 = acc[ai][bj][m][1];
                    v0[0] *= bf_lo(g.x); v0[1] *= bf_hi(g.x); v0[2] *= bf_lo(g.y); v0[3] *= bf_hi(g.y);
                    v1[0] *= bf_lo(g.z); v1[1] *= bf_hi(g.z); v1[2] *= bf_lo(g.w); v1[3] *= bf_hi(g.w);
                    bf16_t* mp = Mx + row * 1024 + col0 + bj * HALF;
                    if (ACCUM) { const u32x4 o = *(const u32x4*)mp;
                        v0[0] += bf_lo(o.x); v0[1] += bf_hi(o.x); v0[2] += bf_lo(o.y); v0[3] += bf_hi(o.y);
                        v1[0] += bf_lo(o.z); v1[1] += bf_hi(o.z); v1[2] += bf_lo(o.w); v1[3] += bf_hi(o.w); }
                    *(u32x4*)mp = pack8(v0, v1); } }
    }
};
struct EpiOut {
    static constexpr bool PERM = true, AFTER_DRAIN = false;
    const float* x; float* x1; bf16_t* x1b; float* rowss;
    __device__ __forceinline__ void operator()(const f32x4 (&acc)[2][2][4][2], const Unit& u, int wr, int wc, int fr, int fq) const {
        const int row0 = u.pm * BM + wr * 64 + fr, col0 = u.pn * BM + wc * 32 + 8 * fq;
#pragma unroll
        for (int ai = 0; ai < 2; ++ai)
#pragma unroll
            for (int m = 0; m < 4; ++m) { const size_t row = (size_t)(row0 + ai * HALF + m * 16); float ss = 0.f;
#pragma unroll
                for (int bj = 0; bj < 2; ++bj) { const size_t off = row * 1024 + col0 + bj * HALF;
                    const f32x4 v0 = acc[ai][bj][m][0] + *(const f32x4*)(x + off), v1 = acc[ai][bj][m][1] + *(const f32x4*)(x + off + 4);
                    *(f32x4*)(x1 + off) = v0; *(f32x4*)(x1 + off + 4) = v1; *(u32x4*)(x1b + off) = pack8(v0, v1);
                    ss += (v0[0] * v0[0] + v0[1] * v0[1]) + (v0[2] * v0[2] + v0[3] * v0[3]) + (v1[0] * v1[0] + v1[1] * v1[1]) + (v1[2] * v1[2] + v1[3] * v1[3]); }
                ss += __shfl_xor(ss, 16); ss += __shfl_xor(ss, 32);
                if (fq == 0) atomicAdd(rowss + row, ss); }
    }
};
struct EpiFF1 {
    static constexpr bool PERM = true, AFTER_DRAIN = false;
    const float* rowss; bf16_t* U;
    __device__ __forceinline__ void operator()(const f32x4 (&acc)[2][2][4][2], const Unit& u, int wr, int wc, int fr, int fq) const {
        const int row0 = u.pm * BM + wr * 64 + fr, col0 = u.pn * BM + wc * 32 + 8 * fq;
#pragma unroll
        for (int ai = 0; ai < 2; ++ai)
#pragma unroll
            for (int m = 0; m < 4; ++m) { const size_t row = (size_t)(row0 + ai * HALF + m * 16);
                const float rs = 1.0f / sqrtf(rowss[row] * (1.f / 1024.f) + 1e-6f);
#pragma unroll
                for (int bj = 0; bj < 2; ++bj) { f32x4 v0 = acc[ai][bj][m][0] * rs, v1 = acc[ai][bj][m][1] * rs;
#pragma unroll
                    for (int i = 0; i < 4; ++i) { const float a = fmaxf(v0[i], 0.f), b = fmaxf(v1[i], 0.f); v0[i] = a * a; v1[i] = b * b; }
                    *(u32x4*)(U + row * 4096 + col0 + bj * HALF) = pack8(v0, v1); } }
    }
};
struct EpiFF2 {
    static constexpr bool PERM = true, AFTER_DRAIN = false;
    float* out;
    __device__ __forceinline__ void operator()(const f32x4 (&acc)[2][2][4][2], const Unit& u, int wr, int wc, int fr, int fq) const {
        const int row0 = u.pm * BM + wr * 64 + fr, col0 = u.pn * BM + wc * 32 + 8 * fq;
#pragma unroll
        for (int ai = 0; ai < 2; ++ai)
#pragma unroll
            for (int m = 0; m < 4; ++m) { const size_t row = (size_t)(row0 + ai * HALF + m * 16);
#pragma unroll
                for (int bj = 0; bj < 2; ++bj) { float* p = out + row * 1024 + col0 + bj * HALF;
                    const f32x4 v0 = acc[ai][bj][m][0] + *(const f32x4*)p, v1 = acc[ai][bj][m][1] + *(const f32x4*)(p + 4);
                    *(f32x4*)p = v0; *(f32x4*)(p + 4) = v1; } }
    }
};
template <class Epi, class Sched, bool ALIGN_EPI = false, bool SP2 = false>
__device__ __forceinline__ void gemm_phase(PG8_LAS unsigned char* lds, const Gemm g, const Sched& S, const Epi& E) {
    const int tid = threadIdx.x, wid = __builtin_amdgcn_readfirstlane(tid >> 6), lane = tid & 63, wr = wid >> 2, wc = wid & 3, fr = lane & 15, fq = lane >> 4;
    const int K = g.K, nt = K / BK;
    unsigned voffA[2], voffB[2];
#pragma unroll
    for (int i = 0; i < 2; ++i) { int R, C; stage_rc(tid * 16 + i * 8192, R, C); const int Rb = Epi::PERM ? ((R & ~31) + perm32(R & 31)) : R;
        voffA[i] = (unsigned)(R * K + C) * 2u; voffB[i] = (unsigned)(Rb * K + C) * 2u; }
    const size_t kstep = (size_t)(BK * 2);
    const size_t hstep = (size_t)HALF * K * 2;
    const size_t tstep = 2 * hstep;
    const unsigned ldsw = (unsigned)wid * 1024u;
    const int aoff = lds_byte(wr * 64 + fr, fq * 8), boff = lds_byte(wc * 32 + fr, fq * 8);
#define PG8_SA(b, h) (((b) * 2 + (h)) * HTB)
#define PG8_SB(b, h) ((4 + (b) * 2 + (h)) * HTB)
#define PG8_STAGE(bufoff, gbase, voff) do { _Pragma("unroll") for (int _i = 0; _i < 2; ++_i) \
        __builtin_amdgcn_global_load_lds((const unsigned*)((const char*)(gbase) + (voff)[_i]), (PG8_LAS unsigned*)(lds + (bufoff) + ldsw + _i * 8192), 16, 0, 0); } while (0)
#define PG8_LDA(dst, b, h) do { _Pragma("unroll") for (int m = 0; m < 4; ++m) _Pragma("unroll") for (int k = 0; k < 2; ++k) dst[m][k] = *(const PG8_LAS bf16x8*)(lds + PG8_SA(b, h) + aoff + m * 2048 + k * 1024); } while (0)
#define PG8_LDB(dst, b, h) do { _Pragma("unroll") for (int n = 0; n < 2; ++n) _Pragma("unroll") for (int k = 0; k < 2; ++k) dst[n][k] = *(const PG8_LAS bf16x8*)(lds + PG8_SB(b, h) + boff + n * 2048 + k * 1024); } while (0)
#define PG8_MMA(ai, bj, At, Bt) do { __builtin_amdgcn_s_setprio(1); _Pragma("unroll") for (int m = 0; m < 4; ++m) _Pragma("unroll") for (int n = 0; n < 2; ++n) _Pragma("unroll") for (int k = 0; k < 2; ++k) \
        acc[ai][bj][m][n] = __builtin_amdgcn_mfma_f32_16x16x32_bf16(Bt[n][k], At[m][k], acc[ai][bj][m][n], 0, 0, 0); __builtin_amdgcn_s_setprio(0); } while (0)
#define PG8_WAIT_V(n) asm volatile("s_waitcnt vmcnt(" #n ")" ::: "memory")
#define PG8_WAIT_L(n) asm volatile("s_waitcnt lgkmcnt(" #n ")" ::: "memory")
#define PG8_BAR __builtin_amdgcn_s_barrier()
#define PG8_SCHED __builtin_amdgcn_sched_barrier(0)
    Unit cur, nxt; int ui = 0;
    if (!S.next(0, cur)) return;
    f32x4 acc[2][2][4][2];
#pragma unroll
    for (int a = 0; a < 2; ++a)
#pragma unroll
        for (int b = 0; b < 2; ++b)
#pragma unroll
            for (int m = 0; m < 4; ++m)
#pragma unroll
                for (int n = 0; n < 2; ++n) acc[a][b][m][n] = (f32x4){0.f, 0.f, 0.f, 0.f};
    bf16x8 At[4][2], B0[2][2], B1[2][2];
    const char* cA = (const char*)g.A + (size_t)cur.pm * tstep; const char* cB = (const char*)g.Bt + (size_t)cur.pn * tstep;
    S.a_ready(cur);
    if constexpr (SP2) {
        PG8_STAGE(PG8_SB(0, 0), cB, voffB); PG8_STAGE(PG8_SB(0, 1), cB + hstep, voffB); PG8_STAGE(PG8_SA(0, 0), cA, voffA); PG8_STAGE(PG8_SA(0, 1), cA + hstep, voffA);
        if (wr == 1) PG8_BAR;
        PG8_WAIT_V(2); PG8_BAR;
        PG8_STAGE(PG8_SB(1, 0), cB + kstep, voffB); PG8_STAGE(PG8_SA(1, 0), cA + kstep, voffA); PG8_STAGE(PG8_SB(1, 1), cB + hstep + kstep, voffB);
        PG8_WAIT_V(6); PG8_BAR;
    } else {
        PG8_STAGE(PG8_SB(0, 0), cB, voffB); PG8_STAGE(PG8_SA(0, 0), cA, voffA); PG8_STAGE(PG8_SB(0, 1), cB + hstep, voffB); PG8_STAGE(PG8_SA(0, 1), cA + hstep, voffA);
        if (wr == 1) PG8_BAR;
        PG8_WAIT_V(4); PG8_BAR;
        PG8_STAGE(PG8_SB(1, 0), cB + kstep, voffB); PG8_STAGE(PG8_SA(1, 0), cA + kstep, voffA); PG8_STAGE(PG8_SB(1, 1), cB + hstep + kstep, voffB);
        PG8_WAIT_V(6); PG8_BAR;
    }
    for (;;) {
        const bool has_next = S.next(ui + 1, nxt);
        const char* nA = has_next ? (const char*)g.A + (size_t)nxt.pm * tstep : cA; const char* nB = has_next ? (const char*)g.Bt + (size_t)nxt.pn * tstep : cB;
        for (int t = 0; t < nt; t += 2) {
            const bool last = (t == nt - 2);
            const char* a1 = cA + (size_t)(t + 1) * kstep;
            const char* a2 = last ? nA : cA + (size_t)(t + 2) * kstep; const char* b2 = last ? nB : cB + (size_t)(t + 2) * kstep;
            const char* a3 = a2 + kstep; const char* b3 = b2 + kstep;
            if (last && has_next) S.a_ready(nxt);
            if constexpr (SP2) {
            PG8_LDB(B0, 0, 0); PG8_LDB(B1, 0, 1); PG8_SCHED; PG8_LDA(At, 0, 0); PG8_STAGE(PG8_SA(1, 1), a1 + hstep, voffA);
            PG8_WAIT_V(8); PG8_WAIT_L(0); PG8_BAR; PG8_MMA(0, 0, At, B0); PG8_MMA(0, 1, At, B1); PG8_BAR; PG8_SCHED;
            PG8_LDA(At, 0, 1); PG8_STAGE(PG8_SB(0, 0), b2, voffB); PG8_STAGE(PG8_SB(0, 1), b2 + hstep, voffB); PG8_STAGE(PG8_SA(0, 0), a2, voffA);
            PG8_WAIT_V(8); PG8_WAIT_L(0); PG8_BAR; PG8_MMA(1, 0, At, B0); PG8_MMA(1, 1, At, B1); PG8_BAR; PG8_SCHED;
            PG8_LDB(B0, 1, 0); PG8_LDB(B1, 1, 1); PG8_SCHED; PG8_LDA(At, 1, 0); PG8_STAGE(PG8_SA(0, 1), a2 + hstep, voffA);
            PG8_WAIT_V(8); PG8_WAIT_L(0); PG8_BAR; PG8_MMA(0, 0, At, B0); PG8_MMA(0, 1, At, B1); PG8_BAR; PG8_SCHED;
            PG8_LDA(At, 1, 1); PG8_STAGE(PG8_SB(1, 0), b3, voffB); PG8_STAGE(PG8_SB(1, 1), b3 + hstep, voffB); PG8_STAGE(PG8_SA(1, 0), a3, voffA);
            PG8_WAIT_V(8); PG8_WAIT_L(0); PG8_BAR; PG8_MMA(1, 0, At, B0); PG8_MMA(1, 1, At, B1); PG8_BAR; PG8_SCHED;
            } else {
            PG8_LDB(B0, 0, 0); PG8_SCHED; PG8_LDA(At, 0, 0); PG8_STAGE(PG8_SA(1, 1), a1 + hstep, voffA);
            PG8_WAIT_L(8); PG8_BAR; PG8_WAIT_L(0); PG8_MMA(0, 0, At, B0); PG8_BAR; PG8_SCHED;
            PG8_LDB(B1, 0, 1); PG8_STAGE(PG8_SB(0, 0), b2, voffB);
            PG8_BAR; PG8_WAIT_L(0); PG8_MMA(0, 1, At, B1); PG8_BAR;
            PG8_LDA(At, 0, 1); PG8_STAGE(PG8_SA(0, 0), a2, voffA);
            PG8_BAR; PG8_WAIT_L(0); PG8_MMA(1, 0, At, B0); PG8_BAR; PG8_SCHED;
            PG8_STAGE(PG8_SB(0, 1), b2 + hstep, voffB);
            PG8_WAIT_V(6); PG8_BAR; PG8_MMA(1, 1, At, B1); PG8_BAR;
            PG8_LDB(B0, 1, 0); PG8_SCHED; PG8_LDA(At, 1, 0); PG8_STAGE(PG8_SA(0, 1), a2 + hstep, voffA);
            PG8_WAIT_L(8); PG8_BAR; PG8_WAIT_L(0); PG8_MMA(0, 0, At, B0); PG8_BAR; PG8_SCHED;
            PG8_LDB(B1, 1, 1); PG8_STAGE(PG8_SB(1, 0), b3, voffB);
            PG8_BAR; PG8_WAIT_L(0); PG8_MMA(0, 1, At, B1); PG8_BAR;
            PG8_LDA(At, 1, 1); PG8_STAGE(PG8_SA(1, 0), a3, voffA);
            PG8_BAR; PG8_WAIT_L(0); PG8_MMA(1, 0, At, B0); PG8_BAR; PG8_SCHED;
            PG8_STAGE(PG8_SB(1, 1), b3 + hstep, voffB);
            PG8_WAIT_V(6); PG8_BAR; PG8_MMA(1, 1, At, B1); PG8_BAR;
            }
        }
        if constexpr (ALIGN_EPI) { if (wr == 0) PG8_BAR; }
        if constexpr (!Epi::AFTER_DRAIN) { E(acc, cur, wr, wc, fr, fq); S.done(cur); }
        if (!has_next) break;
#pragma unroll
        for (int a = 0; a < 2; ++a)
#pragma unroll
            for (int b = 0; b < 2; ++b)
#pragma unroll
                for (int m = 0; m < 4; ++m)
#pragma unroll
                    for (int n = 0; n < 2; ++n) acc[a][b][m][n] = (f32x4){0.f, 0.f, 0.f, 0.f};
        cur = nxt; cA = nA; cB = nB; ++ui;
        if constexpr (ALIGN_EPI) { if (wr == 1) PG8_BAR; }
    }
    PG8_WAIT_V(0);
    if constexpr (!ALIGN_EPI) { if (wr == 0) PG8_BAR; }
    PG8_BAR;
    if constexpr (Epi::AFTER_DRAIN) { E.fused(acc, cur, wr, wc, fr, fq, lds, wid, lane); S.done(cur); }
#undef PG8_SA
#undef PG8_SB
#undef PG8_STAGE
#undef PG8_LDA
#undef PG8_LDB
#undef PG8_MMA
#undef PG8_WAIT_V
#undef PG8_WAIT_L
#undef PG8_BAR
#undef PG8_SCHED
}
}
constexpr int D_MODEL = 1024, BATCH = 4, SEQ = 8192, NTOK = BATCH * SEQ;
constexpr int D_PROJ = 5408, D_FF = 4096, NP_PAD = 5632;
constexpr int NWAVES = 8;
constexpr size_t MiB = 1u << 20;
constexpr size_t WS_CTL = 0, CTL_ZERO_BYTES = 1 * MiB;
constexpr size_t CTL_ROWSS = 512 * 1024;
constexpr size_t WS_WIN = 2 * MiB, WS_WA = 13 * MiB, WS_WB = 14 * MiB, WS_WO = 15 * MiB, WS_W1 = 17 * MiB, WS_W2 = 25 * MiB, WS_CK1 = 33 * MiB, WS_CV1 = 34 * MiB;
constexpr size_t WS_SMALL = 35 * MiB;
constexpr size_t WS_KSN = 40 * MiB, WS_KWN = 48 * MiB, WS_VST = 56 * MiB, WS_VWT = 64 * MiB, WS_KCN = 72 * MiB, WS_VCT = 73 * MiB;
constexpr size_t WS_GT = 76 * MiB;
constexpr size_t WS_RD = 79 * MiB + 512 * 1024;
constexpr size_t CTL_QCTR = 4096;
constexpr size_t CTL_BAR = 16384;
constexpr int XB_LDS_OFF = 147392;
constexpr size_t WS_XN = 36 * MiB;
constexpr size_t WS_QN = 100 * MiB, WS_KV = 132 * MiB, WS_ML = 180 * MiB, WS_G = 308 * MiB, WS_S = 436 * MiB;
constexpr size_t WS_YA = 440 * MiB, WS_YB = 472 * MiB;
constexpr size_t WS_MX = 180 * MiB;
constexpr size_t WS_U = 180 * MiB;
constexpr size_t WS_END = 504 * MiB;
constexpr int RING_BYTES = 131072, MISC_OFF = RING_BYTES + 320, LDS_BYTES = 147456;

#define GAS __attribute__((address_space(1)))
#define LAS __attribute__((address_space(3)))
typedef unsigned short bf16;
typedef unsigned v4u __attribute__((ext_vector_type(4)));
typedef float f32x4 __attribute__((ext_vector_type(4)));
#define LDS_WAIT() asm volatile("s_waitcnt lgkmcnt(0)" ::: "memory")
#define VM_WAIT() asm volatile("s_waitcnt vmcnt(0)" ::: "memory")
__device__ __forceinline__ unsigned f2bf(float f) { unsigned u = __builtin_bit_cast(unsigned, f); return (u + 0x7fffu + ((u >> 16) & 1u)) >> 16; }
__device__ __forceinline__ float bf2f(bf16 v) { return __uint_as_float((unsigned)v << 16); }
__device__ __forceinline__ unsigned pk2(float lo, float hi) { return f2bf(lo) | (f2bf(hi) << 16); }
__device__ __forceinline__ float wave_sum(float v) {
#pragma unroll
    for (int o = 1; o < 64; o <<= 1) v += __shfl_xor(v, o);
    return v;
}
__device__ __forceinline__ float wave_max(float v) {
#pragma unroll
    for (int o = 1; o < 64; o <<= 1) v = fmaxf(v, __shfl_xor(v, o));
    return v;
}

__device__ __forceinline__ int proj_src_col(int n) {
    if (n < 1280) return n;
    if (n < 3328) { const int q = (n - 1280) >> 9, r = (n - 1280) & 511; return (q == 0 ? 1304 : q == 1 ? 1816 : q == 2 ? 2328 : 2848) + r; }
    if (n < 5376) return 3360 + (n - 3328);
    if (n < 5400) return 1280 + (n - 5376);
    if (n < 5404) return 2840 + (n - 5400);
    if (n < 5408) return 2844 + (n - 5404);
    return -1;
}
template <bool MAP>
__device__ __forceinline__ void transpose_item(const float* W, int K, int ldw, const float* kscale, bf16* WT, int Nout, LAS float* scr, int item, int lane) {
    const int nblk = Nout / 32, kb = item / nblk, nb = item % nblk, k0 = 64 * kb, n0 = 32 * nb;
    const int n4 = (lane & 7) * 4;
    const int sc = MAP ? proj_src_col(n0 + n4) : (n0 + n4);
#pragma unroll
    for (int i = 0; i < 8; ++i) {
        const int kk = 8 * i + (lane >> 3);
        f32x4 v = {0.f, 0.f, 0.f, 0.f};
        if (sc >= 0) v = *(const GAS f32x4*)(W + (size_t)(k0 + kk) * ldw + sc);
        if (kscale) { const float g = kscale[k0 + kk]; v = v * g; }
        scr[kk * 33 + n4] = v.x; scr[kk * 33 + n4 + 1] = v.y; scr[kk * 33 + n4 + 2] = v.z; scr[kk * 33 + n4 + 3] = v.w;
    }
    LDS_WAIT(); asm volatile("" ::: "memory");
    const int c = lane & 7;
#pragma unroll
    for (int j = 0; j < 4; ++j) { const int n = (lane >> 3) + 8 * j; const LAS float* s = scr + (8 * c) * 33 + n;
        v4u o; o.x = pk2(s[0 * 33], s[1 * 33]); o.y = pk2(s[2 * 33], s[3 * 33]); o.z = pk2(s[4 * 33], s[5 * 33]); o.w = pk2(s[6 * 33], s[7 * 33]);
        *(GAS v4u*)(WT + (size_t)(n0 + n) * K + k0 + 8 * c) = o; }
    LDS_WAIT(); asm volatile("" ::: "memory");
}
__device__ __forceinline__ void rms_row_to_bf16(const float* xrow, bf16* orow, int lane) {
    const GAS f32x4* xr = (const GAS f32x4*)xrow + lane;
    f32x4 v[4]; float s = 0.f;
#pragma unroll
    for (int j = 0; j < 4; ++j) { v[j] = xr[64 * j]; s += (v[j].x * v[j].x + v[j].y * v[j].y) + (v[j].z * v[j].z + v[j].w * v[j].w); }
    const float rstd = 1.f / sqrtf(wave_sum(s) * (1.f / D_MODEL) + 1e-6f);
    GAS unsigned long long* o8 = (GAS unsigned long long*)orow + lane;
#pragma unroll
    for (int j = 0; j < 4; ++j) o8[64 * j] = (unsigned long long)pk2(v[j].x * rstd, v[j].y * rstd) | ((unsigned long long)pk2(v[j].z * rstd, v[j].w * rstd) << 32);
}

#define XB_TMO      128
#define XB_XCNT(j)  (256  + 64 * (j))
#define XB_XSUB(j)  (1280 + 64 * (j))
#define XB_XGEN(j)  (2304 + 64 * (j))
#define XB_TOP      3328
#define XB_TOPGEN   3392
#define XCD_BAR_WORDS 3456
#define XB_SPIN_CAP (1u << 18)

__device__ __forceinline__ unsigned xb_ld(unsigned* p)              { return __hip_atomic_load(p, __ATOMIC_RELAXED, __HIP_MEMORY_SCOPE_AGENT); }
__device__ __forceinline__ unsigned xb_add(unsigned* p, unsigned v) { return __hip_atomic_fetch_add(p, v, __ATOMIC_RELAXED, __HIP_MEMORY_SCOPE_AGENT); }
__device__ __forceinline__ unsigned xb_xcc_id() { return (unsigned)__builtin_amdgcn_s_getreg((3 << 11) | 20) & 0xFu; }
#define XB_SPIN(cond, bar) do { unsigned _sp = 0; while (cond) { __builtin_amdgcn_s_sleep(1); \
    if ((++_sp & 255u) == 0u) { if (xb_ld(&(bar)[XB_TMO])) break; if (_sp > XB_SPIN_CAP) { atomicAdd(&(bar)[XB_TMO], 1u); break; } } } } while (0)

struct XcdBarrier {
    unsigned* bar; unsigned x;
    volatile LAS unsigned* st;
};

__device__ __forceinline__ XcdBarrier xcd_barrier_post(unsigned* bar, volatile LAS unsigned* st) {
    XcdBarrier b; b.bar = bar; b.x = xb_xcc_id(); b.st = st;
    if (threadIdx.x == 0) (void)xb_add(&bar[XB_XCNT(b.x)], 1u);
    return b;
}
__device__ __forceinline__ void xcd_barrier_complete(unsigned* bar, unsigned x, unsigned& nloc, unsigned& nx) {
    const unsigned G = gridDim.x * gridDim.y * gridDim.z;
    unsigned sum, cnt, mine, sp = 0u;
    for (;;) {
        sum = 0u; cnt = 0u; mine = 0u;
#pragma unroll
        for (unsigned j = 0; j < 16; ++j) { const unsigned c = xb_ld(&bar[XB_XCNT(j)]); sum += c; cnt += (c > 0u) ? 1u : 0u; mine = (j == x) ? c : mine; }
        if (sum == G) break;
        __builtin_amdgcn_s_sleep(1);
        if ((++sp & 255u) == 0u) { if (xb_ld(&bar[XB_TMO])) break; if (sp > XB_SPIN_CAP) { atomicAdd(&bar[XB_TMO], 1u); break; } }
    }
    nloc = mine > 0u ? mine : 1u; nx = cnt > 0u ? cnt : 1u;
}

__device__ __forceinline__ void xcd_barrier(const XcdBarrier& b) {
    asm volatile("s_waitcnt vmcnt(0)" ::: "memory");
    __syncthreads();
    if (threadIdx.x == 0) {
        unsigned* bar = b.bar;
        __builtin_amdgcn_s_waitcnt(0);
        unsigned nloc = b.st[0], nx = b.st[1];
        if (nloc == 0u) { xcd_barrier_complete(bar, b.x, nloc, nx); b.st[0] = nloc; b.st[1] = nx; }
        const unsigned old = xb_add(&bar[XB_XSUB(b.x)], 1u);
        const unsigned gen = old / nloc;
        if (old + 1u == (gen + 1u) * nloc) {
            __builtin_amdgcn_fence(__ATOMIC_RELEASE, "agent");
            asm volatile("s_waitcnt vmcnt(0)" ::: "memory");
            const unsigned og = xb_add(&bar[XB_TOP], 1u);
            const unsigned tg = og / nx;
            if (og + 1u == (tg + 1u) * nx) xb_add(&bar[XB_TOPGEN], 1u);
            else XB_SPIN(xb_ld(&bar[XB_TOPGEN]) == tg, bar);
            __builtin_amdgcn_fence(__ATOMIC_ACQUIRE, "agent");
            xb_add(&bar[XB_XGEN(b.x)], 1u);
            asm volatile("s_waitcnt vmcnt(0)" ::: "memory");
        } else {
            XB_SPIN(xb_ld(&bar[XB_XGEN(b.x)]) == gen, bar);
            __builtin_amdgcn_fence(__ATOMIC_ACQUIRE, "agent");
            asm volatile("s_waitcnt vmcnt(0)" ::: "memory");
        }
    }
    __syncthreads();
}
typedef short bf16x8 __attribute__((ext_vector_type(8)));
typedef float f32x16 __attribute__((ext_vector_type(16)));
typedef unsigned u32x4 __attribute__((ext_vector_type(4)));
typedef unsigned u32x2 __attribute__((ext_vector_type(2)));
constexpr float LOG2E = 1.4426950408889634f;
__device__ const unsigned char BUCKET_TAB2[129] = {0, 1, 2, 3, 4, 5, 6, 7, 8, 9, 10, 11, 12, 13, 14, 15, 16, 16, 16, 17, 17, 18, 18, 18, 19, 19, 19, 20, 20, 20, 20, 21, 21, 21, 21, 22, 22, 22, 22, 22, 23, 23, 23, 23, 23, 23, 24, 24, 24, 24, 24, 24, 25, 25, 25, 25, 25, 25, 25, 26, 26, 26, 26, 26, 26, 26, 26, 27, 27, 27, 27, 27, 27, 27, 27, 27, 27, 28, 28, 28, 28, 28, 28, 28, 28, 28, 28, 29, 29, 29, 29, 29, 29, 29, 29, 29, 29, 29, 29, 30, 30, 30, 30, 30, 30, 30, 30, 30, 30, 30, 30, 30, 30, 31, 31, 31, 31, 31, 31, 31, 31, 31, 31, 31, 31, 31, 31, 31, 31};
__device__ __forceinline__ unsigned cvtpk(float lo, float hi) { typedef float f2 __attribute__((ext_vector_type(2))); typedef __bf16 b2 __attribute__((ext_vector_type(2))); f2 v = {lo, hi}; b2 b = __builtin_convertvector(v, b2); return __builtin_bit_cast(unsigned, b); }
__device__ __forceinline__ float bflo(unsigned w) { return __uint_as_float(w << 16); }
__device__ __forceinline__ float bfhi(unsigned w) { return __uint_as_float(w & 0xffff0000u); }
__device__ __forceinline__ int key_off16(int pp) { return (pp & 3) + 8 * ((pp >> 2) & 1) + 4 * (pp >> 3); }
__device__ __forceinline__ int crow(int r, int hi) { return (r & 3) + 8 * (r >> 2) + 4 * hi; }

__device__ __forceinline__ void knorm_item(const bf16* KV, int col0, const float* gain, bf16* dst, size_t tok0, int lane) {
    const int ch = lane & 7;
    float gn[8];
#pragma unroll
    for (int i = 0; i < 8; ++i) gn[i] = gain[8 * ch + i];
#pragma unroll
    for (int it = 0; it < 8; ++it) {
        const int r = 8 * it + (lane >> 3);
        const u32x4 v = *(const u32x4*)(KV + (tok0 + r) * 768 + col0 + 8 * ch);
        float f[8] = {bflo(v.x), bfhi(v.x), bflo(v.y), bfhi(v.y), bflo(v.z), bfhi(v.z), bflo(v.w), bfhi(v.w)};
        float ss = 0.f;
#pragma unroll
        for (int i = 0; i < 8; ++i) ss += f[i] * f[i];
        ss += __shfl_xor(ss, 1); ss += __shfl_xor(ss, 2); ss += __shfl_xor(ss, 4);
        const float rs = 1.f / sqrtf(ss * (1.f / 64.f) + 1e-6f);
        u32x4 o; o.x = cvtpk(f[0] * rs * gn[0], f[1] * rs * gn[1]); o.y = cvtpk(f[2] * rs * gn[2], f[3] * rs * gn[3]); o.z = cvtpk(f[4] * rs * gn[4], f[5] * rs * gn[5]); o.w = cvtpk(f[6] * rs * gn[6], f[7] * rs * gn[7]);
        *(u32x4*)(dst + (size_t)r * 64 + 8 * ch) = o;
    }
}
__device__ __forceinline__ void vtrans_item(const bf16* KV, int col0, bf16* dst, size_t tok0, LAS unsigned short* scr, int lane) {
#pragma unroll
    for (int it = 0; it < 8; ++it) {
        const int r = 8 * it + (lane >> 3), ch = lane & 7;
        const u32x4 v = *(const u32x4*)(KV + (tok0 + r) * 768 + col0 + 8 * ch);
        *(LAS u32x4*)(scr + r * 72 + 8 * ch) = v;
    }
    LDS_WAIT(); asm volatile("" ::: "memory");
    const int d = lane;
#pragma unroll
    for (int oc = 0; oc < 8; ++oc) {
        unsigned w[4];
#pragma unroll
        for (int k2 = 0; k2 < 4; ++k2) {
            const int p0 = 8 * oc + 2 * k2, p1 = p0 + 1;
            const int key0 = 16 * (p0 >> 4) + key_off16(p0 & 15), key1 = 16 * (p1 >> 4) + key_off16(p1 & 15);
            w[k2] = (unsigned)scr[key0 * 72 + d] | ((unsigned)scr[key1 * 72 + d] << 16);
        }
        u32x4 o; o.x = w[0]; o.y = w[1]; o.z = w[2]; o.w = w[3];
        *(u32x4*)(dst + (size_t)d * 64 + 8 * oc) = o;
    }
    LDS_WAIT(); asm volatile("" ::: "memory");
}
__device__ __forceinline__ void compress_unit(int unit, const bf16* KV, const bf16* W1T, const bf16* W2T, const float* b1p, const float* b2, const float* kgain0,
                                              bf16* KCN, bf16* VCT, LAS unsigned char* lds, int tid) {
    const int kv = unit & 1, tl = (unit >> 1) & 7, bg = unit >> 4, b = bg >> 1, g = bg & 1;
    const int lane = tid & 63, w = __builtin_amdgcn_readfirstlane(tid >> 6), r32 = lane & 31, hi = lane >> 5;
    const int colbase = (kv ? 128 : 0) + 64 * g;
    LAS unsigned short* hid = (LAS unsigned short*)lds;
    LAS float* outl = (LAS float*)(lds + 64 * 264 * 2);
    f32x16 acc[2]; acc[0] = f32x16{}; acc[1] = f32x16{};
    const bf16* brow = W1T + (size_t)(32 * w + r32) * 2048 + 8 * hi;
    LAS unsigned char* strip = lds + 51200;
    const bf16* kvb = KV + ((size_t)b * SEQ) * 768 + colbase;
#pragma unroll 1
    for (int rt = 0; rt < 2; ++rt) {
        const int T0 = 16 * (64 * tl + 32 * rt);
        for (int pi = tid; pi < 528 * 8; pi += 512) {
            const int tk = pi >> 3, ch = pi & 7; int tok = T0 + tk; tok = tok > SEQ - 1 ? SEQ - 1 : tok;
            *(LAS u32x4*)(strip + tk * 128 + ((ch ^ ((tk >> 4) & 7)) << 4)) = *(const u32x4*)(kvb + (size_t)tok * 768 + 8 * ch);
        }
        __syncthreads();
        f32x16 a = f32x16{};
#pragma unroll 8
        for (int s = 0; s < 128; ++s) {
            const int jj = s >> 2, ch = 2 * (s & 3) + hi, tk = 16 * r32 + jj;
            const bf16x8 bf = *(const bf16x8*)(brow + 16 * s);
            const bf16x8 af = *(const LAS bf16x8*)(strip + tk * 128 + ((ch ^ ((tk >> 4) & 7)) << 4));
            a = __builtin_amdgcn_mfma_f32_32x32x16_bf16(af, bf, a, 0, 0, 0);
        }
        if (rt == 0) acc[0] = a; else acc[1] = a;
        __syncthreads();
    }
    {
        const int col = 32 * w + r32; const float bb = b1p[col];
#pragma unroll
        for (int rt = 0; rt < 2; ++rt)
#pragma unroll
            for (int r = 0; r < 16; ++r) {
                const float x = acc[rt][r] + bb;
                const float u = 0.7978845608028654f * (x + 0.044715f * x * x * x);
                const float e = __builtin_amdgcn_exp2f(2.f * LOG2E * u);
                const float th = 1.f - 2.f * __builtin_amdgcn_rcpf(e + 1.f);
                hid[(32 * rt + crow(r, hi)) * 264 + col] = (unsigned short)(cvtpk(0.5f * x * (1.f + th), 0.f) & 0xffffu);
            }
    }
    __syncthreads();
    if (w < 4) {
        const int rt = w >> 1, ct = w & 1;
        f32x16 o = f32x16{};
        const bf16* b2row = W2T + (size_t)(32 * ct + r32) * 256 + 8 * hi;
#pragma unroll
        for (int s = 0; s < 16; ++s) {
            const bf16x8 af = *(const LAS bf16x8*)(hid + (32 * rt + r32) * 264 + 16 * s + 8 * hi);
            const bf16x8 bf = *(const bf16x8*)(b2row + 16 * s);
            o = __builtin_amdgcn_mfma_f32_32x32x16_bf16(af, bf, o, 0, 0, 0);
        }
        const float bb = b2[32 * ct + r32];
#pragma unroll
        for (int r = 0; r < 16; ++r) outl[(32 * rt + crow(r, hi)) * 65 + 32 * ct + r32] = o[r] + bb;
    }
    __syncthreads();
#pragma unroll
    for (int k = 0; k < 8; ++k) {
        const int r = 8 * w + k, n = 64 * tl + r;
        float v = outl[r * 65 + lane];
        if (kv == 0) {
            const float ss = wave_sum(v * v);
            v = v * (1.f / sqrtf(ss * (1.f / 64.f) + 1e-6f)) * kgain0[lane];
            if (n >= 511) v = 0.f;
            KCN[((size_t)bg * 512 + n) * 64 + lane] = (bf16)f2bf(v);
        } else {
            if (n >= 511) v = 0.f;
            const int pos = 16 * (r >> 4) + key_off16(r & 15);
            VCT[(((size_t)bg * 8 + tl) * 64 + lane) * 64 + pos] = (bf16)f2bf(v);
        }
    }
    __syncthreads();
}

constexpr int ENG_BUF = 0;
constexpr int ENG_LUT = 32768;
constexpr int LUTN = 704;
constexpr int ENG_IMP = ENG_LUT + 4 * LUTN * 4;
constexpr int ENG_SELM = ENG_IMP + 64 * 128 * 4;
constexpr int ENG_UNION = ENG_SELM + 64 * 4 * 4;
constexpr int ENG_TLIST = ENG_UNION + 16;
constexpr int ENG_MISC = ENG_TLIST + 132 * 4;
constexpr int ENG_RING2 = ENG_MISC + 16;
constexpr int ENG_END = ENG_RING2 + 4 * 16384;

struct EngPtrs { const bf16 *QN, *KCN, *VCT, *KSN, *VST, *KWN, *VWT; const float* SB; const float* rel; const float* qgain; const float* bounds; bf16* YA; };

__device__ __forceinline__ int swz7(int row) { return ((row >> 1) ^ ((row >> 4) & 1)) & 7; }
__device__ __forceinline__ int tile_off(int row, int ch) { return row * 128 + ((ch ^ swz7(row)) << 4); }

template <int BR>
__device__ __forceinline__ void eng_branch(LAS unsigned char* lds, const bf16* Kg, const bf16* Vg, int nt, int c, int tid, int lane, int hq, int qloc,
                                           const bf16x8 (&qr)[4], float& lsum, float inv_l, f32x16 (&o)[2]) {
    const int r32 = lane & 31, hi = lane >> 5;
    const LAS float* lut = (const LAS float*)(lds + ENG_LUT) + hq * LUTN;
    LAS float* imp = (LAS float*)(lds + ENG_IMP);
    unsigned sm0 = 0u, sm1 = 0u, sm2 = 0u, sm3 = 0u;
    if (BR == 2) { const LAS unsigned* selm = (const LAS unsigned*)(lds + ENG_SELM) + qloc * 4; sm0 = selm[0]; sm1 = selm[1]; sm2 = selm[2]; sm3 = selm[3]; }
    auto tile_id = [&](int k) -> int { return BR <= 2 ? k : (c - 8 + k < 0 ? 0 : c - 8 + k); };
    const int kofs = (BR == 3) ? (c < 8 ? 8 - c : 0) : 0;
    constexpr int NST = (BR <= 1) ? 6 : 8;
    const int wv = __builtin_amdgcn_readfirstlane(tid >> 6);
    const unsigned vot = (unsigned)((((lane >> 3)) * 64 + (((lane & 7) ^ swz7(8 * wv + (lane >> 3))) << 3)) * 2) + (unsigned)wv * 1024u;
    auto stage_off = [&](int sidx) -> int {
        if (sidx < 2) return ENG_BUF + sidx * 16384;
        if (BR <= 1) return ENG_RING2 + (sidx - 2) * 16384;
        return sidx < 4 ? ENG_IMP + (sidx - 2) * 16384 : ENG_RING2 + (sidx - 4) * 16384; };
#define ENG_DMA(src, dstoff) __builtin_amdgcn_global_load_lds((const unsigned*)(src), (LAS unsigned*)(lds + (dstoff)), 16, 0, 0)
#define ENG_ISSUE(kk) do { int kq_ = (kk) < nt ? (kk) : nt - 1; const int jq_ = tile_id(kq_ + kofs); const int so_ = stage_off((kk) % NST) + wv * 1024; \
        ENG_DMA((const char*)Kg + (size_t)jq_ * 8192 + vot, so_); if (BR != 0) ENG_DMA((const char*)Vg + (size_t)jq_ * 8192 + vot, so_ + 8192); } while (0)
#define ENG_WAIT(n) asm volatile("s_waitcnt vmcnt(%0)" :: "n"(n) : "memory")
    constexpr int DPT = (BR == 0) ? 1 : 2;
    unsigned koff[4];
#pragma unroll
    for (int s = 0; s < 4; ++s) koff[s] = (unsigned)tile_off(r32, 2 * s + hi);
    auto frag8 = [&](unsigned base, bf16x8 (&f)[8]) {
        const unsigned a0 = base + koff[0], a1 = base + koff[1], a2 = base + koff[2], a3 = base + koff[3];
        asm volatile("ds_read_b128 %0, %8\n\tds_read_b128 %1, %8 offset:4096\n\tds_read_b128 %2, %9\n\tds_read_b128 %3, %9 offset:4096\n\t"
                     "ds_read_b128 %4, %10\n\tds_read_b128 %5, %10 offset:4096\n\tds_read_b128 %6, %11\n\tds_read_b128 %7, %11 offset:4096\n\ts_waitcnt lgkmcnt(0)"
                     : "=&v"(f[0]), "=&v"(f[1]), "=&v"(f[2]), "=&v"(f[3]), "=&v"(f[4]), "=&v"(f[5]), "=&v"(f[6]), "=&v"(f[7])
                     : "v"(a0), "v"(a1), "v"(a2), "v"(a3) : "memory");
    };
    auto qk_mfma = [&](int so, int j, f32x16& p0, f32x16& p1) {
        bf16x8 kf[8];
        frag8((unsigned)so, kf);
        p0 = __builtin_amdgcn_mfma_f32_32x32x16_bf16(kf[0], qr[0], f32x16{}, 0, 0, 0);
        p1 = __builtin_amdgcn_mfma_f32_32x32x16_bf16(kf[1], qr[0], f32x16{}, 0, 0, 0);
#pragma unroll
        for (int s = 1; s < 4; ++s) {
            p0 = __builtin_amdgcn_mfma_f32_32x32x16_bf16(kf[2 * s], qr[s], p0, 0, 0, 0);
            p1 = __builtin_amdgcn_mfma_f32_32x32x16_bf16(kf[2 * s + 1], qr[s], p1, 0, 0, 0);
        }
    };
    auto qk_fix = [&](int j, f32x16& p0, f32x16& p1) {
        bool near_;
        if (BR <= 1) { const int dmin = 64 * c - 16 * (64 * j + 63) - 31; near_ = dmin < 128; }
        else if (BR == 2) near_ = (j >= c - 2);
        else near_ = (j >= c - 2) || (j == c - 8);
        if (near_) {
            if (BR <= 1) {
                const int dbase = 64 * c + qloc - 16 * (64 * j + 4 * hi) - 31;
#pragma unroll
                for (int r = 0; r < 16; ++r) {
                    const int cr0 = (r & 3) + 8 * (r >> 2);
                    const int d0 = dbase - 16 * cr0, d1 = dbase - 16 * (32 + cr0);
                    int i0 = (d0 > 128 ? 128 : d0) + 64, i1 = (d1 > 128 ? 128 : d1) + 64;
                    i0 = i0 < 0 ? 0 : i0; i1 = i1 < 0 ? 0 : i1;
                    float b0 = lut[i0], b1 = lut[i1];
                    asm volatile("" : "+v"(b0), "+v"(b1));
                    p0[r] += b0; p1[r] += b1;
                }
            } else {
                const LAS float* pb = lut + (64 * (c - j) + qloc - 4 * hi + 64 - 59);
#pragma unroll
                for (int r = 0; r < 16; ++r) { const int cr0 = (r & 3) + 8 * (r >> 2); p0[r] += pb[59 - cr0]; p1[r] += pb[59 - 32 - cr0]; }
            }
        }
    };
#pragma unroll
    for (int i = 0; i < NST - 1; ++i) ENG_ISSUE(i);
    f32x16 pA0, pA1, pB0, pB1;
    {
        ENG_WAIT((NST - 2) * DPT);
        __builtin_amdgcn_s_barrier(); asm volatile("" ::: "memory");
        const int j0 = tile_id(kofs);
        qk_mfma(stage_off(0), j0, pA0, pA1); qk_fix(j0, pA0, pA1);
    }
#define ENG_STEP(k, pc0, pc1, pn0, pn1) do { \
        const int j = tile_id((k) + kofs); \
          \
        unsigned selbit_ = 1u; bool dc_ = true; \
        if (BR == 2) { selbit_ = sm0 & 1u; dc_ = __builtin_amdgcn_ballot_w64(selbit_ != 0u) != 0ull; } \
          \
        ENG_WAIT((NST - 3) * DPT); \
        __builtin_amdgcn_s_barrier(); asm volatile("" ::: "memory"); \
        ENG_ISSUE((k) + NST - 1); \
        eng_step_body(k, j, pc0, pc1, pn0, pn1, dc_, selbit_); \
        if (BR == 2) { sm0 = (sm0 >> 1) | (sm1 << 31); sm1 = (sm1 >> 1) | (sm2 << 31); sm2 = (sm2 >> 1) | (sm3 << 31); sm3 >>= 1; } } while (0)
    auto eng_step_body = [&](int k, int j, f32x16& pc0, f32x16& pc1, f32x16& pn0, f32x16& pn1, const bool dopv, const unsigned selbit) {
        const int bufo = stage_off(k % NST);
        const int kn = (k + 1 < nt) ? k + 1 : nt - 1;
        const int jn = tile_id(kn + kofs);
        qk_mfma(stage_off((k + 1) % NST), jn, pn0, pn1);
        float ls = 0.f;
        u32x4 pw[4];
        {
#pragma unroll
            for (int r = 0; r < 16; ++r) { pc0[r] = __builtin_amdgcn_exp2f(pc0[r]); pc1[r] = __builtin_amdgcn_exp2f(pc1[r]); ls += pc0[r] + pc1[r]; }
            if (BR == 1) {
#pragma unroll
                for (int r = 0; r < 16; ++r) { pc0[r] *= inv_l; pc1[r] *= inv_l; }
            }
            unsigned selmask = 0xffffffffu;
            if (BR == 2) { selmask = selbit ? 0xffffffffu : 0u; ls = selbit ? ls : 0.f; }
            if (BR != 0) {
#pragma unroll
                for (int s2 = 0; s2 < 2; ++s2) {
                    pw[s2].x = cvtpk(pc0[8 * s2 + 0], pc0[8 * s2 + 1]); pw[s2].y = cvtpk(pc0[8 * s2 + 2], pc0[8 * s2 + 3]); pw[s2].z = cvtpk(pc0[8 * s2 + 4], pc0[8 * s2 + 5]); pw[s2].w = cvtpk(pc0[8 * s2 + 6], pc0[8 * s2 + 7]);
                    pw[2 + s2].x = cvtpk(pc1[8 * s2 + 0], pc1[8 * s2 + 1]); pw[2 + s2].y = cvtpk(pc1[8 * s2 + 2], pc1[8 * s2 + 3]); pw[2 + s2].z = cvtpk(pc1[8 * s2 + 4], pc1[8 * s2 + 5]); pw[2 + s2].w = cvtpk(pc1[8 * s2 + 6], pc1[8 * s2 + 7]);
                }
                if (BR == 2) {
#pragma unroll
                    for (int i = 0; i < 4; ++i) { pw[i].x &= selmask; pw[i].y &= selmask; pw[i].z &= selmask; pw[i].w &= selmask; }
                }
            }
            if (BR != 0) asm volatile("" : "+v"(pw[0]), "+v"(pw[1]), "+v"(pw[2]), "+v"(pw[3]), "+v"(ls)); else asm volatile("" : "+v"(ls));
            if (BR == 1 && c >= 16) {
                const int q = qloc;
#pragma unroll
                for (int a = 0; a < 4; ++a) {
                    float g0 = (pc0[4 * a] + pc0[4 * a + 1]) + (pc0[4 * a + 2] + pc0[4 * a + 3]), s0 = pc0[4 * a + 3];
                    float g1 = (pc1[4 * a] + pc1[4 * a + 1]) + (pc1[4 * a + 2] + pc1[4 * a + 3]), s1 = pc1[4 * a + 3];
                    g0 += __shfl_xor(g0, 1); s0 += __shfl_xor(s0, 1); g1 += __shfl_xor(g1, 1); s1 += __shfl_xor(s1, 1);
                    g0 += __shfl_xor(g0, 2); s0 += __shfl_xor(s0, 2); g1 += __shfl_xor(g1, 2); s1 += __shfl_xor(s1, 2);
                    if (hq == 0) {
                        const int jb0 = 16 * j + 2 * a + hi, jb1 = jb0 + 8;
                        imp[q * 128 + (jb0 ^ (q & 31))] += g0;
                        imp[q * 128 + (jb1 ^ (q & 31))] += g1;
                        asm volatile("" ::: "memory");
                        if (jb0 + 1 < 128) imp[q * 128 + ((jb0 + 1) ^ (q & 31))] += s0;
                        if (jb1 + 1 < 128) imp[q * 128 + ((jb1 + 1) ^ (q & 31))] += s1;
                        asm volatile("" ::: "memory");
                    }
                }
            }
            lsum += ls;
        }
        qk_fix(jn, pn0, pn1);
        if (BR != 0 && (BR != 2 || dopv)) {
            bf16x8 vf[8];
            frag8((unsigned)(bufo + 8192), vf);
#pragma unroll
            for (int ks = 0; ks < 4; ++ks) {
                const bf16x8 pf = __builtin_bit_cast(bf16x8, pw[ks]);
                o[0] = __builtin_amdgcn_mfma_f32_32x32x16_bf16(vf[2 * ks], pf, o[0], 0, 0, 0);
                o[1] = __builtin_amdgcn_mfma_f32_32x32x16_bf16(vf[2 * ks + 1], pf, o[1], 0, 0, 0);
            }
        }
    };
    int k = 0;
    for (; k + 1 < nt; k += 2) { ENG_STEP(k, pA0, pA1, pB0, pB1); ENG_STEP(k + 1, pB0, pB1, pA0, pA1); }
    if (k < nt) ENG_STEP(k, pA0, pA1, pB0, pB1);
#undef ENG_STEP
#undef ENG_WAIT
    asm volatile("s_waitcnt vmcnt(0)" ::: "memory");
    __syncthreads();
#undef ENG_ISSUE
#undef ENG_DMA
}

__device__ __forceinline__ void eng_unit(int unit, const EngPtrs& P, LAS unsigned char* lds, int tid) {
    const int c = 127 - (unit >> 3), bg = unit & 7, b = bg >> 1, g = bg & 1;
    const int lane = tid & 63, w = __builtin_amdgcn_readfirstlane(tid >> 6), r32 = lane & 31, hi = lane >> 5;
    const int hq = r32 & 3, qloc = 8 * w + (r32 >> 2);
    const int head = 4 * g + hq;
    const int t = 64 * c + qloc;
    const size_t row = (size_t)b * SEQ + t;
    LAS float* lutw = (LAS float*)(lds + ENG_LUT);
    LAS float* imp = (LAS float*)(lds + ENG_IMP);
    LAS unsigned* selm = (LAS unsigned*)(lds + ENG_SELM);
    LAS unsigned* uni = (LAS unsigned*)(lds + ENG_UNION);
    LAS int* tlist = (LAS int*)(lds + ENG_TLIST);
    LAS int* misc = (LAS int*)(lds + ENG_MISC);
    for (int i = tid; i < 4 * LUTN; i += 512) {
        const int h4 = i / LUTN, ii = i % LUTN, dist = ii - 64, hd = 4 * g + h4;
        float v;
        if (dist < 0 || dist >= 512) v = -INFINITY;
        else { const int bk = dist >= 128 ? 31 : (int)BUCKET_TAB2[dist]; v = (P.rel[bk * 8 + hd] - P.rel[31 * 8 + hd]) * LOG2E; }
        lutw[i] = v;
    }
    if (c >= 16) for (int i = tid; i < 64 * 128; i += 512) imp[i] = 0.f;
    if (tid < 4) uni[tid] = 0u;
    bf16x8 qr[4];
    {
        const bf16* qp = P.QN + row * 512 + head * 64 + 8 * hi;
        u32x4 raw[4]; float ss = 0.f;
#pragma unroll
        for (int s = 0; s < 4; ++s) { raw[s] = *(const u32x4*)(qp + 16 * s);
            const float f[8] = {bflo(raw[s].x), bfhi(raw[s].x), bflo(raw[s].y), bfhi(raw[s].y), bflo(raw[s].z), bfhi(raw[s].z), bflo(raw[s].w), bfhi(raw[s].w)};
#pragma unroll
            for (int i = 0; i < 8; ++i) ss += f[i] * f[i]; }
        ss += __shfl_xor(ss, 32);
        const float rs = (1.f / sqrtf(ss * (1.f / 64.f) + 1e-6f)) * 0.125f * LOG2E;
#pragma unroll
        for (int s = 0; s < 4; ++s) {
            const float* gp = P.qgain + 16 * s + 8 * hi;
            u32x4 o4;
            o4.x = cvtpk(bflo(raw[s].x) * rs * gp[0], bfhi(raw[s].x) * rs * gp[1]); o4.y = cvtpk(bflo(raw[s].y) * rs * gp[2], bfhi(raw[s].y) * rs * gp[3]);
            o4.z = cvtpk(bflo(raw[s].z) * rs * gp[4], bfhi(raw[s].z) * rs * gp[5]); o4.w = cvtpk(bflo(raw[s].w) * rs * gp[6], bfhi(raw[s].w) * rs * gp[7]);
            qr[s] = __builtin_bit_cast(bf16x8, o4);
        }
    }
    const float* gl = P.SB + row * 32 + head * 3;
    const float gate0 = 1.f / (1.f + __expf(-gl[0])), gate1 = 1.f / (1.f + __expf(-gl[1])), gate2 = 1.f / (1.f + __expf(-gl[2]));
    bf16* const yp = P.YA + row * 512 + head * 64 + 4 * hi;
    __syncthreads();
    {
        const int nvmax = (4 * c + 3 > 511) ? 511 : 4 * c + 3;
        const int ntc = (nvmax + 63) >> 6;
        const bf16* Kg = P.KCN + (size_t)bg * 512 * 64; const bf16* Vg = P.VCT + (size_t)bg * 8 * 4096;
        float l1 = 0.f; f32x16 od[2]; od[0] = f32x16{}; od[1] = f32x16{};
        eng_branch<0>(lds, Kg, Vg, ntc, c, tid, lane, hq, qloc, qr, l1, 0.f, od);
        l1 += __shfl_xor(l1, 32);
        const float inv = l1 > 0.f ? 1.f / l1 : 0.f;
        float l2 = 0.f;
        eng_branch<1>(lds, Kg, Vg, ntc, c, tid, lane, hq, qloc, qr, l2, inv, od);
#pragma unroll
        for (int dh = 0; dh < 2; ++dh)
#pragma unroll
            for (int a = 0; a < 4; ++a) { u32x2 v; v.x = cvtpk(gate0 * od[dh][4 * a], gate0 * od[dh][4 * a + 1]); v.y = cvtpk(gate0 * od[dh][4 * a + 2], gate0 * od[dh][4 * a + 3]); *(u32x2*)(yp + 32 * dh + 8 * a) = v; }
    }
    {
        const int q = tid >> 3, part = tid & 7;
        unsigned m16 = 0u;
        if (c >= 16) {
            unsigned key[16];
#pragma unroll
            for (int jj = 0; jj < 16; ++jj) { const int j = part * 16 + jj; key[jj] = (j >= 1 && j <= c - 2) ? (__float_as_uint(imp[q * 128 + (j ^ (q & 31))]) + 1u) : 0u; }
            unsigned T = 0u;
            for (int bit = 31; bit >= 0; --bit) {
                const unsigned cand = T | (1u << bit);
                int cnt = 0;
#pragma unroll
                for (int jj = 0; jj < 16; ++jj) cnt += key[jj] >= cand ? 1 : 0;
                cnt += __shfl_xor(cnt, 1); cnt += __shfl_xor(cnt, 2); cnt += __shfl_xor(cnt, 4);
                if (cnt >= 13) T = cand;
            }
            int gt = 0, eq = 0;
#pragma unroll
            for (int jj = 0; jj < 16; ++jj) { gt += key[jj] > T ? 1 : 0; eq += key[jj] == T ? 1 : 0; }
            int gtot = gt; gtot += __shfl_xor(gtot, 1); gtot += __shfl_xor(gtot, 2); gtot += __shfl_xor(gtot, 4);
            int pre = 0;
#pragma unroll
            for (int pp = 0; pp < 8; ++pp) { const int e = __shfl(eq, (lane & ~7) + pp); if (pp < part) pre += e; }
            int quota = 13 - gtot - pre; quota = quota < 0 ? 0 : quota;
#pragma unroll
            for (int jj = 0; jj < 16; ++jj) {
                bool s = key[jj] > T;
                if (key[jj] == T && T != 0u) { if (quota > 0) { s = true; --quota; } }
                m16 |= s ? (1u << jj) : 0u;
            }
        }
        unsigned wd = m16 << (16 * (part & 1));
        wd |= __shfl_xor(wd, 1);
        const int wi = part >> 1;
        if (c >= 16) {
            if (wi == 0) wd |= 1u;
            if (((c - 1) >> 5) == wi) wd |= 1u << ((c - 1) & 31);
            if ((c >> 5) == wi) wd |= 1u << (c & 31);
        } else {
            wd = (wi == 0) ? ((c >= 31) ? 0xffffffffu : ((2u << c) - 1u)) : 0u;
        }
        if ((part & 1) == 0) selm[q * 4 + wi] = wd;
    }
    __syncthreads();
    {
        const int nts = c + 1;
        float l = 0.f; f32x16 od[2]; od[0] = f32x16{}; od[1] = f32x16{};
        eng_branch<2>(lds, P.KSN + (size_t)bg * SEQ * 64, P.VST + (size_t)bg * 128 * 4096, nts, c, tid, lane, hq, qloc, qr, l, 0.f, od);
        l += __shfl_xor(l, 32);
        const float sc = gate1 / l;
#pragma unroll
        for (int dh = 0; dh < 2; ++dh)
#pragma unroll
            for (int a = 0; a < 4; ++a) { const u32x2 y = *(const u32x2*)(yp + 32 * dh + 8 * a);
                u32x2 v; v.x = cvtpk(bflo(y.x) + sc * od[dh][4 * a], bfhi(y.x) + sc * od[dh][4 * a + 1]); v.y = cvtpk(bflo(y.y) + sc * od[dh][4 * a + 2], bfhi(y.y) + sc * od[dh][4 * a + 3]); *(u32x2*)(yp + 32 * dh + 8 * a) = v; }
    }
    {
        const int ntw = c < 8 ? c + 1 : 9;
        float l = 0.f; f32x16 od[2]; od[0] = f32x16{}; od[1] = f32x16{};
        eng_branch<3>(lds, P.KWN + (size_t)bg * SEQ * 64, P.VWT + (size_t)bg * 128 * 4096, ntw, c, tid, lane, hq, qloc, qr, l, 0.f, od);
        l += __shfl_xor(l, 32);
        const float sc = gate2 / l;
#pragma unroll
        for (int dh = 0; dh < 2; ++dh)
#pragma unroll
            for (int a = 0; a < 4; ++a) { const u32x2 y = *(const u32x2*)(yp + 32 * dh + 8 * a);
                u32x2 v; v.x = cvtpk(bflo(y.x) + sc * od[dh][4 * a], bfhi(y.x) + sc * od[dh][4 * a + 1]); v.y = cvtpk(bflo(y.y) + sc * od[dh][4 * a + 2], bfhi(y.y) + sc * od[dh][4 * a + 3]); *(u32x2*)(yp + 32 * dh + 8 * a) = v; }
    }
}
__device__ __forceinline__ int pos16(int k) { return 16 * (k >> 4) + key_off16(k & 15); }
__device__ __forceinline__ float fsilu(float a) { return a / (1.f + __expf(-a)); }

constexpr int MLP_ROWB = 272;
constexpr int MLP_QIN = 0, MLP_KIN = 67 * MLP_ROWB, MLP_VIN = 2 * 67 * MLP_ROWB, MLP_QOUT = MLP_VIN + 64 * MLP_ROWB, MLP_KOUT = MLP_QOUT + 64 * MLP_ROWB, MLP_END = MLP_KOUT + 64 * MLP_ROWB;
__device__ __forceinline__ void ml_prep_unit(int unit, const bf16* ML, const float* cw, const float* cb, bf16* QC, bf16* KC, bf16* KT, bf16* VT, LAS unsigned char* lds, int tid) {
    const int bh = unit >> 7, chunk = unit & 127, b = bh >> 2, h = bh & 3;
    const int t0 = 64 * chunk;
    const size_t rowb = (size_t)b * SEQ;
    for (int pi = tid; pi < 67 * 16; pi += 512) {
        const int r = pi >> 4, ch = pi & 15, t = t0 - 3 + r;
        u32x4 qv = {0u, 0u, 0u, 0u}, kv = {0u, 0u, 0u, 0u};
        if (t >= 0) { const bf16* rp = ML + (rowb + t) * 2048 + h * 128 + 8 * ch; qv = *(const u32x4*)rp; kv = *(const u32x4*)(rp + 512); }
        *(LAS u32x4*)(lds + MLP_QIN + r * MLP_ROWB + 16 * ch) = qv; *(LAS u32x4*)(lds + MLP_KIN + r * MLP_ROWB + 16 * ch) = kv;
    }
    for (int pi = tid; pi < 64 * 16; pi += 512) {
        const int r = pi >> 4, ch = pi & 15;
        *(LAS u32x4*)(lds + MLP_VIN + r * MLP_ROWB + 16 * ch) = *(const u32x4*)(ML + (rowb + t0 + r) * 2048 + 1024 + h * 128 + 8 * ch);
    }
    __syncthreads();
    {
        const int ch = tid & 127, seg = tid >> 7;
#pragma unroll
        for (int which = 0; which < 2; ++which) {
            const int gc = which * 512 + h * 128 + ch;
            const float w0 = cw[gc], w1 = cw[1024 + gc], w2 = cw[2048 + gc], w3 = cw[3072 + gc], bias = cb[gc];
            const float sc = which == 0 ? 0.08838834764831845f : 1.f;
            const LAS unsigned short* in = (const LAS unsigned short*)(lds + (which ? MLP_KIN : MLP_QIN)) + ch;
            LAS unsigned short* out = (LAS unsigned short*)(lds + (which ? MLP_KOUT : MLP_QOUT)) + ch;
            float x0 = bf2f(in[(16 * seg + 0) * (MLP_ROWB / 2)]), x1 = bf2f(in[(16 * seg + 1) * (MLP_ROWB / 2)]), x2 = bf2f(in[(16 * seg + 2) * (MLP_ROWB / 2)]);
#pragma unroll
            for (int r = 0; r < 16; ++r) {
                const float x3 = bf2f(in[(16 * seg + r + 3) * (MLP_ROWB / 2)]);
                const float a = bias + x0 * w0 + x1 * w1 + x2 * w2 + x3 * w3;
                out[(16 * seg + r) * (MLP_ROWB / 2)] = (unsigned short)f2bf(fsilu(a) * sc);
                x0 = x1; x1 = x2; x2 = x3;
            }
        }
    }
    __syncthreads();
    const size_t cbase = ((size_t)bh * 128 + chunk) * 8192;
    for (int pi = tid; pi < 1024; pi += 512) {
        {
            const int r = pi >> 4, pc = pi & 15;
            const LAS unsigned short* qo = (const LAS unsigned short*)(lds + MLP_QOUT + r * MLP_ROWB);
            const LAS unsigned short* ko = (const LAS unsigned short*)(lds + MLP_KOUT + r * MLP_ROWB);
            unsigned qw[4], kw[4];
#pragma unroll
            for (int k2 = 0; k2 < 4; ++k2) { const int d0 = pos16(8 * pc + 2 * k2), d1 = pos16(8 * pc + 2 * k2 + 1); qw[k2] = (unsigned)qo[d0] | ((unsigned)qo[d1] << 16); kw[k2] = (unsigned)ko[d0] | ((unsigned)ko[d1] << 16); }
            u32x4 qv; qv.x = qw[0]; qv.y = qw[1]; qv.z = qw[2]; qv.w = qw[3];
            u32x4 kv; kv.x = kw[0]; kv.y = kw[1]; kv.z = kw[2]; kv.w = kw[3];
            *(u32x4*)(QC + cbase + (size_t)r * 128 + 8 * pc) = qv; *(u32x4*)(KC + cbase + (size_t)r * 128 + 8 * pc) = kv;
        }
        {
            const int d = pi >> 3, tc = pi & 7;
            const LAS unsigned short* ko = (const LAS unsigned short*)(lds + MLP_KOUT) + d;
            const LAS unsigned short* vo = (const LAS unsigned short*)(lds + MLP_VIN) + d;
            unsigned kw[4], vw[4];
#pragma unroll
            for (int k2 = 0; k2 < 4; ++k2) { const int r0 = pos16(8 * tc + 2 * k2), r1 = pos16(8 * tc + 2 * k2 + 1);
                kw[k2] = (unsigned)ko[r0 * (MLP_ROWB / 2)] | ((unsigned)ko[r1 * (MLP_ROWB / 2)] << 16); vw[k2] = (unsigned)vo[r0 * (MLP_ROWB / 2)] | ((unsigned)vo[r1 * (MLP_ROWB / 2)] << 16); }
            u32x4 kv; kv.x = kw[0]; kv.y = kw[1]; kv.z = kw[2]; kv.w = kw[3];
            u32x4 vv; vv.x = vw[0]; vv.y = vw[1]; vv.z = vw[2]; vv.w = vw[3];
            *(u32x4*)(KT + cbase + (size_t)d * 64 + 8 * tc) = kv; *(u32x4*)(VT + cbase + (size_t)d * 64 + 8 * tc) = vv;
        }
    }
    __syncthreads();
}
__device__ __forceinline__ void ml_gates_unit(int bh, const float* SB, const float* ibias, const float* fbias, float* GT, LAS unsigned char* lds, int tid) {
    const int b = bh >> 2, h = bh & 3;
    LAS float* gs = (LAS float*)lds; LAS float* am = gs + 128; LAS float* mpv = gs + 256;
    const float fb = fbias[h], ib = ibias[h];
    const int c = tid;
    const float* sp = SB + ((size_t)b * SEQ + 64 * c) * 32;
    float g = 0.f, amax = -INFINITY;
    if (tid < 128) {
        for (int i0 = 0; i0 < 64; i0 += 16) {
            float fv[16], iv[16];
#pragma unroll
            for (int k = 0; k < 16; ++k) { fv[k] = sp[(i0 + k) * 32 + 28 + h]; iv[k] = sp[(i0 + k) * 32 + 24 + h]; }
#pragma unroll
            for (int k = 0; k < 16; ++k) { const float f = fv[k] + fb; const float lf = fminf(f, 0.f) - log1pf(__expf(-fabsf(f))); g += lf; amax = fmaxf(amax, iv[k] + ib - g); }
        }
        gs[c] = g; am[c] = amax;
    }
    __syncthreads();
    if (tid == 0) { float m = 0.f; for (int k = 0; k < 128; ++k) { mpv[k] = m; m = gs[k] + fmaxf(m, am[k]); } }
    __syncthreads();
    if (tid < 128) {
        const float mp = mpv[c], mx = fmaxf(mp, amax);
        float* gt = GT + ((size_t)bh * 128 + c) * 384;
        float bc = 0.f, runmax = -INFINITY;
        for (int i0 = 0; i0 < 64; i0 += 16) {
            float fv[16], iv[16];
#pragma unroll
            for (int k = 0; k < 16; ++k) { fv[k] = sp[(i0 + k) * 32 + 28 + h]; iv[k] = sp[(i0 + k) * 32 + 24 + h]; }
#pragma unroll
            for (int k = 0; k < 16; ++k) {
                const int i = i0 + k;
                const float f = fv[k] + fb; const float lf = fminf(f, 0.f) - log1pf(__expf(-fabsf(f))); bc += lf;
                const float d = iv[k] + ib - bc;
                runmax = fmaxf(runmax, d);
                const float ei = -fmaxf(mp, runmax);
                gt[0 * 64 + i] = ei * LOG2E; gt[1 * 64 + i] = d * LOG2E; gt[2 * 64 + i] = __expf(mp + ei); gt[3 * 64 + i] = __expf(-bc + ei);
                gt[4 * 64 + pos16(i)] = __expf(d - mx);
            }
        }
        gt[5 * 64] = __expf(mp - mx);
    }
    __syncthreads();
}

constexpr int CH_Q = 0, CH_K = 16384, CH_KT = 32768, CH_VT = 49152, CH_TAB = 65536, CH_BUFSZ = 67584;
constexpr int CH_NP = 2 * CH_BUFSZ, CH_WB = CH_NP + 512, CH_DP = CH_WB + 6144, CH_RD = CH_DP + 768, CH_END = CH_RD + 512;
__device__ __forceinline__ int ct_off(int row, int ch) { return row * 128 + ((ch ^ (row & 7)) << 4); }
__device__ __forceinline__ int qk_off(int row, int ch) { return row * 256 + ((ch ^ (row & 15)) << 4); }
__device__ __forceinline__ bf16x8 pack8r(const f32x16& x, int s2) { u32x4 p; p.x = cvtpk(x[8 * s2 + 0], x[8 * s2 + 1]); p.y = cvtpk(x[8 * s2 + 2], x[8 * s2 + 3]); p.z = cvtpk(x[8 * s2 + 4], x[8 * s2 + 5]); p.w = cvtpk(x[8 * s2 + 6], x[8 * s2 + 7]); return __builtin_bit_cast(bf16x8, p); }

template <int OFF2>
__device__ __forceinline__ void lds_read8(unsigned a0, unsigned a1, unsigned a2, unsigned a3, bf16x8 (&f)[8]) {
    asm volatile("ds_read_b128 %0, %8\n\tds_read_b128 %1, %8 offset:%c12\n\tds_read_b128 %2, %9\n\tds_read_b128 %3, %9 offset:%c12\n\t"
                 "ds_read_b128 %4, %10\n\tds_read_b128 %5, %10 offset:%c12\n\tds_read_b128 %6, %11\n\tds_read_b128 %7, %11 offset:%c12\n\ts_waitcnt lgkmcnt(0)"
                 : "=&v"(f[0]), "=&v"(f[1]), "=&v"(f[2]), "=&v"(f[3]), "=&v"(f[4]), "=&v"(f[5]), "=&v"(f[6]), "=&v"(f[7])
                 : "v"(a0), "v"(a1), "v"(a2), "v"(a3), "i"(OFF2) : "memory");
}
struct ChainPtrs { const bf16 *QC, *KC, *KT, *VT; const float* GT; const bf16* ML; bf16* YB; float* RD; };

__device__ __forceinline__ void ml_chain(int bh, const ChainPtrs& P, LAS unsigned char* lds, int tid) {
    const int lane_ = tid & 63, w = __builtin_amdgcn_readfirstlane(tid >> 6);
    const int b = bh >> 2, h = bh & 3;
    const bool slicew = w < 5;
    f32x16 C[4]; C[0] = f32x16{}; C[1] = f32x16{}; C[2] = f32x16{}; C[3] = f32x16{};
    const bf16* q0 = P.QC + (size_t)bh * 128 * 8192; const bf16* k0 = P.KC + (size_t)bh * 128 * 8192;
    const bf16* kt0 = P.KT + (size_t)bh * 128 * 8192; const bf16* vt0 = P.VT + (size_t)bh * 128 * 8192;
    const float* gt0 = P.GT + (size_t)bh * 128 * 384;
    const int wl = w - 4;
#define CH_DMA(src, dstoff) __builtin_amdgcn_global_load_lds((const unsigned*)(src), (LAS unsigned*)(lds + (dstoff)), 16, 0, 0)
#define CH_LOAD(cc, par) do { if (w >= 4) { const int bo_ = (par) * CH_BUFSZ; \
        const unsigned voq = (unsigned)(((4 * wl + (lane >> 4)) * 128 + (((lane & 15) ^ ((4 * wl + (lane >> 4)) & 15)) << 3)) * 2); \
        const unsigned vot = (unsigned)((((lane >> 3)) * 64 + (((lane & 7) ^ (lane >> 3)) << 3)) * 2); \
        const char* qb_ = (const char*)q0 + (size_t)(cc) * 16384; const char* kb_ = (const char*)k0 + (size_t)(cc) * 16384; \
        const char* tb_ = (const char*)kt0 + (size_t)(cc) * 16384 + wl * 4096; const char* vb_ = (const char*)vt0 + (size_t)(cc) * 16384 + wl * 4096; \
        _Pragma("unroll") for (int k = 0; k < 4; ++k) { \
            CH_DMA(qb_ + k * 4096 + voq, bo_ + CH_Q + (wl + 4 * k) * 1024); CH_DMA(kb_ + k * 4096 + voq, bo_ + CH_K + (wl + 4 * k) * 1024); \
            CH_DMA(tb_ + k * 1024 + vot, bo_ + CH_KT + (wl * 4 + k) * 1024); CH_DMA(vb_ + k * 1024 + vot, bo_ + CH_VT + (wl * 4 + k) * 1024); } \
        if (wl == 0) { CH_DMA(gt0 + (size_t)(cc) * 384 + lane * 4, bo_ + CH_TAB); if (lane < 32) CH_DMA(gt0 + (size_t)(cc) * 384 + 256 + lane * 4, bo_ + CH_TAB + 1024); } } } while (0)
#define CH_STOREOUT(cc, par) do { if (w >= 4) { \
        u32x4 y_[4]; \
        _Pragma("unroll") for (int n = 0; n < 4; ++n) { const int row = 16 * n + 4 * wl + (lane >> 4), ch = lane & 15; y_[n] = *(const LAS u32x4*)(lds + (par) * CH_BUFSZ + CH_Q + row * 256 + ((ch ^ (row & 15)) << 4)); } \
        asm volatile("s_waitcnt lgkmcnt(0)" : "+v"(y_[0]), "+v"(y_[1]), "+v"(y_[2]), "+v"(y_[3]) :: "memory"); \
        _Pragma("unroll") for (int n = 0; n < 4; ++n) { const int row = 16 * n + 4 * wl + (lane >> 4), ch = lane & 15; \
            *(u32x4*)(P.YB + ((size_t)b * SEQ + 64 * (cc) + row) * 512 + 128 * h + 8 * ch) = y_[n]; } } } while (0)
    { const int lane = lane_; CH_LOAD(0, 0); }
    __syncthreads();
    for (int c = 0; c < 128; ++c) {
        const int par = c & 1;
        int oz; asm volatile("v_mov_b32 %0, 0" : "=v"(oz));
        const int lane = lane_ + oz, r32 = lane & 31, hi = lane >> 5;
        LAS unsigned char* bufp = lds + par * CH_BUFSZ;
        LAS float* tab = (LAS float*)(bufp + CH_TAB);
        if (c >= 1) CH_STOREOUT(c - 1, par ^ 1);
        if (c + 1 < 128) CH_LOAD(c + 1, par ^ 1);
        f32x16 acc[2]; acc[0] = f32x16{}; acc[1] = f32x16{};
        if (slicew) {
            const unsigned qb_ = (unsigned)(par * CH_BUFSZ + CH_Q);
#pragma unroll
            for (int hb = 0; hb < 2; ++hb) {
                bf16x8 qf[8];
                lds_read8<8192>(qb_ + qk_off(r32, 2 * (4 * hb + 0) + hi), qb_ + qk_off(r32, 2 * (4 * hb + 1) + hi), qb_ + qk_off(r32, 2 * (4 * hb + 2) + hi), qb_ + qk_off(r32, 2 * (4 * hb + 3) + hi), qf);
#pragma unroll
                for (int i = 0; i < 4; ++i) {
                    const int s = 4 * hb + i;
                    const bf16x8 cf = pack8r(C[s >> 1], s & 1);
                    acc[0] = __builtin_amdgcn_mfma_f32_32x32x16_bf16(cf, qf[2 * i], acc[0], 0, 0, 0);
                    acc[1] = __builtin_amdgcn_mfma_f32_32x32x16_bf16(cf, qf[2 * i + 1], acc[1], 0, 0, 0);
                }
            }
            const float sc0 = tab[2 * 64 + r32], sc1 = tab[2 * 64 + 32 + r32];
#pragma unroll
            for (int r = 0; r < 16; ++r) { acc[0][r] *= sc0; acc[1][r] *= sc1; }
        } else {
            const int jh = (w == 7) ? 1 : 0, ih = (w == 5) ? 0 : 1;
            f32x16 S = f32x16{};
            const unsigned kb2 = (unsigned)(par * CH_BUFSZ + CH_K + 8192 * jh), qb2 = (unsigned)(par * CH_BUFSZ + CH_Q + 8192 * ih);
#pragma unroll
            for (int hb = 0; hb < 2; ++hb) {
                bf16x8 kf8[8], qf8[8];
                lds_read8<0>(kb2 + qk_off(r32, 2 * (4 * hb + 0) + hi), kb2 + qk_off(r32, 2 * (4 * hb + 1) + hi), kb2 + qk_off(r32, 2 * (4 * hb + 2) + hi), kb2 + qk_off(r32, 2 * (4 * hb + 3) + hi), kf8);
                lds_read8<0>(qb2 + qk_off(r32, 2 * (4 * hb + 0) + hi), qb2 + qk_off(r32, 2 * (4 * hb + 1) + hi), qb2 + qk_off(r32, 2 * (4 * hb + 2) + hi), qb2 + qk_off(r32, 2 * (4 * hb + 3) + hi), qf8);
#pragma unroll
                for (int i = 0; i < 4; ++i) S = __builtin_amdgcn_mfma_f32_32x32x16_bf16(kf8[2 * i], qf8[2 * i], S, 0, 0, 0);
            }
            const float ei = tab[32 * ih + r32];
            const bool diag = (jh == ih);
#pragma unroll
            for (int a = 0; a < 4; ++a) {
                const f32x4 d = *(const LAS f32x4*)(tab + 64 + 32 * jh + 8 * a + 4 * hi);
#pragma unroll
                for (int i = 0; i < 4; ++i) {
                    const int r = 4 * a + i, jl = 8 * a + 4 * hi + i;
                    float wv = S[r] * __builtin_amdgcn_exp2f(ei + d[i]);
                    if (diag && jl > r32) wv = 0.f;
                    S[r] = wv;
                }
            }
            const int tix = w - 5;
            *(LAS bf16x8*)(lds + CH_WB + (tix * 2 + 0) * 1024 + lane * 16) = pack8r(S, 0);
            *(LAS bf16x8*)(lds + CH_WB + (tix * 2 + 1) * 1024 + lane * 16) = pack8r(S, 1);
        }
        asm volatile("s_waitcnt lgkmcnt(0)" ::: "memory"); __builtin_amdgcn_s_barrier(); asm volatile("" ::: "memory");
        if (slicew) {
            const int sl = w;
            const float decay = tab[5 * 64];
#pragma unroll
            for (int t4 = 0; t4 < 4; ++t4)
#pragma unroll
                for (int r = 0; r < 16; ++r) C[t4][r] *= decay;
            const unsigned vb_ = (unsigned)(par * CH_BUFSZ + CH_VT), tb_ = (unsigned)(par * CH_BUFSZ + CH_KT), wb_ = (unsigned)CH_WB + lane * 16;
            bf16x8 vfr[4], wpk[6];
            {
                const int vrow = sl < 4 ? 32 * sl + r32 : r32;
                bf16x8 t8[8];
                lds_read8<1024>(wb_ + 0 * 2048, wb_ + 1 * 2048, wb_ + 2 * 2048, vb_ + ct_off(vrow, hi), t8);
                wpk[0] = t8[0]; wpk[1] = t8[1]; wpk[2] = t8[2]; wpk[3] = t8[3]; wpk[4] = t8[4]; wpk[5] = t8[5]; vfr[0] = t8[6];
                bf16x8 u8[8];
                lds_read8<0>(vb_ + ct_off(vrow, 2 + hi), vb_ + ct_off(vrow, 4 + hi), vb_ + ct_off(vrow, 6 + hi), vb_ + ct_off(vrow, 6 + hi), u8);
                vfr[1] = u8[0]; vfr[2] = u8[2]; vfr[3] = u8[4];
                if (sl == 4) { const short one = (r32 == 0) ? (short)0x3F80 : (short)0; const bf16x8 o8 = {one, one, one, one, one, one, one, one}; vfr[0] = o8; vfr[1] = o8; vfr[2] = o8; vfr[3] = o8; }
            }
            bf16x8 svf[4];
#pragma unroll
            for (int ks = 0; ks < 4; ++ks) {
                const bf16x8 vf = vfr[ks];
                if (ks < 2) { acc[0] = __builtin_amdgcn_mfma_f32_32x32x16_bf16(vf, wpk[0 * 2 + ks], acc[0], 0, 0, 0);
                              acc[1] = __builtin_amdgcn_mfma_f32_32x32x16_bf16(vf, wpk[1 * 2 + ks], acc[1], 0, 0, 0); }
                else acc[1] = __builtin_amdgcn_mfma_f32_32x32x16_bf16(vf, wpk[2 * 2 + (ks - 2)], acc[1], 0, 0, 0);
                const f32x4 sa = *(const LAS f32x4*)(tab + 4 * 64 + 16 * ks + 8 * hi), sb = *(const LAS f32x4*)(tab + 4 * 64 + 16 * ks + 8 * hi + 4);
                const u32x4 vx = __builtin_bit_cast(u32x4, vf);
                u32x4 sv; sv.x = cvtpk(bflo(vx.x) * sa[0], bfhi(vx.x) * sa[1]); sv.y = cvtpk(bflo(vx.y) * sa[2], bfhi(vx.y) * sa[3]);
                sv.z = cvtpk(bflo(vx.z) * sb[0], bfhi(vx.z) * sb[1]); sv.w = cvtpk(bflo(vx.w) * sb[2], bfhi(vx.w) * sb[3]);
                svf[ks] = __builtin_bit_cast(bf16x8, sv);
            }
#pragma unroll
            for (int kp = 0; kp < 2; ++kp) {
                bf16x8 kt8[8];
                lds_read8<4096>(tb_ + ct_off(r32, 2 * (2 * kp) + hi), tb_ + ct_off(64 + r32, 2 * (2 * kp) + hi), tb_ + ct_off(r32, 2 * (2 * kp + 1) + hi), tb_ + ct_off(64 + r32, 2 * (2 * kp + 1) + hi), kt8);
                C[0] = __builtin_amdgcn_mfma_f32_32x32x16_bf16(kt8[0], svf[2 * kp], C[0], 0, 0, 0);
                C[1] = __builtin_amdgcn_mfma_f32_32x32x16_bf16(kt8[1], svf[2 * kp], C[1], 0, 0, 0);
                C[2] = __builtin_amdgcn_mfma_f32_32x32x16_bf16(kt8[2], svf[2 * kp], C[2], 0, 0, 0);
                C[3] = __builtin_amdgcn_mfma_f32_32x32x16_bf16(kt8[3], svf[2 * kp], C[3], 0, 0, 0);
                C[0] = __builtin_amdgcn_mfma_f32_32x32x16_bf16(kt8[4], svf[2 * kp + 1], C[0], 0, 0, 0);
                C[1] = __builtin_amdgcn_mfma_f32_32x32x16_bf16(kt8[5], svf[2 * kp + 1], C[1], 0, 0, 0);
                C[2] = __builtin_amdgcn_mfma_f32_32x32x16_bf16(kt8[6], svf[2 * kp + 1], C[2], 0, 0, 0);
                C[3] = __builtin_amdgcn_mfma_f32_32x32x16_bf16(kt8[7], svf[2 * kp + 1], C[3], 0, 0, 0);
            }
            if (sl < 4) {
#pragma unroll
                for (int ih = 0; ih < 2; ++ih) {
                    const int i = 32 * ih + r32;
#pragma unroll
                    for (int a = 0; a < 4; ++a) {
                        u32x2 yv; yv.x = cvtpk(acc[ih][4 * a], acc[ih][4 * a + 1]); yv.y = cvtpk(acc[ih][4 * a + 2], acc[ih][4 * a + 3]);
                        *(LAS u32x2*)(bufp + CH_Q + i * 256 + (((4 * sl + a) ^ (i & 15)) << 4) + 8 * hi) = yv;
                    }
                }
            } else if (hi == 0) {
                const float d0 = acc[0][0], d1 = acc[1][0];
                float* rp = P.RD + ((size_t)b * SEQ + 64 * c) * 4 + h;
                rp[(size_t)r32 * 4] = 1.f / fmaxf(fabsf(d0), tab[3 * 64 + r32]);
                rp[(size_t)(32 + r32) * 4] = 1.f / fmaxf(fabsf(d1), tab[3 * 64 + 32 + r32]);
            }
        }
        __syncthreads();
    }
    { const int lane = lane_; CH_STOREOUT(127, 1); }
    __syncthreads();
#undef CH_LOAD
#undef CH_DMA
#undef CH_STOREOUT
}
struct Args { const float* in[26]; float* out; unsigned char* ws; int ph_lo, ph_hi; };

__global__ void __launch_bounds__(NWAVES * 64, 2) mk_fwd(Args args) {
    extern __shared__ __attribute__((aligned(16))) unsigned char lds_raw[];
    LAS unsigned char* lds = (LAS unsigned char*)lds_raw;
    const int tid = threadIdx.x, lane = tid & 63, wave = __builtin_amdgcn_readfirstlane(tid >> 6);
    const int G = gridDim.x; const int bx = blockIdx.x;
    const int vcu = (G % 8 == 0) ? (bx % 8) * (G / 8) + bx / 8 : bx;
    unsigned char* ws = args.ws;
    const float* x = args.in[0];
    bf16* WinT = (bf16*)(ws + WS_WIN); bf16* WaT = (bf16*)(ws + WS_WA); bf16* WbT = (bf16*)(ws + WS_WB); bf16* WoT = (bf16*)(ws + WS_WO);
    bf16* W1T = (bf16*)(ws + WS_W1); bf16* W2T = (bf16*)(ws + WS_W2);
    bf16* XN = (bf16*)(ws + WS_XN); bf16* QN = (bf16*)(ws + WS_QN); bf16* KV = (bf16*)(ws + WS_KV); bf16* ML = (bf16*)(ws + WS_ML); bf16* GB = (bf16*)(ws + WS_G);
    float* SB = (float*)(ws + WS_S); bf16* YA = (bf16*)(ws + WS_YA); bf16* YB = (bf16*)(ws + WS_YB); bf16* MX = (bf16*)(ws + WS_MX); bf16* UB = (bf16*)(ws + WS_U);
    float* rowss = (float*)(ws + WS_CTL + CTL_ROWSS);
    bf16* CK1T = (bf16*)(ws + WS_CK1); bf16* CV1T = (bf16*)(ws + WS_CV1); bf16* CK2T = (bf16*)(ws + WS_SMALL); bf16* CV2T = (bf16*)(ws + WS_SMALL + 32768);
    float* B1K = (float*)(ws + WS_SMALL + 65536); float* B1V = (float*)(ws + WS_SMALL + 65536 + 1024); float* BOUNDS = (float*)(ws + WS_SMALL + 65536 + 2048);
    bf16* KSN = (bf16*)(ws + WS_KSN); bf16* KWN = (bf16*)(ws + WS_KWN); bf16* VST = (bf16*)(ws + WS_VST); bf16* VWT = (bf16*)(ws + WS_VWT); bf16* KCN = (bf16*)(ws + WS_KCN); bf16* VCT = (bf16*)(ws + WS_VCT);
    bf16* QCb = (bf16*)args.out; bf16* KCb = QCb + (size_t)16 * 128 * 8192; bf16* KTb = KCb + (size_t)16 * 128 * 8192; bf16* VTb = KTb + (size_t)16 * 128 * 8192;
    float* GTb = (float*)(ws + WS_GT); float* RDb = (float*)(ws + WS_RD);
    volatile LAS unsigned* xbst = (volatile LAS unsigned*)(lds + XB_LDS_OFF);
    if (tid < 2) xbst[tid] = 0u;
    __syncthreads();
    XcdBarrier xbar = xcd_barrier_post((unsigned*)(ws + WS_CTL + CTL_BAR), xbst);
    const int lo = args.ph_lo, hi = args.ph_hi;
#define IN(k) (lo <= (k) && (k) < hi)
#define SEAM(k) do { if (IN(k) && IN((k) + 1)) { xcd_barrier(xbar); } } while (0)

    if (IN(0)) {
        LAS float* scr = (LAS float*)(lds + wave * 16384);
        const int gw = vcu * NWAVES + wave, NGW = G * NWAVES;
        constexpr int I_IN = (1024 / 64) * (NP_PAD / 32), I_A = (512 / 64) * (1024 / 32), I_O = (1024 / 64) * (1024 / 32), I_1 = (1024 / 64) * (4096 / 32), I_2 = (4096 / 64) * (1024 / 32);
        constexpr int I_C1 = (2048 / 64) * (256 / 32), I_C2 = (256 / 64) * (64 / 32), I_B1 = 512;
        constexpr int NITEMS = I_IN + 2 * I_A + I_O + I_1 + I_2 + 2 * I_C1 + 2 * I_C2 + I_B1 + 1;
        for (int pass = 0; pass < 2; ++pass) {
        if (((pass ^ gw) & 1) == 0)
        for (int it = gw; it < NITEMS; it += NGW) {
            int r = it;
            if (r < I_IN) { transpose_item<true>(args.in[2], 1024, D_PROJ, args.in[1], WinT, NP_PAD, scr, r, lane); continue; } r -= I_IN;
            if (r < I_A) { transpose_item<false>(args.in[20], 512, 1024, nullptr, WaT, 1024, scr, r, lane); continue; } r -= I_A;
            if (r < I_A) { transpose_item<false>(args.in[21], 512, 1024, nullptr, WbT, 1024, scr, r, lane); continue; } r -= I_A;
            if (r < I_O) { transpose_item<false>(args.in[22], 1024, 1024, nullptr, WoT, 1024, scr, r, lane); continue; } r -= I_O;
            if (r < I_1) { transpose_item<false>(args.in[24], 1024, 4096, args.in[23], W1T, 4096, scr, r, lane); continue; } r -= I_1;
            if (r < I_2) { transpose_item<false>(args.in[25], 4096, 1024, nullptr, W2T, 1024, scr, r, lane); continue; } r -= I_2;
            if (r < I_C1) { transpose_item<false>(args.in[6], 2048, 256, nullptr, CK1T, 256, scr, r, lane); continue; } r -= I_C1;
            if (r < I_C1) { transpose_item<false>(args.in[11], 2048, 256, nullptr, CV1T, 256, scr, r, lane); continue; } r -= I_C1;
            if (r < I_C2) { transpose_item<false>(args.in[8], 256, 64, nullptr, CK2T, 64, scr, r, lane); continue; } r -= I_C2;
            if (r < I_C2) { transpose_item<false>(args.in[13], 256, 64, nullptr, CV2T, 64, scr, r, lane); continue; } r -= I_C2;
            if (r < I_B1) {
                const int kv = r >> 8, u = r & 255; const float* pos = args.in[kv ? 10 : 5]; const float* w1 = args.in[kv ? 11 : 6]; const float* b1 = args.in[kv ? 12 : 7];
                float a = 0.f;
                for (int i = lane; i < 2048; i += 64) a += pos[i] * w1[(size_t)i * 256 + u];
                a = wave_sum(a);
                if (lane == 0) (kv ? B1V : B1K)[u] = a + b1[u];
                continue; } r -= I_B1;
            {
                float gq = fabsf(args.in[3][lane]); float gk = fmaxf(fmaxf(fabsf(args.in[4][lane]), fabsf(args.in[4][64 + lane])), fabsf(args.in[4][128 + lane]));
                gq = wave_max(gq); gk = wave_max(gk);
                if (lane < 8) { float mb = -1e30f; for (int bk = 0; bk < 32; ++bk) mb = fmaxf(mb, args.in[15][bk * 8 + lane] - args.in[15][31 * 8 + lane]);
                    const float top = (8.f * gq * gk + mb) * 1.4426950408889634f;
                    BOUNDS[lane] = top > 100.f ? 100.f - top : 0.f; }
            }
        }
        else
        for (int m = gw; m < NTOK; m += NGW) rms_row_to_bf16(x + (size_t)m * D_MODEL, XN + (size_t)m * D_MODEL, lane);
        }
    }
    SEAM(0);
    if (IN(1)) {
        pg8::Gemm g{XN, WinT, NTOK, NP_PAD, 1024}; pg8::StaticOrder S; S.init(NTOK, NP_PAD, G, bx);
        pg8::EpiProj E{QN, KV, ML, GB, SB};
        pg8::gemm_phase<pg8::EpiProj, pg8::StaticOrder, true, true>(lds, g, S, E);
    }
    SEAM(1);
    if (IN(2)) {
        const float* kgain = args.in[4];
        if (bx < 128) { const int kvs = bx & 1; compress_unit(bx, KV, kvs ? CV1T : CK1T, kvs ? CV2T : CK2T, kvs ? B1V : B1K, args.in[kvs ? 14 : 9], kgain, KCN, VCT, lds, tid); }
        else if (bx < 144) ml_gates_unit(bx - 128, SB, args.in[18], args.in[19], GTb, lds, tid);
        unsigned* pctr = (unsigned*)(ws + WS_CTL + CTL_QCTR) + 64;
        LAS int* pm = (LAS int*)(lds + 147000);
        LAS unsigned short* scr = (LAS unsigned short*)(lds + wave * 17408);
        for (;;) {
            __syncthreads();
            if (tid == 0) pm[0] = (int)atomicAdd(pctr, 1u);
            __syncthreads();
            const int u = pm[0];
            if (u >= 2048 + 512) break;
            if (u < 2048) ml_prep_unit(u, ML, args.in[16], args.in[17], QCb, KCb, KTb, VTb, lds, tid);
            else {
                const int it = (u - 2048) * 8 + wave;
                const int kind = it & 3, bgj = it >> 2, bg = bgj >> 7, j = bgj & 127, b = bg >> 1, g = bg & 1;
                const size_t tok0 = (size_t)b * SEQ + 64 * j;
                if (kind == 0) knorm_item(KV, 256 + 64 * g, kgain + 64, KSN + ((size_t)bg * SEQ + 64 * j) * 64, tok0, lane);
                else if (kind == 1) knorm_item(KV, 512 + 64 * g, kgain + 128, KWN + ((size_t)bg * SEQ + 64 * j) * 64, tok0, lane);
                else if (kind == 2) vtrans_item(KV, 384 + 64 * g, VST + ((size_t)bg * 128 + j) * 4096, tok0, scr, lane);
                else vtrans_item(KV, 640 + 64 * g, VWT + ((size_t)bg * 128 + j) * 4096, tok0, scr, lane);
            }
        }
    }
    SEAM(2);
    if (IN(3)) {
        if (bx < 16) { ChainPtrs CP{QCb, KCb, KTb, VTb, GTb, ML, YB, RDb}; ml_chain(bx, CP, lds, tid); }
        EngPtrs P{QN, KCN, VCT, KSN, VST, KWN, VWT, SB, args.in[15], args.in[3], BOUNDS, YA};
        unsigned* qctr = (unsigned*)(ws + WS_CTL + CTL_QCTR);
        LAS int* misc = (LAS int*)(lds + ENG_MISC);
        for (;;) {
            __syncthreads();
            if (tid == 0) misc[0] = (int)atomicAdd(qctr, 1u);
            __syncthreads();
            const int u = misc[0];
            if (u >= 1024) break;
            eng_unit(u, P, lds, tid);
        }
    }
    SEAM(3);
    if (IN(4)) {
        {
            const int gt_ = bx * (NWAVES * 64) + tid, GT_ = G * NWAVES * 64;
            for (int i = gt_; i < NTOK * 64; i += GT_) {
                const int row = i >> 6, c8 = (i & 63) * 8;
                const v4u y = *(const v4u*)(YB + (size_t)row * 512 + c8), o = *(const v4u*)(ML + (size_t)row * 2048 + 1536 + c8);
                const float rd = RDb[(size_t)row * 4 + (c8 >> 7)];
                v4u r;
                r.x = pg8::cvt_pk_bf16(pg8::bf_lo(y.x) * pg8::bf_lo(o.x) * rd, pg8::bf_hi(y.x) * pg8::bf_hi(o.x) * rd); r.y = pg8::cvt_pk_bf16(pg8::bf_lo(y.y) * pg8::bf_lo(o.y) * rd, pg8::bf_hi(y.y) * pg8::bf_hi(o.y) * rd);
                r.z = pg8::cvt_pk_bf16(pg8::bf_lo(y.z) * pg8::bf_lo(o.z) * rd, pg8::bf_hi(y.z) * pg8::bf_hi(o.z) * rd); r.w = pg8::cvt_pk_bf16(pg8::bf_lo(y.w) * pg8::bf_lo(o.w) * rd, pg8::bf_hi(y.w) * pg8::bf_hi(o.w) * rd);
                *(v4u*)(YB + (size_t)row * 512 + c8) = r;
            }
        }
        pg8::Gemm g{YA, WaT, NTOK, 1024, 512}; pg8::StaticOrder S; S.init(NTOK, 1024, G, bx);
        pg8::EpiGate<false> E{GB, 0, MX};
        pg8::gemm_phase<pg8::EpiGate<false>, pg8::StaticOrder, true, true>(lds, g, S, E);
    }
    SEAM(4);
    if (IN(5)) {
        pg8::Gemm g{YB, WbT, NTOK, 1024, 512}; pg8::StaticOrder S; S.init(NTOK, 1024, G, bx);
        pg8::EpiGate<true> E{GB, 1024, MX};
        pg8::gemm_phase<pg8::EpiGate<true>, pg8::StaticOrder, true, true>(lds, g, S, E);
    }
    SEAM(5);
    if (IN(6)) {
        pg8::Gemm g{MX, WoT, NTOK, 1024, 1024}; pg8::StaticOrder S; S.init(NTOK, 1024, G, bx);
        pg8::EpiOut E{x, args.out, XN, rowss};
        pg8::gemm_phase<pg8::EpiOut, pg8::StaticOrder, true, true>(lds, g, S, E);
    }
    SEAM(6);
    if (IN(7)) {
        pg8::Gemm g{XN, W1T, NTOK, 4096, 1024}; pg8::StaticOrder S; S.init(NTOK, 4096, G, bx);
        pg8::EpiFF1 E{rowss, UB};
        pg8::gemm_phase<pg8::EpiFF1, pg8::StaticOrder, true, true>(lds, g, S, E);
    }
    SEAM(7);
    if (IN(8)) {
        pg8::Gemm g{UB, W2T, NTOK, 1024, 4096}; pg8::StaticOrder S; S.init(NTOK, 1024, G, bx);
        pg8::EpiFF2 E{args.out};
        pg8::gemm_phase<pg8::EpiFF2, pg8::StaticOrder, true, true>(lds, g, S, E);
    }
#undef IN
#undef SEAM
}

extern "C" void kernel_launch(void* const* d_in, const int* in_sizes, int n_in, void* d_out, int out_size, void* d_ws, size_t ws_size, hipStream_t stream) {
    static int grid = 0;
    if (grid == 0) {
        int dev = 0, cus = 0, per_cu = 0;
        if (hipGetDevice(&dev) != hipSuccess || hipDeviceGetAttribute(&cus, hipDeviceAttributeMultiprocessorCount, dev) != hipSuccess) { grid = -1; return; }
        if (hipFuncSetAttribute((const void*)mk_fwd, hipFuncAttributeMaxDynamicSharedMemorySize, LDS_BYTES) != hipSuccess) { fprintf(stderr, "hipFuncSetAttribute failed\n"); grid = -1; return; }
        if (hipOccupancyMaxActiveBlocksPerMultiprocessor(&per_cu, (const void*)mk_fwd, NWAVES * 64, LDS_BYTES) != hipSuccess || per_cu < 1) { fprintf(stderr, "occupancy query failed (%d)\n", per_cu); grid = -1; return; }
        if (ws_size < WS_END) { fprintf(stderr, "workspace too small: %zu < %zu\n", ws_size, (size_t)WS_END); grid = -1; return; }
        grid = cus;
    }
    if (grid < 0) return;
    (void)hipMemsetAsync((char*)d_ws + WS_CTL, 0, CTL_ZERO_BYTES, stream);
    Args a{};
    for (int i = 0; i < 26; ++i) a.in[i] = (const float*)d_in[i];
    a.out = (float*)d_out; a.ws = (unsigned char*)d_ws; a.ph_lo = 0; a.ph_hi = 9;
    void* kargs[] = {&a};
    hipError_t e = hipLaunchCooperativeKernel((const void*)mk_fwd, dim3(grid), dim3(NWAVES * 64), kargs, LDS_BYTES, stream);
    if (e != hipSuccess) fprintf(stderr, "cooperative launch failed: %s (grid %d)\n", hipGetErrorString(e), grid);
}
```

```cpp
#include <hip/hip_runtime.h>
#include <cstdint>
#include <cstdio>
#include <hip/hip_cooperative_groups.h>
namespace cg = cooperative_groups;
namespace pg8 {
#define PG8_LAS __attribute__((address_space(3)))
typedef unsigned short bf16_t;
typedef short bf16x8 __attribute__((ext_vector_type(8)));
typedef float f32x4 __attribute__((ext_vector_type(4)));
typedef unsigned u32x4 __attribute__((ext_vector_type(4)));
constexpr int BM = 256, BK = 64, HALF = 128, HTB = HALF * BK * 2  , STAGE_BYTES = 8 * HTB, NXCD = 8, WGM = 8;

__host__ __device__ __forceinline__ int lds_byte(int r, int c) { const int st = (r >> 4) * 2 + (c >> 5), rr = r & 15, cc = c & 31, ob = rr * 64 + cc * 2; return st * 1024 + (ob ^ (((ob >> 9) & 1) << 5)); }
__host__ __device__ __forceinline__ void stage_rc(int b, int& R, int& C) { const int st = b / 1024, sb = b % 1024, swz = sb ^ (((sb >> 9) & 1) << 5); R = (st >> 1) * 16 + swz / 64; C = (st & 1) * 32 + (swz % 64) / 2; }
__host__ __device__ __forceinline__ int perm32(int rho) { const int n = rho >> 4, i = rho & 15; return 8 * (i >> 2) + 4 * n + (i & 3); }

struct Unit { int pm, pn; };
struct Gemm { const bf16_t* A; const bf16_t* Bt; int M, N, K; };

struct StaticOrder {
    int nM, nN, nwg, G, c;
    __host__ __device__ void init(int M, int N, int G_, int c_) { nM = M / BM; nN = N / BM; nwg = nM * nN; G = G_; c = c_; }
    __host__ __device__ bool next(int i, Unit& u) const {
        const long L = (long)i * G + c; if (L >= nwg) return false;
        int wgid = (int)L; { const int q = nwg / NXCD, r = nwg % NXCD, xcd = wgid % NXCD, off = wgid / NXCD; wgid = (xcd < r ? xcd * (q + 1) : r * (q + 1) + (xcd - r) * q) + off; }
        const int nig = WGM * nN, gid = wgid / nig, fm = gid * WGM, gsz = (nM - fm) < WGM ? (nM - fm) : WGM;
        u.pm = fm + ((wgid % nig) % gsz); u.pn = (wgid % nig) / gsz; return true;
    }
    __device__ __forceinline__ void a_ready(const Unit&) const {}
    __device__ __forceinline__ void done(const Unit&) const {}
};
__device__ __forceinline__ unsigned cvt_pk_bf16(float lo, float hi) { unsigned r; asm volatile("v_cvt_pk_bf16_f32 %0, %1, %2" : "=v"(r) : "v"(lo), "v"(hi)); return r; }
__device__ __forceinline__ float bf_lo(unsigned w) { return __uint_as_float(w << 16); }
__device__ __forceinline__ float bf_hi(unsigned w) { return __uint_as_float(w & 0xffff0000u); }
__device__ __forceinline__ float fsigmoid(float v) { return __builtin_amdgcn_rcpf(1.f + __builtin_amdgcn_exp2f(-1.4426950408889634f * v)); }
__device__ __forceinline__ u32x4 pack8(const f32x4 v0, const f32x4 v1) { u32x4 w; w.x = cvt_pk_bf16(v0[0], v0[1]); w.y = cvt_pk_bf16(v0[2], v0[3]); w.z = cvt_pk_bf16(v1[0], v1[1]); w.w = cvt_pk_bf16(v1[2], v1[3]); return w; }

struct EpiProj {
    static constexpr bool PERM = true, AFTER_DRAIN = false;
    bf16_t *Qn, *KV, *ML, *G; float* S;
    __device__ __forceinline__ void operator()(const f32x4 (&acc)[2][2][4][2], const Unit& u, int wr, int wc, int fr, int fq) const {
        const int pn = u.pn, row0 = u.pm * BM + wr * 64 + fr;
        if (pn == 21) {
            if (wc == 0) {
#pragma unroll
                for (int ai = 0; ai < 2; ++ai)
#pragma unroll
                    for (int m = 0; m < 4; ++m) { float* p = S + (size_t)(row0 + ai * HALF + m * 16) * 32 + 8 * fq; *(f32x4*)p = acc[ai][0][m][0]; *(f32x4*)(p + 4) = acc[ai][0][m][1]; }
            }
            return;
        }
        bf16_t* base; int ld, ct; bool sig = false;
        if (pn < 2) { base = Qn; ld = 512; ct = pn; }
        else if (pn < 5) { base = KV; ld = 768; ct = pn - 2; }
        else if (pn < 13) { base = ML; ld = 2048; ct = pn - 5; sig = (pn >= 11); }
        else { base = G; ld = 2048; ct = pn - 13; sig = true; }
        const int col0 = ct * 256 + wc * 32 + 8 * fq;
#pragma unroll
        for (int ai = 0; ai < 2; ++ai)
#pragma unroll
            for (int m = 0; m < 4; ++m) { bf16_t* rowp = base + (size_t)(row0 + ai * HALF + m * 16) * ld + col0;
#pragma unroll
                for (int bj = 0; bj < 2; ++bj) { f32x4 v0 = acc[ai][bj][m][0], v1 = acc[ai][bj][m][1];
                    if (sig) {
#pragma unroll
                        for (int i = 0; i < 4; ++i) { v0[i] = fsigmoid(v0[i]); v1[i] = fsigmoid(v1[i]); } }
                    *(u32x4*)(rowp + bj * HALF) = pack8(v0, v1); } }
    }
};
template <bool ACCUM> struct EpiGate {
    static constexpr bool PERM = true, AFTER_DRAIN = false;
    const bf16_t* G; int gcol0; bf16_t* Mx;
    __device__ __forceinline__ void operator()(const f32x4 (&acc)[2][2][4][2], const Unit& u, int wr, int wc, int fr, int fq) const {
        const int row0 = u.pm * BM + wr * 64 + fr, col0 = u.pn * BM + wc * 32 + 8 * fq;
#pragma unroll
        for (int ai = 0; ai < 2; ++ai)
#pragma unroll
            for (int m = 0; m < 4; ++m) { const size_t row = (size_t)(row0 + ai * HALF + m * 16);
#pragma unroll
                for (int bj = 0; bj < 2; ++bj) {
                    const u32x4 g = *(const u32x4*)(G + row * 2048 + gcol0 + col0 + bj * HALF);
                    f32x4 v0 = acc[ai][bj][m][0], v1 = acc[ai][bj][m][1];
                    v0[0] *= bf_lo(g.x); v0[1] *= bf_hi(g.x); v0[2] *= bf_lo(g.y); v0[3] *= bf_hi(g.y);
                    v1[0] *= bf_lo(g.z); v1[1] *= bf_hi(g.z); v1[2] *= bf_lo(g.w); v1[3] *= bf_hi(g.w);
                    bf16_t* mp = Mx + row * 1024 + col0 + bj * HALF;
                    if (ACCUM) { const u32x4 o = *(const u32x4*)mp;
                        v0[0] += bf_lo(o.x); v0[1] += bf_hi(o.x); v0[2] += bf_lo(o.y); v0[3] += bf_hi(o.y);
                        v1[0] += bf_lo(o.z); v1[1] += bf_hi(o.z); v1[2] += bf_lo(o.w); v1[3] += bf_hi(o.w); }
                    *(u32x4*)mp = pack8(v0, v1); } }
    }
};
struct EpiOut {
    static constexpr bool PERM = true, AFTER_DRAIN = false;
    const float* x; float* x1; bf16_t* x1b; float* rowss;
    __device__ __forceinline__ void operator()(const f32x4 (&acc)[2][2][4][2], const Unit& u, int wr, int wc, int fr, int fq) const {
        const int row0 = u.pm * BM + wr * 64 + fr, col0 = u.pn * BM + wc * 32 + 8 * fq;
#pragma unroll
        for (int ai = 0; ai < 2; ++ai)
#pragma unroll
            for (int m = 0; m < 4; ++m) { const size_t row = (size_t)(row0 + ai * HALF + m * 16); float ss = 0.f;
#pragma unroll
                for (int bj = 0; bj < 2; ++bj) { const size_t off = row * 1024 + col0 + bj * HALF;
                    const f32x4 v0 = acc[ai][bj][m][0] + *(const f32x4*)(x + off), v1 = acc[ai][bj][m][1] + *(const f32x4*)(x + off + 4);
                    *(f32x4*)(x1 + off) = v0; *(f32x4*)(x1 + off + 4) = v1; *(u32x4*)(x1b + off) = pack8(v0, v1);
                    ss += (v0[0] * v0[0] + v0[1] * v0[1]) + (v0[2] * v0[2] + v0[3] * v0[3]) + (v1[0] * v1[0] + v1[1] * v1[1]) + (v1[2] * v1[2] + v1[3] * v1[3]); }
                ss += __shfl_xor(ss, 16); ss += __shfl_xor(ss, 32);
                if (fq == 0) atomicAdd(rowss + row, ss); }
    }
};
struct EpiFF1 {
    static constexpr bool PERM = true, AFTER_DRAIN = false;
    const float* rowss; bf16_t* U;
    __device__ __forceinline__ void operator()(const f32x4 (&acc)[2][2][4][2], const Unit& u, int wr, int wc, int fr, int fq) const {
        const int row0 = u.pm * BM + wr * 64 + fr, col0 = u.pn * BM + wc * 32 + 8 * fq;
#pragma unroll
        for (int ai = 0; ai < 2; ++ai)
#pragma unroll
            for (int m = 0; m < 4; ++m) { const size_t row = (size_t)(row0 + ai * HALF + m * 16);
                const float rs = 1.0f / sqrtf(rowss[row] * (1.f / 1024.f) + 1e-6f);
#pragma unroll
                for (int bj = 0; bj < 2; ++bj) { f32x4 v0 = acc[ai][bj][m][0] * rs, v1 = acc[ai][bj][m][1] * rs;
#pragma unroll
                    for (int i = 0; i < 4; ++i) { const float a = fmaxf(v0[i], 0.f), b = fmaxf(v1[i], 0.f); v0[i] = a * a; v1[i] = b * b; }
                    *(u32x4*)(U + row * 4096 + col0 + bj * HALF) = pack8(v0, v1); } }
    }
};
struct EpiFF2 {
    static constexpr bool PERM = true, AFTER_DRAIN = false;
    float* out;
    __device__ __forceinline__ void operator()(const f32x4 (&acc)[2][2][4][2], const Unit& u, int wr, int wc, int fr, int fq) const {
        const int row0 = u.pm * BM + wr * 64 + fr, col0 = u.pn * BM + wc * 32 + 8 * fq;
#pragma unroll
        for (int ai = 0; ai < 2; ++ai)
#pragma unroll
            for (int m = 0; m < 4; ++m) { const size_t row = (size_t)(row0 + ai * HALF + m * 16);
#pragma unroll
                for (int bj = 0; bj < 2; ++bj) { float* p = out + row * 1024 + col0 + bj * HALF;
                    const f32x4 v0 = acc[ai][bj][m][0] + *(const f32x4*)p, v1 = acc[ai][bj][m][1] + *(const f32x4*)(p + 4);
                    *(f32x4*)p = v0; *(f32x4*)(p + 4) = v1; } }
    }
};
template <class Epi, class Sched, bool ALIGN_EPI = false, bool SP2 = false>
__device__ __forceinline__ void gemm_phase(PG8_LAS unsigned char* lds, const Gemm g, const Sched& S, const Epi& E) {
    const int tid = threadIdx.x, wid = __builtin_amdgcn_readfirstlane(tid >> 6), lane = tid & 63, wr = wid >> 2, wc = wid & 3, fr = lane & 15, fq = lane >> 4;
    const int K = g.K, nt = K / BK;
    unsigned voffA[2], voffB[2];
#pragma unroll
    for (int i = 0; i < 2; ++i) { int R, C; stage_rc(tid * 16 + i * 8192, R, C); const int Rb = Epi::PERM ? ((R & ~31) + perm32(R & 31)) : R;
        voffA[i] = (unsigned)(R * K + C) * 2u; voffB[i] = (unsigned)(Rb * K + C) * 2u; }
    const size_t kstep = (size_t)(BK * 2);
    const size_t hstep = (size_t)HALF * K * 2;
    const size_t tstep = 2 * hstep;
    const unsigned ldsw = (unsigned)wid * 1024u;
    const int aoff = lds_byte(wr * 64 + fr, fq * 8), boff = lds_byte(wc * 32 + fr, fq * 8);
#define PG8_SA(b, h) (((b) * 2 + (h)) * HTB)
#define PG8_SB(b, h) ((4 + (b) * 2 + (h)) * HTB)
#define PG8_STAGE(bufoff, gbase, voff) do { _Pragma("unroll") for (int _i = 0; _i < 2; ++_i) \
        __builtin_amdgcn_global_load_lds((const unsigned*)((const char*)(gbase) + (voff)[_i]), (PG8_LAS unsigned*)(lds + (bufoff) + ldsw + _i * 8192), 16, 0, 0); } while (0)
#define PG8_LDA(dst, b, h) do { _Pragma("unroll") for (int m = 0; m < 4; ++m) _Pragma("unroll") for (int k = 0; k < 2; ++k) dst[m][k] = *(const PG8_LAS bf16x8*)(lds + PG8_SA(b, h) + aoff + m * 2048 + k * 1024); } while (0)
#define PG8_LDB(dst, b, h) do { _Pragma("unroll") for (int n = 0; n < 2; ++n) _Pragma("unroll") for (int k = 0; k < 2; ++k) dst[n][k] = *(const PG8_LAS bf16x8*)(lds + PG8_SB(b, h) + boff + n * 2048 + k * 1024); } while (0)
#define PG8_MMA(ai, bj, At, Bt) do { __builtin_amdgcn_s_setprio(1); _Pragma("unroll") for (int m = 0; m < 4; ++m) _Pragma("unroll") for (int n = 0; n < 2; ++n) _Pragma("unroll") for (int k = 0; k < 2; ++k) \
        acc[ai][bj][m][n] = __builtin_amdgcn_mfma_f32_16x16x32_bf16(Bt[n][k], At[m][k], acc[ai][bj][m][n], 0, 0, 0); __builtin_amdgcn_s_setprio(0); } while (0)
#define PG8_WAIT_V(n) asm volatile("s_waitcnt vmcnt(" #n ")" ::: "memory")
#define PG8_WAIT_L(n) asm volatile("s_waitcnt lgkmcnt(" #n ")" ::: "memory")
#define PG8_BAR __builtin_amdgcn_s_barrier()
#define PG8_SCHED __builtin_amdgcn_sched_barrier(0)
    Unit cur, nxt; int ui = 0;
    if (!S.next(0, cur)) return;
    f32x4 acc[2][2][4][2];
#pragma unroll
    for (int a = 0; a < 2; ++a)
#pragma unroll
        for (int b = 0; b < 2; ++b)
#pragma unroll
            for (int m = 0; m < 4; ++m)
#pragma unroll
                for (int n = 0; n < 2; ++n) acc[a][b][m][n] = (f32x4){0.f, 0.f, 0.f, 0.f};
    bf16x8 At[4][2], B0[2][2], B1[2][2];
    const char* cA = (const char*)g.A + (size_t)cur.pm * tstep; const char* cB = (const char*)g.Bt + (size_t)cur.pn * tstep;
    S.a_ready(cur);
    if constexpr (SP2) {
        PG8_STAGE(PG8_SB(0, 0), cB, voffB); PG8_STAGE(PG8_SB(0, 1), cB + hstep, voffB); PG8_STAGE(PG8_SA(0, 0), cA, voffA); PG8_STAGE(PG8_SA(0, 1), cA + hstep, voffA);
        if (wr == 1) PG8_BAR;
        PG8_WAIT_V(2); PG8_BAR;
        PG8_STAGE(PG8_SB(1, 0), cB + kstep, voffB); PG8_STAGE(PG8_SA(1, 0), cA + kstep, voffA); PG8_STAGE(PG8_SB(1, 1), cB + hstep + kstep, voffB);
        PG8_WAIT_V(6); PG8_BAR;
    } else {
        PG8_STAGE(PG8_SB(0, 0), cB, voffB); PG8_STAGE(PG8_SA(0, 0), cA, voffA); PG8_STAGE(PG8_SB(0, 1), cB + hstep, voffB); PG8_STAGE(PG8_SA(0, 1), cA + hstep, voffA);
        if (wr == 1) PG8_BAR;
        PG8_WAIT_V(4); PG8_BAR;
        PG8_STAGE(PG8_SB(1, 0), cB + kstep, voffB); PG8_STAGE(PG8_SA(1, 0), cA + kstep, voffA); PG8_STAGE(PG8_SB(1, 1), cB + hstep + kstep, voffB);
        PG8_WAIT_V(6); PG8_BAR;
    }
    for (;;) {
        const bool has_next = S.next(ui + 1, nxt);
        const char* nA = has_next ? (const char*)g.A + (size_t)nxt.pm * tstep : cA; const char* nB = has_next ? (const char*)g.Bt + (size_t)nxt.pn * tstep : cB;
        for (int t = 0; t < nt; t += 2) {
            const bool last = (t == nt - 2);
            const char* a1 = cA + (size_t)(t + 1) * kstep;
            const char* a2 = last ? nA : cA + (size_t)(t + 2) * kstep; const char* b2 = last ? nB : cB + (size_t)(t + 2) * kstep;
            const char* a3 = a2 + kstep; const char* b3 = b2 + kstep;
            if (last && has_next) S.a_ready(nxt);
            if constexpr (SP2) {
            PG8_LDB(B0, 0, 0); PG8_LDB(B1, 0, 1); PG8_SCHED; PG8_LDA(At, 0, 0); PG8_STAGE(PG8_SA(1, 1), a1 + hstep, voffA);
            PG8_WAIT_V(8); PG8_WAIT_L(0); PG8_BAR; PG8_MMA(0, 0, At, B0); PG8_MMA(0, 1, At, B1); PG8_BAR; PG8_SCHED;
            PG8_LDA(At, 0, 1); PG8_STAGE(PG8_SB(0, 0), b2, voffB); PG8_STAGE(PG8_SB(0, 1), b2 + hstep, voffB); PG8_STAGE(PG8_SA(0, 0), a2, voffA);
            PG8_WAIT_V(8); PG8_WAIT_L(0); PG8_BAR; PG8_MMA(1, 0, At, B0); PG8_MMA(1, 1, At, B1); PG8_BAR; PG8_SCHED;
            PG8_LDB(B0, 1, 0); PG8_LDB(B1, 1, 1); PG8_SCHED; PG8_LDA(At, 1, 0); PG8_STAGE(PG8_SA(0, 1), a2 + hstep, voffA);
            PG8_WAIT_V(8); PG8_WAIT_L(0); PG8_BAR; PG8_MMA(0, 0, At, B0); PG8_MMA(0, 1, At, B1); PG8_BAR; PG8_SCHED;
            PG8_LDA(At, 1, 1); PG8_STAGE(PG8_SB(1, 0), b3, voffB); PG8_STAGE(PG8_SB(1, 1), b3 + hstep, voffB); PG8_STAGE(PG8_SA(1, 0), a3, voffA);
            PG8_WAIT_V(8); PG8_WAIT_L(0); PG8_BAR; PG8_MMA(1, 0, At, B0); PG8_MMA(1, 1, At, B1); PG8_BAR; PG8_SCHED;
            } else {
            PG8_LDB(B0, 0, 0); PG8_SCHED; PG8_LDA(At, 0, 0); PG8_STAGE(PG8_SA(1, 1), a1 + hstep, voffA);
            PG8_WAIT_L(8); PG8_BAR; PG8_WAIT_L(0); PG8_MMA(0, 0, At, B0); PG8_BAR; PG8_SCHED;
            PG8_LDB(B1, 0, 1); PG8_STAGE(PG8_SB(0, 0), b2, voffB);
            PG8_BAR; PG8_WAIT_L(0); PG8_MMA(0, 1, At, B1); PG8_BAR;
            PG8_LDA(At, 0, 1); PG8_STAGE(PG8_SA(0, 0), a2, voffA);
            PG8_BAR; PG8_WAIT_L(0); PG8_MMA(1, 0, At, B0); PG8_BAR; PG8_SCHED;
            PG8_STAGE(PG8_SB(0, 1), b2 + hstep, voffB);
            PG8_WAIT_V(6); PG8_BAR; PG8_MMA(1, 1, At, B1); PG8_BAR;
            PG8_LDB(B0, 1, 0); PG8_SCHED; PG8_LDA(At, 1, 0); PG8_STAGE(PG8_SA(0, 1), a2 + hstep, voffA);
            PG8_WAIT_L(8); PG8_BAR; PG8_WAIT_L(0); PG8_MMA(0, 0, At, B0); PG8_BAR; PG8_SCHED;
            PG8_LDB(B1, 1, 1); PG8_STAGE(PG8_SB(1, 0), b3, voffB);
            PG8_BAR; PG8_WAIT_L(0); PG8_MMA(0, 1, At, B1); PG8_BAR;
            PG8_LDA(At, 1, 1); PG8_STAGE(PG8_SA(1, 0), a3, voffA);
            PG8_BAR; PG8_WAIT_L(0); PG8_MMA(1, 0, At, B0); PG8_BAR; PG8_SCHED;
            PG8_STAGE(PG8_SB(1, 1), b3 + hstep, voffB);
            PG8_WAIT_V(6); PG8_BAR; PG8_MMA(1, 1, At, B1); PG8_BAR;
            }
        }
        if constexpr (ALIGN_EPI) { if (wr == 0) PG8_BAR; }
        if constexpr (!Epi::AFTER_DRAIN) { E(acc, cur, wr, wc, fr, fq); S.done(cur); }
        if (!has_next) break;
#pragma unroll
        for (int a = 0; a < 2; ++a)
#pragma unroll
            for (int b = 0; b < 2; ++b)
#pragma unroll
                for (int m = 0; m < 4; ++m)
#pragma unroll
                    for (int n = 0; n < 2; ++n) acc[a][b][m][n] = (f32x4){0.f, 0.f, 0.f, 0.f};
        cur = nxt; cA = nA; cB = nB; ++ui;
        if constexpr (ALIGN_EPI) { if (wr == 1) PG8_BAR; }
    }
    PG8_WAIT_V(0);
    if constexpr (!ALIGN_EPI) { if (wr == 0) PG8_BAR; }
    PG8_BAR;
    if constexpr (Epi::AFTER_DRAIN) { E.fused(acc, cur, wr, wc, fr, fq, lds, wid, lane); S.done(cur); }
#undef PG8_SA
#undef PG8_SB
#undef PG8_STAGE
#undef PG8_LDA
#undef PG8_LDB
#undef PG8_MMA
#undef PG8_WAIT_V
#undef PG8_WAIT_L
#undef PG8_BAR
#undef PG8_SCHED
}
}
constexpr int D_MODEL = 1024, BATCH = 4, SEQ = 8192, NTOK = BATCH * SEQ;
constexpr int D_PROJ = 5408, D_FF = 4096, NP_PAD = 5632;
constexpr int NWAVES = 8;
constexpr size_t MiB = 1u << 20;
constexpr size_t WS_CTL = 0, CTL_ZERO_BYTES = 1 * MiB;
constexpr size_t CTL_ROWSS = 512 * 1024;
constexpr size_t WS_WIN = 2 * MiB, WS_WA = 13 * MiB, WS_WB = 14 * MiB, WS_WO = 15 * MiB, WS_W1 = 17 * MiB, WS_W2 = 25 * MiB, WS_CK1 = 33 * MiB, WS_CV1 = 34 * MiB;
constexpr size_t WS_SMALL = 35 * MiB;
constexpr size_t WS_KSN = 40 * MiB, WS_KWN = 48 * MiB, WS_VST = 56 * MiB, WS_VWT = 64 * MiB, WS_KCN = 72 * MiB, WS_VCT = 73 * MiB;
constexpr size_t WS_GT = 76 * MiB;
constexpr size_t WS_RD = 79 * MiB + 512 * 1024;
constexpr size_t CTL_QCTR = 4096;
constexpr size_t CTL_BAR = 16384;
constexpr int XB_LDS_OFF = 147392;
constexpr size_t WS_XN = 36 * MiB;
constexpr size_t WS_QN = 100 * MiB, WS_KV = 132 * MiB, WS_ML = 180 * MiB, WS_G = 308 * MiB, WS_S = 436 * MiB;
constexpr size_t WS_YA = 440 * MiB, WS_YB = 472 * MiB;
constexpr size_t WS_MX = 180 * MiB;
constexpr size_t WS_U = 180 * MiB;
constexpr size_t WS_END = 504 * MiB;
constexpr int RING_BYTES = 131072, MISC_OFF = RING_BYTES + 320, LDS_BYTES = 147456;

#define GAS __attribute__((address_space(1)))
#define LAS __attribute__((address_space(3)))
typedef unsigned short bf16;
typedef unsigned v4u __attribute__((ext_vector_type(4)));
typedef float f32x4 __attribute__((ext_vector_type(4)));
#define LDS_WAIT() asm volatile("s_waitcnt lgkmcnt(0)" ::: "memory")
#define VM_WAIT() asm volatile("s_waitcnt vmcnt(0)" ::: "memory")
__device__ __forceinline__ unsigned f2bf(float f) { unsigned u = __builtin_bit_cast(unsigned, f); return (u + 0x7fffu + ((u >> 16) & 1u)) >> 16; }
__device__ __forceinline__ float bf2f(bf16 v) { return __uint_as_float((unsigned)v << 16); }
__device__ __forceinline__ unsigned pk2(float lo, float hi) { return f2bf(lo) | (f2bf(hi) << 16); }
__device__ __forceinline__ float wave_sum(float v) {
#pragma unroll
    for (int o = 1; o < 64; o <<= 1) v += __shfl_xor(v, o);
    return v;
}
__device__ __forceinline__ float wave_max(float v) {
#pragma unroll
    for (int o = 1; o < 64; o <<= 1) v = fmaxf(v, __shfl_xor(v, o));
    return v;
}

__device__ __forceinline__ int proj_src_col(int n) {
    if (n < 1280) return n;
    if (n < 3328) { const int q = (n - 1280) >> 9, r = (n - 1280) & 511; return (q == 0 ? 1304 : q == 1 ? 1816 : q == 2 ? 2328 : 2848) + r; }
    if (n < 5376) return 3360 + (n - 3328);
    if (n < 5400) return 1280 + (n - 5376);
    if (n < 5404) return 2840 + (n - 5400);
    if (n < 5408) return 2844 + (n - 5404);
    return -1;
}
template <bool MAP>
__device__ __forceinline__ void transpose_item(const float* W, int K, int ldw, const float* kscale, bf16* WT, int Nout, LAS float* scr, int item, int lane) {
    const int nblk = Nout / 32, kb = item / nblk, nb = item % nblk, k0 = 64 * kb, n0 = 32 * nb;
    const int n4 = (lane & 7) * 4;
    const int sc = MAP ? proj_src_col(n0 + n4) : (n0 + n4);
#pragma unroll
    for (int i = 0; i < 8; ++i) {
        const int kk = 8 * i + (lane >> 3);
        f32x4 v = {0.f, 0.f, 0.f, 0.f};
        if (sc >= 0) v = *(const GAS f32x4*)(W + (size_t)(k0 + kk) * ldw + sc);
        if (kscale) { const float g = kscale[k0 + kk]; v = v * g; }
        scr[kk * 33 + n4] = v.x; scr[kk * 33 + n4 + 1] = v.y; scr[kk * 33 + n4 + 2] = v.z; scr[kk * 33 + n4 + 3] = v.w;
    }
    LDS_WAIT(); asm volatile("" ::: "memory");
    const int c = lane & 7;
#pragma unroll
    for (int j = 0; j < 4; ++j) { const int n = (lane >> 3) + 8 * j; const LAS float* s = scr + (8 * c) * 33 + n;
        v4u o; o.x = pk2(s[0 * 33], s[1 * 33]); o.y = pk2(s[2 * 33], s[3 * 33]); o.z = pk2(s[4 * 33], s[5 * 33]); o.w = pk2(s[6 * 33], s[7 * 33]);
        *(GAS v4u*)(WT + (size_t)(n0 + n) * K + k0 + 8 * c) = o; }
    LDS_WAIT(); asm volatile("" ::: "memory");
}
__device__ __forceinline__ void rms_row_to_bf16(const float* xrow, bf16* orow, int lane) {
    const GAS f32x4* xr = (const GAS f32x4*)xrow + lane;
    f32x4 v[4]; float s = 0.f;
#pragma unroll
    for (int j = 0; j < 4; ++j) { v[j] = xr[64 * j]; s += (v[j].x * v[j].x + v[j].y * v[j].y) + (v[j].z * v[j].z + v[j].w * v[j].w); }
    const float rstd = 1.f / sqrtf(wave_sum(s) * (1.f / D_MODEL) + 1e-6f);
    GAS unsigned long long* o8 = (GAS unsigned long long*)orow + lane;
#pragma unroll
    for (int j = 0; j < 4; ++j) o8[64 * j] = (unsigned long long)pk2(v[j].x * rstd, v[j].y * rstd) | ((unsigned long long)pk2(v[j].z * rstd, v[j].w * rstd) << 32);
}

#define XB_TMO      128
#define XB_XCNT(j)  (256  + 64 * (j))
#define XB_XSUB(j)  (1280 + 64 * (j))
#define XB_XGEN(j)  (2304 + 64 * (j))
#define XB_TOP      3328
#define XB_TOPGEN   3392
#define XCD_BAR_WORDS 3456
#define XB_SPIN_CAP (1u << 18)

__device__ __forceinline__ unsigned xb_ld(unsigned* p)              { return __hip_atomic_load(p, __ATOMIC_RELAXED, __HIP_MEMORY_SCOPE_AGENT); }
__device__ __forceinline__ unsigned xb_add(unsigned* p, unsigned v) { return __hip_atomic_fetch_add(p, v, __ATOMIC_RELAXED, __HIP_MEMORY_SCOPE_AGENT); }
__device__ __forceinline__ unsigned xb_xcc_id() { return (unsigned)__builtin_amdgcn_s_getreg((3 << 11) | 20) & 0xFu; }
#define XB_SPIN(cond, bar) do { unsigned _sp = 0; while (cond) { __builtin_amdgcn_s_sleep(1); \
    if ((++_sp & 255u) == 0u) { if (xb_ld(&(bar)[XB_TMO])) break; if (_sp > XB_SPIN_CAP) { atomicAdd(&(bar)[XB_TMO], 1u); break; } } } } while (0)

struct XcdBarrier {
    unsigned* bar; unsigned x;
    volatile LAS unsigned* st;
};

__device__ __forceinline__ XcdBarrier xcd_barrier_post(unsigned* bar, volatile LAS unsigned* st) {
    XcdBarrier b; b.bar = bar; b.x = xb_xcc_id(); b.st = st;
    if (threadIdx.x == 0) (void)xb_add(&bar[XB_XCNT(b.x)], 1u);
    return b;
}
__device__ __forceinline__ void xcd_barrier_complete(unsigned* bar, unsigned x, unsigned& nloc, unsigned& nx) {
    const unsigned G = gridDim.x * gridDim.y * gridDim.z;
    unsigned sum, cnt, mine, sp = 0u;
    for (;;) {
        sum = 0u; cnt = 0u; mine = 0u;
#pragma unroll
        for (unsigned j = 0; j < 16; ++j) { const unsigned c = xb_ld(&bar[XB_XCNT(j)]); sum += c; cnt += (c > 0u) ? 1u : 0u; mine = (j == x) ? c : mine; }
        if (sum == G) break;
        __builtin_amdgcn_s_sleep(1);
        if ((++sp & 255u) == 0u) { if (xb_ld(&bar[XB_TMO])) break; if (sp > XB_SPIN_CAP) { atomicAdd(&bar[XB_TMO], 1u); break; } }
    }
    nloc = mine > 0u ? mine : 1u; nx = cnt > 0u ? cnt : 1u;
}

__device__ __forceinline__ void xcd_barrier(const XcdBarrier& b) {
    asm volatile("s_waitcnt vmcnt(0)" ::: "memory");
    __syncthreads();
    if (threadIdx.x == 0) {
        unsigned* bar = b.bar;
        __builtin_amdgcn_s_waitcnt(0);
        unsigned nloc = b.st[0], nx = b.st[1];
        if (nloc == 0u) { xcd_barrier_complete(bar, b.x, nloc, nx); b.st[0] = nloc; b.st[1] = nx; }
        const unsigned old = xb_add(&bar[XB_XSUB(b.x)], 1u);
        const unsigned gen = old / nloc;
        if (old + 1u == (gen + 1u) * nloc) {
            __builtin_amdgcn_fence(__ATOMIC_RELEASE, "agent");
            asm volatile("s_waitcnt vmcnt(0)" ::: "memory");
            const unsigned og = xb_add(&bar[XB_TOP], 1u);
            const unsigned tg = og / nx;
            if (og + 1u == (tg + 1u) * nx) xb_add(&bar[XB_TOPGEN], 1u);
            else XB_SPIN(xb_ld(&bar[XB_TOPGEN]) == tg, bar);
            __builtin_amdgcn_fence(__ATOMIC_ACQUIRE, "agent");
            xb_add(&bar[XB_XGEN(b.x)], 1u);
            asm volatile("s_waitcnt vmcnt(0)" ::: "memory");
        } else {
            XB_SPIN(xb_ld(&bar[XB_XGEN(b.x)]) == gen, bar);
            __builtin_amdgcn_fence(__ATOMIC_ACQUIRE, "agent");
            asm volatile("s_waitcnt vmcnt(0)" ::: "memory");
        }
    }
    __syncthreads();
}
typedef short bf16x8 __attribute__((ext_vector_type(8)));
typedef float f32x16 __attribute__((ext_vector_type(16)));
typedef unsigned u32x4 __attribute__((ext_vector_type(4)));
typedef unsigned u32x2 __attribute__((ext_vector_type(2)));
constexpr float LOG2E = 1.4426950408889634f;
__device__ const unsigned char BUCKET_TAB2[129] = {0, 1, 2, 3, 4, 5, 6, 7, 8, 9, 10, 11, 12, 13, 14, 15, 16, 16, 16, 17, 17, 18, 18, 18, 19, 19, 19, 20, 20, 20, 20, 21, 21, 21, 21, 22, 22, 22, 22, 22, 23, 23, 23, 23, 23, 23, 24, 24, 24, 24, 24, 24, 25, 25, 25, 25, 25, 25, 25, 26, 26, 26, 26, 26, 26, 26, 26, 27, 27, 27, 27, 27, 27, 27, 27, 27, 27, 28, 28, 28, 28, 28, 28, 28, 28, 28, 28, 29, 29, 29, 29, 29, 29, 29, 29, 29, 29, 29, 29, 30, 30, 30, 30, 30, 30, 30, 30, 30, 30, 30, 30, 30, 30, 31, 31, 31, 31, 31, 31, 31, 31, 31, 31, 31, 31, 31, 31, 31, 31};
__device__ __forceinline__ unsigned cvtpk(float lo, float hi) { typedef float f2 __attribute__((ext_vector_type(2))); typedef __bf16 b2 __attribute__((ext_vector_type(2))); f2 v = {lo, hi}; b2 b = __builtin_convertvector(v, b2); return __builtin_bit_cast(unsigned, b); }
__device__ __forceinline__ float bflo(unsigned w) { return __uint_as_float(w << 16); }
__device__ __forceinline__ float bfhi(unsigned w) { return __uint_as_float(w & 0xffff0000u); }
__device__ __forceinline__ int key_off16(int pp) { return (pp & 3) + 8 * ((pp >> 2) & 1) + 4 * (pp >> 3); }
__device__ __forceinline__ int crow(int r, int hi) { return (r & 3) + 8 * (r >> 2) + 4 * hi; }

__device__ __forceinline__ void knorm_item(const bf16* KV, int col0, const float* gain, bf16* dst, size_t tok0, int lane) {
    const int ch = lane & 7;
    float gn[8];
#pragma unroll
    for (int i = 0; i < 8; ++i) gn[i] = gain[8 * ch + i];
#pragma unroll
    for (int it = 0; it < 8; ++it) {
        const int r = 8 * it + (lane >> 3);
        const u32x4 v = *(const u32x4*)(KV + (tok0 + r) * 768 + col0 + 8 * ch);
        float f[8] = {bflo(v.x), bfhi(v.x), bflo(v.y), bfhi(v.y), bflo(v.z), bfhi(v.z), bflo(v.w), bfhi(v.w)};
        float ss = 0.f;
#pragma unroll
        for (int i = 0; i < 8; ++i) ss += f[i] * f[i];
        ss += __shfl_xor(ss, 1); ss += __shfl_xor(ss, 2); ss += __shfl_xor(ss, 4);
        const float rs = 1.f / sqrtf(ss * (1.f / 64.f) + 1e-6f);
        u32x4 o; o.x = cvtpk(f[0] * rs * gn[0], f[1] * rs * gn[1]); o.y = cvtpk(f[2] * rs * gn[2], f[3] * rs * gn[3]); o.z = cvtpk(f[4] * rs * gn[4], f[5] * rs * gn[5]); o.w = cvtpk(f[6] * rs * gn[6], f[7] * rs * gn[7]);
        *(u32x4*)(dst + (size_t)r * 64 + 8 * ch) = o;
    }
}
__device__ __forceinline__ void vtrans_item(const bf16* KV, int col0, bf16* dst, size_t tok0, LAS unsigned short* scr, int lane) {
#pragma unroll
    for (int it = 0; it < 8; ++it) {
        const int r = 8 * it + (lane >> 3), ch = lane & 7;
        const u32x4 v = *(const u32x4*)(KV + (tok0 + r) * 768 + col0 + 8 * ch);
        *(LAS u32x4*)(scr + r * 72 + 8 * ch) = v;
    }
    LDS_WAIT(); asm volatile("" ::: "memory");
    const int d = lane;
#pragma unroll
    for (int oc = 0; oc < 8; ++oc) {
        unsigned w[4];
#pragma unroll
        for (int k2 = 0; k2 < 4; ++k2) {
            const int p0 = 8 * oc + 2 * k2, p1 = p0 + 1;
            const int key0 = 16 * (p0 >> 4) + key_off16(p0 & 15), key1 = 16 * (p1 >> 4) + key_off16(p1 & 15);
            w[k2] = (unsigned)scr[key0 * 72 + d] | ((unsigned)scr[key1 * 72 + d] << 16);
        }
        u32x4 o; o.x = w[0]; o.y = w[1]; o.z = w[2]; o.w = w[3];
        *(u32x4*)(dst + (size_t)d * 64 + 8 * oc) = o;
    }
    LDS_WAIT(); asm volatile("" ::: "memory");
}
__device__ __forceinline__ void compress_unit(int unit, const bf16* KV, const bf16* W1T, const bf16* W2T, const float* b1p, const float* b2, const float* kgain0,
                                              bf16* KCN, bf16* VCT, LAS unsigned char* lds, int tid) {
    const int kv = unit & 1, tl = (unit >> 1) & 7, bg = unit >> 4, b = bg >> 1, g = bg & 1;
    const int lane = tid & 63, w = __builtin_amdgcn_readfirstlane(tid >> 6), r32 = lane & 31, hi = lane >> 5;
    const int colbase = (kv ? 128 : 0) + 64 * g;
    LAS unsigned short* hid = (LAS unsigned short*)lds;
    LAS float* outl = (LAS float*)(lds + 64 * 264 * 2);
    f32x16 acc[2]; acc[0] = f32x16{}; acc[1] = f32x16{};
    const bf16* brow = W1T + (size_t)(32 * w + r32) * 2048 + 8 * hi;
    LAS unsigned char* strip = lds + 51200;
    const bf16* kvb = KV + ((size_t)b * SEQ) * 768 + colbase;
#pragma unroll 1
    for (int rt = 0; rt < 2; ++rt) {
        const int T0 = 16 * (64 * tl + 32 * rt);
        for (int pi = tid; pi < 528 * 8; pi += 512) {
            const int tk = pi >> 3, ch = pi & 7; int tok = T0 + tk; tok = tok > SEQ - 1 ? SEQ - 1 : tok;
            *(LAS u32x4*)(strip + tk * 128 + ((ch ^ ((tk >> 4) & 7)) << 4)) = *(const u32x4*)(kvb + (size_t)tok * 768 + 8 * ch);
        }
        __syncthreads();
        f32x16 a = f32x16{};
#pragma unroll 8
        for (int s = 0; s < 128; ++s) {
            const int jj = s >> 2, ch = 2 * (s & 3) + hi, tk = 16 * r32 + jj;
            const bf16x8 bf = *(const bf16x8*)(brow + 16 * s);
            const bf16x8 af = *(const LAS bf16x8*)(strip + tk * 128 + ((ch ^ ((tk >> 4) & 7)) << 4));
            a = __builtin_amdgcn_mfma_f32_32x32x16_bf16(af, bf, a, 0, 0, 0);
        }
        if (rt == 0) acc[0] = a; else acc[1] = a;
        __syncthreads();
    }
    {
        const int col = 32 * w + r32; const float bb = b1p[col];
#pragma unroll
        for (int rt = 0; rt < 2; ++rt)
#pragma unroll
            for (int r = 0; r < 16; ++r) {
                const float x = acc[rt][r] + bb;
                const float u = 0.7978845608028654f * (x + 0.044715f * x * x * x);
                const float e = __builtin_amdgcn_exp2f(2.f * LOG2E * u);
                const float th = 1.f - 2.f * __builtin_amdgcn_rcpf(e + 1.f);
                hid[(32 * rt + crow(r, hi)) * 264 + col] = (unsigned short)(cvtpk(0.5f * x * (1.f + th), 0.f) & 0xffffu);
            }
    }
    __syncthreads();
    if (w < 4) {
        const int rt = w >> 1, ct = w & 1;
        f32x16 o = f32x16{};
        const bf16* b2row = W2T + (size_t)(32 * ct + r32) * 256 + 8 * hi;
#pragma unroll
        for (int s = 0; s < 16; ++s) {
            const bf16x8 af = *(const LAS bf16x8*)(hid + (32 * rt + r32) * 264 + 16 * s + 8 * hi);
            const bf16x8 bf = *(const bf16x8*)(b2row + 16 * s);
            o = __builtin_amdgcn_mfma_f32_32x32x16_bf16(af, bf, o, 0, 0, 0);
        }
        const float bb = b2[32 * ct + r32];
#pragma unroll
        for (int r = 0; r < 16; ++r) outl[(32 * rt + crow(r, hi)) * 65 + 32 * ct + r32] = o[r] + bb;
    }
    __syncthreads();
#pragma unroll
    for (int k = 0; k < 8; ++k) {
        const int r = 8 * w + k, n = 64 * tl + r;
        float v = outl[r * 65 + lane];
        if (kv == 0) {
            const float ss = wave_sum(v * v);
            v = v * (1.f / sqrtf(ss * (1.f / 64.f) + 1e-6f)) * kgain0[lane];
            if (n >= 511) v = 0.f;
            KCN[((size_t)bg * 512 + n) * 64 + lane] = (bf16)f2bf(v);
        } else {
            if (n >= 511) v = 0.f;
            const int pos = 16 * (r >> 4) + key_off16(r & 15);
            VCT[(((size_t)bg * 8 + tl) * 64 + lane) * 64 + pos] = (bf16)f2bf(v);
        }
    }
    __syncthreads();
}

constexpr int ENG_BUF = 0;
constexpr int ENG_LUT = 32768;
constexpr int LUTN = 256;
constexpr int ENG_EDGE = ENG_LUT + 8 * LUTN * 4;
constexpr int ENG_IMP = 45056;
constexpr int ENG_SELM = ENG_IMP + 64 * 128 * 4;
constexpr int ENG_UNION = ENG_SELM + 64 * 4 * 4;
constexpr int ENG_TLIST = ENG_UNION + 16;
constexpr int ENG_MISC = ENG_TLIST + 132 * 4;
constexpr int ENG_RING2 = ENG_MISC + 16;
constexpr int ENG_END = ENG_RING2 + 4 * 16384;

struct EngPtrs { const bf16 *QN, *KCN, *VCT, *KSN, *VST, *KWN, *VWT; const float* SB; const float* rel; const float* qgain; const float* bounds; bf16* YA; };

__device__ __forceinline__ int swz7(int row) { return ((row >> 1) ^ ((row >> 4) & 1)) & 7; }
__device__ __forceinline__ int tile_off(int row, int ch) { return row * 128 + ((ch ^ swz7(row)) << 4); }

template <int BR>
__device__ __forceinline__ void eng_branch(LAS unsigned char* lds, const bf16* Kg, const bf16* Vg, int nt, int c, int tid, int lane, int hq, int qloc, int headl,
                                           const bf16x8 (&qr)[4], float& lsum, float inv_l, f32x16 (&o)[2]) {
    const int r32 = lane & 31, hi = lane >> 5;
    const LAS float* lut = (const LAS float*)(lds + ENG_LUT) + headl * LUTN;
    const LAS float* edge = (const LAS float*)(lds + ENG_EDGE);
    LAS float* imp = (LAS float*)(lds + ENG_IMP);
    unsigned sm0 = 0u, sm1 = 0u, sm2 = 0u, sm3 = 0u;
    if (BR == 2) { const LAS unsigned* selm = (const LAS unsigned*)(lds + ENG_SELM) + qloc * 4; sm0 = selm[0]; sm1 = selm[1]; sm2 = selm[2]; sm3 = selm[3]; }
    auto tile_id = [&](int k) -> int { return BR <= 2 ? k : (c - 8 + k < 0 ? 0 : c - 8 + k); };
    const int kofs = (BR == 3) ? (c < 8 ? 8 - c : 0) : 0;
    constexpr int NST = (BR <= 1) ? 6 : 8;
    const int wv = __builtin_amdgcn_readfirstlane(tid >> 6);
    const unsigned vot = (unsigned)((((lane >> 3)) * 64 + (((lane & 7) ^ swz7(8 * wv + (lane >> 3))) << 3)) * 2) + (unsigned)wv * 1024u;
    auto stage_off = [&](int sidx) -> int {
        if (sidx < 2) return ENG_BUF + sidx * 16384;
        if (BR <= 1) return ENG_RING2 + (sidx - 2) * 16384;
        return sidx < 4 ? ENG_IMP + (sidx - 2) * 16384 : ENG_RING2 + (sidx - 4) * 16384; };
#define ENG_DMA(src, dstoff) __builtin_amdgcn_global_load_lds((const unsigned*)(src), (LAS unsigned*)(lds + (dstoff)), 16, 0, 0)
#define ENG_ISSUE(kk) do { int kq_ = (kk) < nt ? (kk) : nt - 1; const int jq_ = tile_id(kq_ + kofs); const int so_ = stage_off((kk) % NST) + wv * 1024; \
        ENG_DMA((const char*)Kg + (size_t)jq_ * 8192 + vot, so_); if (BR != 0) ENG_DMA((const char*)Vg + (size_t)jq_ * 8192 + vot, so_ + 8192); } while (0)
#define ENG_WAIT(n) asm volatile("s_waitcnt vmcnt(%0)" :: "n"(n) : "memory")
    constexpr int DPT = (BR == 0) ? 1 : 2;
    unsigned koff[4];
#pragma unroll
    for (int s = 0; s < 4; ++s) koff[s] = (unsigned)tile_off(r32, 2 * s + hi);
    auto frag8 = [&](unsigned base, bf16x8 (&f)[8]) {
        const unsigned a0 = base + koff[0], a1 = base + koff[1], a2 = base + koff[2], a3 = base + koff[3];
        asm volatile("ds_read_b128 %0, %8\n\tds_read_b128 %1, %8 offset:4096\n\tds_read_b128 %2, %9\n\tds_read_b128 %3, %9 offset:4096\n\t"
                     "ds_read_b128 %4, %10\n\tds_read_b128 %5, %10 offset:4096\n\tds_read_b128 %6, %11\n\tds_read_b128 %7, %11 offset:4096\n\ts_waitcnt lgkmcnt(0)"
                     : "=&v"(f[0]), "=&v"(f[1]), "=&v"(f[2]), "=&v"(f[3]), "=&v"(f[4]), "=&v"(f[5]), "=&v"(f[6]), "=&v"(f[7])
                     : "v"(a0), "v"(a1), "v"(a2), "v"(a3) : "memory");
    };
    auto qk_mfma = [&](int so, int j, f32x16& p0, f32x16& p1) {
        bf16x8 kf[8];
        frag8((unsigned)so, kf);
        p0 = __builtin_amdgcn_mfma_f32_32x32x16_bf16(kf[0], qr[0], f32x16{}, 0, 0, 0);
        p1 = __builtin_amdgcn_mfma_f32_32x32x16_bf16(kf[1], qr[0], f32x16{}, 0, 0, 0);
#pragma unroll
        for (int s = 1; s < 4; ++s) {
            p0 = __builtin_amdgcn_mfma_f32_32x32x16_bf16(kf[2 * s], qr[s], p0, 0, 0, 0);
            p1 = __builtin_amdgcn_mfma_f32_32x32x16_bf16(kf[2 * s + 1], qr[s], p1, 0, 0, 0);
        }
    };
    auto qk_fix = [&](int j, f32x16& p0, f32x16& p1) {
        bool near_;
        if (BR <= 1) { const int dmin = 64 * c - 16 * (64 * j + 63) - 31; near_ = dmin < 128; }
        else if (BR == 2) near_ = (j >= c - 2);
        else near_ = (j >= c - 2) || (j == c - 8);
        if (near_) {
            if (BR <= 1) {
                const int dbase = 64 * c + qloc - 16 * (64 * j + 4 * hi) - 31;
#pragma unroll
                for (int r = 0; r < 16; ++r) {
                    const int cr0 = (r & 3) + 8 * (r >> 2);
                    const int d0 = dbase - 16 * cr0, d1 = dbase - 16 * (32 + cr0);
                    int i0 = (d0 > 128 ? 128 : d0) + 64, i1 = (d1 > 128 ? 128 : d1) + 64;
                    i0 = i0 < 0 ? 0 : i0; i1 = i1 < 0 ? 0 : i1;
                    float b0 = lut[i0], b1 = lut[i1];
                    asm volatile("" : "+v"(b0), "+v"(b1));
                    p0[r] += b0; p1[r] += b1;
                }
            } else {
                const LAS float* pb = (BR == 3 && j == c - 8) ? edge + (64 + qloc - 4 * hi - 59) : lut + (64 * (c - j) + qloc - 4 * hi + 64 - 59);
#pragma unroll
                for (int r = 0; r < 16; ++r) { const int cr0 = (r & 3) + 8 * (r >> 2); p0[r] += pb[59 - cr0]; p1[r] += pb[59 - 32 - cr0]; }
            }
        }
    };
#pragma unroll
    for (int i = 0; i < NST - 1; ++i) ENG_ISSUE(i);
    f32x16 pA0, pA1, pB0, pB1;
    {
        ENG_WAIT((NST - 2) * DPT);
        __builtin_amdgcn_s_barrier(); asm volatile("" ::: "memory");
        const int j0 = tile_id(kofs);
        qk_mfma(stage_off(0), j0, pA0, pA1); qk_fix(j0, pA0, pA1);
    }
#define ENG_STEP(k, pc0, pc1, pn0, pn1) do { \
        const int j = tile_id((k) + kofs); \
          \
        unsigned selbit_ = 1u; bool dc_ = true; \
        if (BR == 2) { selbit_ = sm0 & 1u; dc_ = __builtin_amdgcn_ballot_w64(selbit_ != 0u) != 0ull; } \
          \
        ENG_WAIT((NST - 3) * DPT); \
        __builtin_amdgcn_s_barrier(); asm volatile("" ::: "memory"); \
        ENG_ISSUE((k) + NST - 1); \
        eng_step_body(k, j, pc0, pc1, pn0, pn1, dc_, selbit_); \
        if (BR == 2) { sm0 = (sm0 >> 1) | (sm1 << 31); sm1 = (sm1 >> 1) | (sm2 << 31); sm2 = (sm2 >> 1) | (sm3 << 31); sm3 >>= 1; } } while (0)
    auto eng_step_body = [&](int k, int j, f32x16& pc0, f32x16& pc1, f32x16& pn0, f32x16& pn1, const bool dopv, const unsigned selbit) {
        const int bufo = stage_off(k % NST);
        const int kn = (k + 1 < nt) ? k + 1 : nt - 1;
        const int jn = tile_id(kn + kofs);
        qk_mfma(stage_off((k + 1) % NST), jn, pn0, pn1);
        float ls = 0.f;
        u32x4 pw[4];
        {
#pragma unroll
            for (int r = 0; r < 16; ++r) { pc0[r] = __builtin_amdgcn_exp2f(pc0[r]); pc1[r] = __builtin_amdgcn_exp2f(pc1[r]); ls += pc0[r] + pc1[r]; }
            if (BR == 1) {
#pragma unroll
                for (int r = 0; r < 16; ++r) { pc0[r] *= inv_l; pc1[r] *= inv_l; }
            }
            unsigned selmask = 0xffffffffu;
            if (BR == 2) { selmask = selbit ? 0xffffffffu : 0u; ls = selbit ? ls : 0.f; }
            if (BR != 0) {
#pragma unroll
                for (int s2 = 0; s2 < 2; ++s2) {
                    pw[s2].x = cvtpk(pc0[8 * s2 + 0], pc0[8 * s2 + 1]); pw[s2].y = cvtpk(pc0[8 * s2 + 2], pc0[8 * s2 + 3]); pw[s2].z = cvtpk(pc0[8 * s2 + 4], pc0[8 * s2 + 5]); pw[s2].w = cvtpk(pc0[8 * s2 + 6], pc0[8 * s2 + 7]);
                    pw[2 + s2].x = cvtpk(pc1[8 * s2 + 0], pc1[8 * s2 + 1]); pw[2 + s2].y = cvtpk(pc1[8 * s2 + 2], pc1[8 * s2 + 3]); pw[2 + s2].z = cvtpk(pc1[8 * s2 + 4], pc1[8 * s2 + 5]); pw[2 + s2].w = cvtpk(pc1[8 * s2 + 6], pc1[8 * s2 + 7]);
                }
                if (BR == 2) {
#pragma unroll
                    for (int i = 0; i < 4; ++i) { pw[i].x &= selmask; pw[i].y &= selmask; pw[i].z &= selmask; pw[i].w &= selmask; }
                }
            }
            if (BR != 0) asm volatile("" : "+v"(pw[0]), "+v"(pw[1]), "+v"(pw[2]), "+v"(pw[3]), "+v"(ls)); else asm volatile("" : "+v"(ls));
            if (BR == 1 && c >= 16) {
                const int q = qloc;
#pragma unroll
                for (int a = 0; a < 4; ++a) {
                    float g0 = (pc0[4 * a] + pc0[4 * a + 1]) + (pc0[4 * a + 2] + pc0[4 * a + 3]), s0 = pc0[4 * a + 3];
                    float g1 = (pc1[4 * a] + pc1[4 * a + 1]) + (pc1[4 * a + 2] + pc1[4 * a + 3]), s1 = pc1[4 * a + 3];
                    g0 += __shfl_xor(g0, 1); s0 += __shfl_xor(s0, 1); g1 += __shfl_xor(g1, 1); s1 += __shfl_xor(s1, 1);
                    g0 += __shfl_xor(g0, 2); s0 += __shfl_xor(s0, 2); g1 += __shfl_xor(g1, 2); s1 += __shfl_xor(s1, 2);
                    if (hq == 0) {
                        const int jb0 = 16 * j + 2 * a + hi, jb1 = jb0 + 8;
                        imp[q * 128 + (jb0 ^ (q & 31))] += g0;
                        imp[q * 128 + (jb1 ^ (q & 31))] += g1;
                        asm volatile("" ::: "memory");
                        if (jb0 + 1 < 128) imp[q * 128 + ((jb0 + 1) ^ (q & 31))] += s0;
                        if (jb1 + 1 < 128) imp[q * 128 + ((jb1 + 1) ^ (q & 31))] += s1;
                        asm volatile("" ::: "memory");
                    }
                }
            }
            lsum += ls;
        }
        qk_fix(jn, pn0, pn1);
        if (BR != 0 && (BR != 2 || dopv)) {
            bf16x8 vf[8];
            frag8((unsigned)(bufo + 8192), vf);
#pragma unroll
            for (int ks = 0; ks < 4; ++ks) {
                const bf16x8 pf = __builtin_bit_cast(bf16x8, pw[ks]);
                o[0] = __builtin_amdgcn_mfma_f32_32x32x16_bf16(vf[2 * ks], pf, o[0], 0, 0, 0);
                o[1] = __builtin_amdgcn_mfma_f32_32x32x16_bf16(vf[2 * ks + 1], pf, o[1], 0, 0, 0);
            }
        }
    };
    int k = 0;
    for (; k + 1 < nt; k += 2) { ENG_STEP(k, pA0, pA1, pB0, pB1); ENG_STEP(k + 1, pB0, pB1, pA0, pA1); }
    if (k < nt) ENG_STEP(k, pA0, pA1, pB0, pB1);
#undef ENG_STEP
#undef ENG_WAIT
    asm volatile("s_waitcnt vmcnt(0)" ::: "memory");
    __syncthreads();
#undef ENG_ISSUE
#undef ENG_DMA
}

__device__ __forceinline__ void eng_tables(const float* rel, LAS unsigned char* lds, int tid) {
    LAS float* lutw = (LAS float*)(lds + ENG_LUT);
    for (int i = tid; i < 8 * LUTN; i += 512) {
        const int hd = i >> 8, dist = (i & 255) - 64;
        float v = -INFINITY;
        if (dist >= 0) { const int bk = dist >= 128 ? 31 : (int)BUCKET_TAB2[dist]; v = (rel[bk * 8 + hd] - rel[31 * 8 + hd]) * LOG2E; }
        lutw[i] = v;
    }
    if (tid < 128) ((LAS float*)(lds + ENG_EDGE))[tid] = (tid + 448 < 512) ? 0.f : -INFINITY;
}
__device__ __forceinline__ void eng_unit(int unit, const EngPtrs& P, LAS unsigned char* lds, int tid) {
    const int c = 127 - (unit >> 3), bg = unit & 7, b = bg >> 1, g = bg & 1;
    const int lane = tid & 63, w = __builtin_amdgcn_readfirstlane(tid >> 6), r32 = lane & 31, hi = lane >> 5;
    const int hq = r32 & 3, qloc = 8 * w + (r32 >> 2);
    const int head = 4 * g + hq;
    const int t = 64 * c + qloc;
    const size_t row = (size_t)b * SEQ + t;
    LAS float* imp = (LAS float*)(lds + ENG_IMP);
    LAS unsigned* selm = (LAS unsigned*)(lds + ENG_SELM);
    LAS unsigned* uni = (LAS unsigned*)(lds + ENG_UNION);
    LAS int* tlist = (LAS int*)(lds + ENG_TLIST);
    LAS int* misc = (LAS int*)(lds + ENG_MISC);
    if (c >= 16) for (int i = tid; i < 64 * 128; i += 512) imp[i] = 0.f;
    if (tid < 4) uni[tid] = 0u;
    bf16x8 qr[4];
    {
        const bf16* qp = P.QN + row * 512 + head * 64 + 8 * hi;
        u32x4 raw[4]; float ss = 0.f;
#pragma unroll
        for (int s = 0; s < 4; ++s) { raw[s] = *(const u32x4*)(qp + 16 * s);
            const float f[8] = {bflo(raw[s].x), bfhi(raw[s].x), bflo(raw[s].y), bfhi(raw[s].y), bflo(raw[s].z), bfhi(raw[s].z), bflo(raw[s].w), bfhi(raw[s].w)};
#pragma unroll
            for (int i = 0; i < 8; ++i) ss += f[i] * f[i]; }
        ss += __shfl_xor(ss, 32);
        const float rs = (1.f / sqrtf(ss * (1.f / 64.f) + 1e-6f)) * 0.125f * LOG2E;
#pragma unroll
        for (int s = 0; s < 4; ++s) {
            const float* gp = P.qgain + 16 * s + 8 * hi;
            u32x4 o4;
            o4.x = cvtpk(bflo(raw[s].x) * rs * gp[0], bfhi(raw[s].x) * rs * gp[1]); o4.y = cvtpk(bflo(raw[s].y) * rs * gp[2], bfhi(raw[s].y) * rs * gp[3]);
            o4.z = cvtpk(bflo(raw[s].z) * rs * gp[4], bfhi(raw[s].z) * rs * gp[5]); o4.w = cvtpk(bflo(raw[s].w) * rs * gp[6], bfhi(raw[s].w) * rs * gp[7]);
            qr[s] = __builtin_bit_cast(bf16x8, o4);
        }
    }
    const float* gl = P.SB + row * 32 + head * 3;
    const float gate0 = 1.f / (1.f + __expf(-gl[0])), gate1 = 1.f / (1.f + __expf(-gl[1])), gate2 = 1.f / (1.f + __expf(-gl[2]));
    bf16* const yp = P.YA + row * 512 + head * 64 + 4 * hi;
    __syncthreads();
    {
        const int nvmax = (4 * c + 3 > 511) ? 511 : 4 * c + 3;
        const int ntc = (nvmax + 63) >> 6;
        const bf16* Kg = P.KCN + (size_t)bg * 512 * 64; const bf16* Vg = P.VCT + (size_t)bg * 8 * 4096;
        float l1 = 0.f; f32x16 od[2]; od[0] = f32x16{}; od[1] = f32x16{};
        eng_branch<0>(lds, Kg, Vg, ntc, c, tid, lane, hq, qloc, head, qr, l1, 0.f, od);
        l1 += __shfl_xor(l1, 32);
        const float inv = l1 > 0.f ? 1.f / l1 : 0.f;
        float l2 = 0.f;
        eng_branch<1>(lds, Kg, Vg, ntc, c, tid, lane, hq, qloc, head, qr, l2, inv, od);
#pragma unroll
        for (int dh = 0; dh < 2; ++dh)
#pragma unroll
            for (int a = 0; a < 4; ++a) { u32x2 v; v.x = cvtpk(gate0 * od[dh][4 * a], gate0 * od[dh][4 * a + 1]); v.y = cvtpk(gate0 * od[dh][4 * a + 2], gate0 * od[dh][4 * a + 3]); *(u32x2*)(yp + 32 * dh + 8 * a) = v; }
    }
    {
        const int q = tid >> 3, part = tid & 7;
        unsigned m16 = 0u;
        if (c >= 16) {
            unsigned key[16];
#pragma unroll
            for (int jj = 0; jj < 16; ++jj) { const int j = part * 16 + jj; key[jj] = (j >= 1 && j <= c - 2) ? (__float_as_uint(imp[q * 128 + (j ^ (q & 31))]) + 1u) : 0u; }
            unsigned T = 0u;
            for (int bit = 31; bit >= 0; --bit) {
                const unsigned cand = T | (1u << bit);
                int cnt = 0;
#pragma unroll
                for (int jj = 0; jj < 16; ++jj) cnt += key[jj] >= cand ? 1 : 0;
                cnt += __shfl_xor(cnt, 1); cnt += __shfl_xor(cnt, 2); cnt += __shfl_xor(cnt, 4);
                if (cnt >= 13) T = cand;
            }
            int gt = 0, eq = 0;
#pragma unroll
            for (int jj = 0; jj < 16; ++jj) { gt += key[jj] > T ? 1 : 0; eq += key[jj] == T ? 1 : 0; }
            int gtot = gt; gtot += __shfl_xor(gtot, 1); gtot += __shfl_xor(gtot, 2); gtot += __shfl_xor(gtot, 4);
            int pre = 0;
#pragma unroll
            for (int pp = 0; pp < 8; ++pp) { const int e = __shfl(eq, (lane & ~7) + pp); if (pp < part) pre += e; }
            int quota = 13 - gtot - pre; quota = quota < 0 ? 0 : quota;
#pragma unroll
            for (int jj = 0; jj < 16; ++jj) {
                bool s = key[jj] > T;
                if (key[jj] == T && T != 0u) { if (quota > 0) { s = true; --quota; } }
                m16 |= s ? (1u << jj) : 0u;
            }
        }
        unsigned wd = m16 << (16 * (part & 1));
        wd |= __shfl_xor(wd, 1);
        const int wi = part >> 1;
        if (c >= 16) {
            if (wi == 0) wd |= 1u;
            if (((c - 1) >> 5) == wi) wd |= 1u << ((c - 1) & 31);
            if ((c >> 5) == wi) wd |= 1u << (c & 31);
        } else {
            wd = (wi == 0) ? ((c >= 31) ? 0xffffffffu : ((2u << c) - 1u)) : 0u;
        }
        if ((part & 1) == 0) selm[q * 4 + wi] = wd;
    }
    __syncthreads();
    {
        const int nts = c + 1;
        float l = 0.f; f32x16 od[2]; od[0] = f32x16{}; od[1] = f32x16{};
        eng_branch<2>(lds, P.KSN + (size_t)bg * SEQ * 64, P.VST + (size_t)bg * 128 * 4096, nts, c, tid, lane, hq, qloc, head, qr, l, 0.f, od);
        l += __shfl_xor(l, 32);
        const float sc = gate1 / l;
#pragma unroll
        for (int dh = 0; dh < 2; ++dh)
#pragma unroll
            for (int a = 0; a < 4; ++a) { const u32x2 y = *(const u32x2*)(yp + 32 * dh + 8 * a);
                u32x2 v; v.x = cvtpk(bflo(y.x) + sc * od[dh][4 * a], bfhi(y.x) + sc * od[dh][4 * a + 1]); v.y = cvtpk(bflo(y.y) + sc * od[dh][4 * a + 2], bfhi(y.y) + sc * od[dh][4 * a + 3]); *(u32x2*)(yp + 32 * dh + 8 * a) = v; }
    }
    {
        const int ntw = c < 8 ? c + 1 : 9;
        float l = 0.f; f32x16 od[2]; od[0] = f32x16{}; od[1] = f32x16{};
        eng_branch<3>(lds, P.KWN + (size_t)bg * SEQ * 64, P.VWT + (size_t)bg * 128 * 4096, ntw, c, tid, lane, hq, qloc, head, qr, l, 0.f, od);
        l += __shfl_xor(l, 32);
        const float sc = gate2 / l;
#pragma unroll
        for (int dh = 0; dh < 2; ++dh)
#pragma unroll
            for (int a = 0; a < 4; ++a) { const u32x2 y = *(const u32x2*)(yp + 32 * dh + 8 * a);
                u32x2 v; v.x = cvtpk(bflo(y.x) + sc * od[dh][4 * a], bfhi(y.x) + sc * od[dh][4 * a + 1]); v.y = cvtpk(bflo(y.y) + sc * od[dh][4 * a + 2], bfhi(y.y) + sc * od[dh][4 * a + 3]); *(u32x2*)(yp + 32 * dh + 8 * a) = v; }
    }
}
__device__ __forceinline__ int pos16(int k) { return 16 * (k >> 4) + key_off16(k & 15); }
__device__ __forceinline__ float fsilu(float a) { return a / (1.f + __expf(-a)); }

constexpr int MLP_ROWB = 272;
constexpr int MLP_QIN = 0, MLP_KIN = 67 * MLP_ROWB, MLP_VIN = 2 * 67 * MLP_ROWB, MLP_QOUT = MLP_VIN + 64 * MLP_ROWB, MLP_KOUT = MLP_QOUT + 64 * MLP_ROWB, MLP_END = MLP_KOUT + 64 * MLP_ROWB;
__device__ __forceinline__ void ml_prep_unit(int unit, const bf16* ML, const float* cw, const float* cb, bf16* QC, bf16* KC, bf16* KT, bf16* VT, LAS unsigned char* lds, int tid) {
    const int bh = unit >> 7, chunk = unit & 127, b = bh >> 2, h = bh & 3;
    const int t0 = 64 * chunk;
    const size_t rowb = (size_t)b * SEQ;
    for (int pi = tid; pi < 67 * 16; pi += 512) {
        const int r = pi >> 4, ch = pi & 15, t = t0 - 3 + r;
        u32x4 qv = {0u, 0u, 0u, 0u}, kv = {0u, 0u, 0u, 0u};
        if (t >= 0) { const bf16* rp = ML + (rowb + t) * 2048 + h * 128 + 8 * ch; qv = *(const u32x4*)rp; kv = *(const u32x4*)(rp + 512); }
        *(LAS u32x4*)(lds + MLP_QIN + r * MLP_ROWB + 16 * ch) = qv; *(LAS u32x4*)(lds + MLP_KIN + r * MLP_ROWB + 16 * ch) = kv;
    }
    for (int pi = tid; pi < 64 * 16; pi += 512) {
        const int r = pi >> 4, ch = pi & 15;
        *(LAS u32x4*)(lds + MLP_VIN + r * MLP_ROWB + 16 * ch) = *(const u32x4*)(ML + (rowb + t0 + r) * 2048 + 1024 + h * 128 + 8 * ch);
    }
    __syncthreads();
    {
        const int ch = tid & 127, seg = tid >> 7;
#pragma unroll
        for (int which = 0; which < 2; ++which) {
            const int gc = which * 512 + h * 128 + ch;
            const float w0 = cw[gc], w1 = cw[1024 + gc], w2 = cw[2048 + gc], w3 = cw[3072 + gc], bias = cb[gc];
            const float sc = which == 0 ? 0.08838834764831845f : 1.f;
            const LAS unsigned short* in = (const LAS unsigned short*)(lds + (which ? MLP_KIN : MLP_QIN)) + ch;
            LAS unsigned short* out = (LAS unsigned short*)(lds + (which ? MLP_KOUT : MLP_QOUT)) + ch;
            float x0 = bf2f(in[(16 * seg + 0) * (MLP_ROWB / 2)]), x1 = bf2f(in[(16 * seg + 1) * (MLP_ROWB / 2)]), x2 = bf2f(in[(16 * seg + 2) * (MLP_ROWB / 2)]);
#pragma unroll
            for (int r = 0; r < 16; ++r) {
                const float x3 = bf2f(in[(16 * seg + r + 3) * (MLP_ROWB / 2)]);
                const float a = bias + x0 * w0 + x1 * w1 + x2 * w2 + x3 * w3;
                out[(16 * seg + r) * (MLP_ROWB / 2)] = (unsigned short)f2bf(fsilu(a) * sc);
                x0 = x1; x1 = x2; x2 = x3;
            }
        }
    }
    __syncthreads();
    const size_t cbase = ((size_t)bh * 128 + chunk) * 8192;
    for (int pi = tid; pi < 1024; pi += 512) {
        {
            const int r = pi >> 4, pc = pi & 15;
            const LAS unsigned short* qo = (const LAS unsigned short*)(lds + MLP_QOUT + r * MLP_ROWB);
            const LAS unsigned short* ko = (const LAS unsigned short*)(lds + MLP_KOUT + r * MLP_ROWB);
            unsigned qw[4], kw[4];
#pragma unroll
            for (int k2 = 0; k2 < 4; ++k2) { const int d0 = pos16(8 * pc + 2 * k2), d1 = pos16(8 * pc + 2 * k2 + 1); qw[k2] = (unsigned)qo[d0] | ((unsigned)qo[d1] << 16); kw[k2] = (unsigned)ko[d0] | ((unsigned)ko[d1] << 16); }
            u32x4 qv; qv.x = qw[0]; qv.y = qw[1]; qv.z = qw[2]; qv.w = qw[3];
            u32x4 kv; kv.x = kw[0]; kv.y = kw[1]; kv.z = kw[2]; kv.w = kw[3];
            *(u32x4*)(QC + cbase + (size_t)r * 128 + 8 * pc) = qv; *(u32x4*)(KC + cbase + (size_t)r * 128 + 8 * pc) = kv;
        }
        {
            const int d = pi >> 3, tc = pi & 7;
            const LAS unsigned short* ko = (const LAS unsigned short*)(lds + MLP_KOUT) + d;
            const LAS unsigned short* vo = (const LAS unsigned short*)(lds + MLP_VIN) + d;
            unsigned kw[4], vw[4];
#pragma unroll
            for (int k2 = 0; k2 < 4; ++k2) { const int r0 = pos16(8 * tc + 2 * k2), r1 = pos16(8 * tc + 2 * k2 + 1);
                kw[k2] = (unsigned)ko[r0 * (MLP_ROWB / 2)] | ((unsigned)ko[r1 * (MLP_ROWB / 2)] << 16); vw[k2] = (unsigned)vo[r0 * (MLP_ROWB / 2)] | ((unsigned)vo[r1 * (MLP_ROWB / 2)] << 16); }
            u32x4 kv; kv.x = kw[0]; kv.y = kw[1]; kv.z = kw[2]; kv.w = kw[3];
            u32x4 vv; vv.x = vw[0]; vv.y = vw[1]; vv.z = vw[2]; vv.w = vw[3];
            *(u32x4*)(KT + cbase + (size_t)d * 64 + 8 * tc) = kv; *(u32x4*)(VT + cbase + (size_t)d * 64 + 8 * tc) = vv;
        }
    }
    __syncthreads();
}
__device__ __forceinline__ void ml_gates_unit(int bh, const float* SB, const float* ibias, const float* fbias, float* GT, LAS unsigned char* lds, int tid) {
    const int b = bh >> 2, h = bh & 3;
    LAS float* gs = (LAS float*)lds; LAS float* am = gs + 128; LAS float* mpv = gs + 256;
    const float fb = fbias[h], ib = ibias[h];
    const int c = tid;
    const float* sp = SB + ((size_t)b * SEQ + 64 * c) * 32;
    float g = 0.f, amax = -INFINITY;
    if (tid < 128) {
        for (int i0 = 0; i0 < 64; i0 += 16) {
            float fv[16], iv[16];
#pragma unroll
            for (int k = 0; k < 16; ++k) { fv[k] = sp[(i0 + k) * 32 + 28 + h]; iv[k] = sp[(i0 + k) * 32 + 24 + h]; }
#pragma unroll
            for (int k = 0; k < 16; ++k) { const float f = fv[k] + fb; const float lf = fminf(f, 0.f) - log1pf(__expf(-fabsf(f))); g += lf; amax = fmaxf(amax, iv[k] + ib - g); }
        }
        gs[c] = g; am[c] = amax;
    }
    __syncthreads();
    if (tid == 0) { float m = 0.f; for (int k = 0; k < 128; ++k) { mpv[k] = m; m = gs[k] + fmaxf(m, am[k]); } }
    __syncthreads();
    if (tid < 128) {
        const float mp = mpv[c], mx = fmaxf(mp, amax);
        float* gt = GT + ((size_t)bh * 128 + c) * 384;
        float bc = 0.f, runmax = -INFINITY;
        for (int i0 = 0; i0 < 64; i0 += 16) {
            float fv[16], iv[16];
#pragma unroll
            for (int k = 0; k < 16; ++k) { fv[k] = sp[(i0 + k) * 32 + 28 + h]; iv[k] = sp[(i0 + k) * 32 + 24 + h]; }
#pragma unroll
            for (int k = 0; k < 16; ++k) {
                const int i = i0 + k;
                const float f = fv[k] + fb; const float lf = fminf(f, 0.f) - log1pf(__expf(-fabsf(f))); bc += lf;
                const float d = iv[k] + ib - bc;
                runmax = fmaxf(runmax, d);
                const float ei = -fmaxf(mp, runmax);
                gt[0 * 64 + i] = ei * LOG2E; gt[1 * 64 + i] = d * LOG2E; gt[2 * 64 + i] = __expf(mp + ei); gt[3 * 64 + i] = __expf(-bc + ei);
                gt[4 * 64 + pos16(i)] = __expf(d - mx);
            }
        }
        gt[5 * 64] = __expf(mp - mx);
    }
    __syncthreads();
}

constexpr int CH_Q = 0, CH_K = 16384, CH_KT = 32768, CH_VT = 49152, CH_TAB = 65536, CH_BUFSZ = 67584;
constexpr int CH_NP = 2 * CH_BUFSZ, CH_WB = CH_NP + 512, CH_DP = CH_WB + 6144, CH_RD = CH_DP + 768, CH_END = CH_RD + 512;
__device__ __forceinline__ int ct_off(int row, int ch) { return row * 128 + ((ch ^ (row & 7)) << 4); }
__device__ __forceinline__ int qk_off(int row, int ch) { return row * 256 + ((ch ^ (row & 15)) << 4); }
__device__ __forceinline__ bf16x8 pack8r(const f32x16& x, int s2) { u32x4 p; p.x = cvtpk(x[8 * s2 + 0], x[8 * s2 + 1]); p.y = cvtpk(x[8 * s2 + 2], x[8 * s2 + 3]); p.z = cvtpk(x[8 * s2 + 4], x[8 * s2 + 5]); p.w = cvtpk(x[8 * s2 + 6], x[8 * s2 + 7]); return __builtin_bit_cast(bf16x8, p); }

template <int OFF2>
__device__ __forceinline__ void lds_read8(unsigned a0, unsigned a1, unsigned a2, unsigned a3, bf16x8 (&f)[8]) {
    asm volatile("ds_read_b128 %0, %8\n\tds_read_b128 %1, %8 offset:%c12\n\tds_read_b128 %2, %9\n\tds_read_b128 %3, %9 offset:%c12\n\t"
                 "ds_read_b128 %4, %10\n\tds_read_b128 %5, %10 offset:%c12\n\tds_read_b128 %6, %11\n\tds_read_b128 %7, %11 offset:%c12\n\ts_waitcnt lgkmcnt(0)"
                 : "=&v"(f[0]), "=&v"(f[1]), "=&v"(f[2]), "=&v"(f[3]), "=&v"(f[4]), "=&v"(f[5]), "=&v"(f[6]), "=&v"(f[7])
                 : "v"(a0), "v"(a1), "v"(a2), "v"(a3), "i"(OFF2) : "memory");
}
struct ChainPtrs { const bf16 *QC, *KC, *KT, *VT; const float* GT; const bf16* ML; bf16* YB; float* RD; };

__device__ __forceinline__ void ml_chain(int bh, const ChainPtrs& P, LAS unsigned char* lds, int tid) {
    const int lane_ = tid & 63, w = __builtin_amdgcn_readfirstlane(tid >> 6);
    const int b = bh >> 2, h = bh & 3;
    const bool slicew = w < 5;
    f32x16 C[4]; C[0] = f32x16{}; C[1] = f32x16{}; C[2] = f32x16{}; C[3] = f32x16{};
    const bf16* q0 = P.QC + (size_t)bh * 128 * 8192; const bf16* k0 = P.KC + (size_t)bh * 128 * 8192;
    const bf16* kt0 = P.KT + (size_t)bh * 128 * 8192; const bf16* vt0 = P.VT + (size_t)bh * 128 * 8192;
    const float* gt0 = P.GT + (size_t)bh * 128 * 384;
    const int wl = w - 4;
#define CH_DMA(src, dstoff) __builtin_amdgcn_global_load_lds((const unsigned*)(src), (LAS unsigned*)(lds + (dstoff)), 16, 0, 0)
#define CH_LOAD(cc, par) do { if (w >= 4) { const int bo_ = (par) * CH_BUFSZ; \
        const unsigned voq = (unsigned)(((4 * wl + (lane >> 4)) * 128 + (((lane & 15) ^ ((4 * wl + (lane >> 4)) & 15)) << 3)) * 2); \
        const unsigned vot = (unsigned)((((lane >> 3)) * 64 + (((lane & 7) ^ (lane >> 3)) << 3)) * 2); \
        const char* qb_ = (const char*)q0 + (size_t)(cc) * 16384; const char* kb_ = (const char*)k0 + (size_t)(cc) * 16384; \
        const char* tb_ = (const char*)kt0 + (size_t)(cc) * 16384 + wl * 4096; const char* vb_ = (const char*)vt0 + (size_t)(cc) * 16384 + wl * 4096; \
        _Pragma("unroll") for (int k = 0; k < 4; ++k) { \
            CH_DMA(qb_ + k * 4096 + voq, bo_ + CH_Q + (wl + 4 * k) * 1024); CH_DMA(kb_ + k * 4096 + voq, bo_ + CH_K + (wl + 4 * k) * 1024); \
            CH_DMA(tb_ + k * 1024 + vot, bo_ + CH_KT + (wl * 4 + k) * 1024); CH_DMA(vb_ + k * 1024 + vot, bo_ + CH_VT + (wl * 4 + k) * 1024); } \
        if (wl == 0) { CH_DMA(gt0 + (size_t)(cc) * 384 + lane * 4, bo_ + CH_TAB); if (lane < 32) CH_DMA(gt0 + (size_t)(cc) * 384 + 256 + lane * 4, bo_ + CH_TAB + 1024); } } } while (0)
#define CH_STOREOUT(cc, par) do { if (w >= 4) { \
        u32x4 y_[4]; \
        _Pragma("unroll") for (int n = 0; n < 4; ++n) { const int row = 16 * n + 4 * wl + (lane >> 4), ch = lane & 15; y_[n] = *(const LAS u32x4*)(lds + (par) * CH_BUFSZ + CH_Q + row * 256 + ((ch ^ (row & 15)) << 4)); } \
        asm volatile("s_waitcnt lgkmcnt(0)" : "+v"(y_[0]), "+v"(y_[1]), "+v"(y_[2]), "+v"(y_[3]) :: "memory"); \
        _Pragma("unroll") for (int n = 0; n < 4; ++n) { const int row = 16 * n + 4 * wl + (lane >> 4), ch = lane & 15; \
            *(u32x4*)(P.YB + ((size_t)b * SEQ + 64 * (cc) + row) * 512 + 128 * h + 8 * ch) = y_[n]; } } } while (0)
    { const int lane = lane_; CH_LOAD(0, 0); }
    __syncthreads();
    for (int c = 0; c < 128; ++c) {
        const int par = c & 1;
        int oz; asm volatile("v_mov_b32 %0, 0" : "=v"(oz));
        const int lane = lane_ + oz, r32 = lane & 31, hi = lane >> 5;
        LAS unsigned char* bufp = lds + par * CH_BUFSZ;
        LAS float* tab = (LAS float*)(bufp + CH_TAB);
        if (c >= 1) CH_STOREOUT(c - 1, par ^ 1);
        if (c + 1 < 128) CH_LOAD(c + 1, par ^ 1);
        f32x16 acc[2]; acc[0] = f32x16{}; acc[1] = f32x16{};
        if (slicew) {
            const unsigned qb_ = (unsigned)(par * CH_BUFSZ + CH_Q);
#pragma unroll
            for (int hb = 0; hb < 2; ++hb) {
                bf16x8 qf[8];
                lds_read8<8192>(qb_ + qk_off(r32, 2 * (4 * hb + 0) + hi), qb_ + qk_off(r32, 2 * (4 * hb + 1) + hi), qb_ + qk_off(r32, 2 * (4 * hb + 2) + hi), qb_ + qk_off(r32, 2 * (4 * hb + 3) + hi), qf);
#pragma unroll
                for (int i = 0; i < 4; ++i) {
                    const int s = 4 * hb + i;
                    const bf16x8 cf = pack8r(C[s >> 1], s & 1);
                    acc[0] = __builtin_amdgcn_mfma_f32_32x32x16_bf16(cf, qf[2 * i], acc[0], 0, 0, 0);
                    acc[1] = __builtin_amdgcn_mfma_f32_32x32x16_bf16(cf, qf[2 * i + 1], acc[1], 0, 0, 0);
                }
            }
            const float sc0 = tab[2 * 64 + r32], sc1 = tab[2 * 64 + 32 + r32];
#pragma unroll
            for (int r = 0; r < 16; ++r) { acc[0][r] *= sc0; acc[1][r] *= sc1; }
        } else {
            const int jh = (w == 7) ? 1 : 0, ih = (w == 5) ? 0 : 1;
            f32x16 S = f32x16{};
            const unsigned kb2 = (unsigned)(par * CH_BUFSZ + CH_K + 8192 * jh), qb2 = (unsigned)(par * CH_BUFSZ + CH_Q + 8192 * ih);
#pragma unroll
            for (int hb = 0; hb < 2; ++hb) {
                bf16x8 kf8[8], qf8[8];
                lds_read8<0>(kb2 + qk_off(r32, 2 * (4 * hb + 0) + hi), kb2 + qk_off(r32, 2 * (4 * hb + 1) + hi), kb2 + qk_off(r32, 2 * (4 * hb + 2) + hi), kb2 + qk_off(r32, 2 * (4 * hb + 3) + hi), kf8);
                lds_read8<0>(qb2 + qk_off(r32, 2 * (4 * hb + 0) + hi), qb2 + qk_off(r32, 2 * (4 * hb + 1) + hi), qb2 + qk_off(r32, 2 * (4 * hb + 2) + hi), qb2 + qk_off(r32, 2 * (4 * hb + 3) + hi), qf8);
#pragma unroll
                for (int i = 0; i < 4; ++i) S = __builtin_amdgcn_mfma_f32_32x32x16_bf16(kf8[2 * i], qf8[2 * i], S, 0, 0, 0);
            }
            const float ei = tab[32 * ih + r32];
            const bool diag = (jh == ih);
#pragma unroll
            for (int a = 0; a < 4; ++a) {
                const f32x4 d = *(const LAS f32x4*)(tab + 64 + 32 * jh + 8 * a + 4 * hi);
#pragma unroll
                for (int i = 0; i < 4; ++i) {
                    const int r = 4 * a + i, jl = 8 * a + 4 * hi + i;
                    float wv = S[r] * __builtin_amdgcn_exp2f(ei + d[i]);
                    if (diag && jl > r32) wv = 0.f;
                    S[r] = wv;
                }
            }
            const int tix = w - 5;
            *(LAS bf16x8*)(lds + CH_WB + (tix * 2 + 0) * 1024 + lane * 16) = pack8r(S, 0);
            *(LAS bf16x8*)(lds + CH_WB + (tix * 2 + 1) * 1024 + lane * 16) = pack8r(S, 1);
        }
        asm volatile("s_waitcnt lgkmcnt(0)" ::: "memory"); __builtin_amdgcn_s_barrier(); asm volatile("" ::: "memory");
        if (slicew) {
            const int sl = w;
            const float decay = tab[5 * 64];
#pragma unroll
            for (int t4 = 0; t4 < 4; ++t4)
#pragma unroll
                for (int r = 0; r < 16; ++r) C[t4][r] *= decay;
            const unsigned vb_ = (unsigned)(par * CH_BUFSZ + CH_VT), tb_ = (unsigned)(par * CH_BUFSZ + CH_KT), wb_ = (unsigned)CH_WB + lane * 16;
            bf16x8 vfr[4], wpk[6];
            {
                const int vrow = sl < 4 ? 32 * sl + r32 : r32;
                bf16x8 t8[8];
                lds_read8<1024>(wb_ + 0 * 2048, wb_ + 1 * 2048, wb_ + 2 * 2048, vb_ + ct_off(vrow, hi), t8);
                wpk[0] = t8[0]; wpk[1] = t8[1]; wpk[2] = t8[2]; wpk[3] = t8[3]; wpk[4] = t8[4]; wpk[5] = t8[5]; vfr[0] = t8[6];
                bf16x8 u8[8];
                lds_read8<0>(vb_ + ct_off(vrow, 2 + hi), vb_ + ct_off(vrow, 4 + hi), vb_ + ct_off(vrow, 6 + hi), vb_ + ct_off(vrow, 6 + hi), u8);
                vfr[1] = u8[0]; vfr[2] = u8[2]; vfr[3] = u8[4];
                if (sl == 4) { const short one = (r32 == 0) ? (short)0x3F80 : (short)0; const bf16x8 o8 = {one, one, one, one, one, one, one, one}; vfr[0] = o8; vfr[1] = o8; vfr[2] = o8; vfr[3] = o8; }
            }
            bf16x8 svf[4];
#pragma unroll
            for (int ks = 0; ks < 4; ++ks) {
                const bf16x8 vf = vfr[ks];
                if (ks < 2) { acc[0] = __builtin_amdgcn_mfma_f32_32x32x16_bf16(vf, wpk[0 * 2 + ks], acc[0], 0, 0, 0);
                              acc[1] = __builtin_amdgcn_mfma_f32_32x32x16_bf16(vf, wpk[1 * 2 + ks], acc[1], 0, 0, 0); }
                else acc[1] = __builtin_amdgcn_mfma_f32_32x32x16_bf16(vf, wpk[2 * 2 + (ks - 2)], acc[1], 0, 0, 0);
                const f32x4 sa = *(const LAS f32x4*)(tab + 4 * 64 + 16 * ks + 8 * hi), sb = *(const LAS f32x4*)(tab + 4 * 64 + 16 * ks + 8 * hi + 4);
                const u32x4 vx = __builtin_bit_cast(u32x4, vf);
                u32x4 sv; sv.x = cvtpk(bflo(vx.x) * sa[0], bfhi(vx.x) * sa[1]); sv.y = cvtpk(bflo(vx.y) * sa[2], bfhi(vx.y) * sa[3]);
                sv.z = cvtpk(bflo(vx.z) * sb[0], bfhi(vx.z) * sb[1]); sv.w = cvtpk(bflo(vx.w) * sb[2], bfhi(vx.w) * sb[3]);
                svf[ks] = __builtin_bit_cast(bf16x8, sv);
            }
#pragma unroll
            for (int kp = 0; kp < 2; ++kp) {
                bf16x8 kt8[8];
                lds_read8<4096>(tb_ + ct_off(r32, 2 * (2 * kp) + hi), tb_ + ct_off(64 + r32, 2 * (2 * kp) + hi), tb_ + ct_off(r32, 2 * (2 * kp + 1) + hi), tb_ + ct_off(64 + r32, 2 * (2 * kp + 1) + hi), kt8);
                C[0] = __builtin_amdgcn_mfma_f32_32x32x16_bf16(kt8[0], svf[2 * kp], C[0], 0, 0, 0);
                C[1] = __builtin_amdgcn_mfma_f32_32x32x16_bf16(kt8[1], svf[2 * kp], C[1], 0, 0, 0);
                C[2] = __builtin_amdgcn_mfma_f32_32x32x16_bf16(kt8[2], svf[2 * kp], C[2], 0, 0, 0);
                C[3] = __builtin_amdgcn_mfma_f32_32x32x16_bf16(kt8[3], svf[2 * kp], C[3], 0, 0, 0);
                C[0] = __builtin_amdgcn_mfma_f32_32x32x16_bf16(kt8[4], svf[2 * kp + 1], C[0], 0, 0, 0);
                C[1] = __builtin_amdgcn_mfma_f32_32x32x16_bf16(kt8[5], svf[2 * kp + 1], C[1], 0, 0, 0);
                C[2] = __builtin_amdgcn_mfma_f32_32x32x16_bf16(kt8[6], svf[2 * kp + 1], C[2], 0, 0, 0);
                C[3] = __builtin_amdgcn_mfma_f32_32x32x16_bf16(kt8[7], svf[2 * kp + 1], C[3], 0, 0, 0);
            }
            if (sl < 4) {
#pragma unroll
                for (int ih = 0; ih < 2; ++ih) {
                    const int i = 32 * ih + r32;
#pragma unroll
                    for (int a = 0; a < 4; ++a) {
                        u32x2 yv; yv.x = cvtpk(acc[ih][4 * a], acc[ih][4 * a + 1]); yv.y = cvtpk(acc[ih][4 * a + 2], acc[ih][4 * a + 3]);
                        *(LAS u32x2*)(bufp + CH_Q + i * 256 + (((4 * sl + a) ^ (i & 15)) << 4) + 8 * hi) = yv;
                    }
                }
            } else if (hi == 0) {
                const float d0 = acc[0][0], d1 = acc[1][0];
                float* rp = P.RD + ((size_t)b * SEQ + 64 * c) * 4 + h;
                rp[(size_t)r32 * 4] = 1.f / fmaxf(fabsf(d0), tab[3 * 64 + r32]);
                rp[(size_t)(32 + r32) * 4] = 1.f / fmaxf(fabsf(d1), tab[3 * 64 + 32 + r32]);
            }
        }
        __syncthreads();
    }
    { const int lane = lane_; CH_STOREOUT(127, 1); }
    __syncthreads();
#undef CH_LOAD
#undef CH_DMA
#undef CH_STOREOUT
}
struct Args { const float* in[26]; float* out; unsigned char* ws; int ph_lo, ph_hi; };

__global__ void __launch_bounds__(NWAVES * 64, 2) mk_fwd(Args args) {
    extern __shared__ __attribute__((aligned(16))) unsigned char lds_raw[];
    LAS unsigned char* lds = (LAS unsigned char*)lds_raw;
    const int tid = threadIdx.x, lane = tid & 63, wave = __builtin_amdgcn_readfirstlane(tid >> 6);
    const int G = gridDim.x; const int bx = blockIdx.x;
    const int vcu = (G % 8 == 0) ? (bx % 8) * (G / 8) + bx / 8 : bx;
    unsigned char* ws = args.ws;
    const float* x = args.in[0];
    bf16* WinT = (bf16*)(ws + WS_WIN); bf16* WaT = (bf16*)(ws + WS_WA); bf16* WbT = (bf16*)(ws + WS_WB); bf16* WoT = (bf16*)(ws + WS_WO);
    bf16* W1T = (bf16*)(ws + WS_W1); bf16* W2T = (bf16*)(ws + WS_W2);
    bf16* XN = (bf16*)(ws + WS_XN); bf16* QN = (bf16*)(ws + WS_QN); bf16* KV = (bf16*)(ws + WS_KV); bf16* ML = (bf16*)(ws + WS_ML); bf16* GB = (bf16*)(ws + WS_G);
    float* SB = (float*)(ws + WS_S); bf16* YA = (bf16*)(ws + WS_YA); bf16* YB = (bf16*)(ws + WS_YB); bf16* MX = (bf16*)(ws + WS_MX); bf16* UB = (bf16*)(ws + WS_U);
    float* rowss = (float*)(ws + WS_CTL + CTL_ROWSS);
    bf16* CK1T = (bf16*)(ws + WS_CK1); bf16* CV1T = (bf16*)(ws + WS_CV1); bf16* CK2T = (bf16*)(ws + WS_SMALL); bf16* CV2T = (bf16*)(ws + WS_SMALL + 32768);
    float* B1K = (float*)(ws + WS_SMALL + 65536); float* B1V = (float*)(ws + WS_SMALL + 65536 + 1024); float* BOUNDS = (float*)(ws + WS_SMALL + 65536 + 2048);
    bf16* KSN = (bf16*)(ws + WS_KSN); bf16* KWN = (bf16*)(ws + WS_KWN); bf16* VST = (bf16*)(ws + WS_VST); bf16* VWT = (bf16*)(ws + WS_VWT); bf16* KCN = (bf16*)(ws + WS_KCN); bf16* VCT = (bf16*)(ws + WS_VCT);
    bf16* QCb = (bf16*)args.out; bf16* KCb = QCb + (size_t)16 * 128 * 8192; bf16* KTb = KCb + (size_t)16 * 128 * 8192; bf16* VTb = KTb + (size_t)16 * 128 * 8192;
    float* GTb = (float*)(ws + WS_GT); float* RDb = (float*)(ws + WS_RD);
    volatile LAS unsigned* xbst = (volatile LAS unsigned*)(lds + XB_LDS_OFF);
    if (tid < 2) xbst[tid] = 0u;
    __syncthreads();
    XcdBarrier xbar = xcd_barrier_post((unsigned*)(ws + WS_CTL + CTL_BAR), xbst);
    const int lo = args.ph_lo, hi = args.ph_hi;
#define IN(k) (lo <= (k) && (k) < hi)
#define SEAM(k) do { if (IN(k) && IN((k) + 1)) { xcd_barrier(xbar); } } while (0)

    if (IN(0)) {
        LAS float* scr = (LAS float*)(lds + wave * 16384);
        const int gw = vcu * NWAVES + wave, NGW = G * NWAVES;
        constexpr int I_IN = (1024 / 64) * (NP_PAD / 32), I_A = (512 / 64) * (1024 / 32), I_O = (1024 / 64) * (1024 / 32), I_1 = (1024 / 64) * (4096 / 32), I_2 = (4096 / 64) * (1024 / 32);
        constexpr int I_C1 = (2048 / 64) * (256 / 32), I_C2 = (256 / 64) * (64 / 32), I_B1 = 512;
        constexpr int NITEMS = I_IN + 2 * I_A + I_O + I_1 + I_2 + 2 * I_C1 + 2 * I_C2 + I_B1 + 1;
        for (int pass = 0; pass < 2; ++pass) {
        if (((pass ^ gw) & 1) == 0)
        for (int it = gw; it < NITEMS; it += NGW) {
            int r = it;
            if (r < I_IN) { transpose_item<true>(args.in[2], 1024, D_PROJ, args.in[1], WinT, NP_PAD, scr, r, lane); continue; } r -= I_IN;
            if (r < I_A) { transpose_item<false>(args.in[20], 512, 1024, nullptr, WaT, 1024, scr, r, lane); continue; } r -= I_A;
            if (r < I_A) { transpose_item<false>(args.in[21], 512, 1024, nullptr, WbT, 1024, scr, r, lane); continue; } r -= I_A;
            if (r < I_O) { transpose_item<false>(args.in[22], 1024, 1024, nullptr, WoT, 1024, scr, r, lane); continue; } r -= I_O;
            if (r < I_1) { transpose_item<false>(args.in[24], 1024, 4096, args.in[23], W1T, 4096, scr, r, lane); continue; } r -= I_1;
            if (r < I_2) { transpose_item<false>(args.in[25], 4096, 1024, nullptr, W2T, 1024, scr, r, lane); continue; } r -= I_2;
            if (r < I_C1) { transpose_item<false>(args.in[6], 2048, 256, nullptr, CK1T, 256, scr, r, lane); continue; } r -= I_C1;
            if (r < I_C1) { transpose_item<false>(args.in[11], 2048, 256, nullptr, CV1T, 256, scr, r, lane); continue; } r -= I_C1;
            if (r < I_C2) { transpose_item<false>(args.in[8], 256, 64, nullptr, CK2T, 64, scr, r, lane); continue; } r -= I_C2;
            if (r < I_C2) { transpose_item<false>(args.in[13], 256, 64, nullptr, CV2T, 64, scr, r, lane); continue; } r -= I_C2;
            if (r < I_B1) {
                const int kv = r >> 8, u = r & 255; const float* pos = args.in[kv ? 10 : 5]; const float* w1 = args.in[kv ? 11 : 6]; const float* b1 = args.in[kv ? 12 : 7];
                float a = 0.f;
                for (int i = lane; i < 2048; i += 64) a += pos[i] * w1[(size_t)i * 256 + u];
                a = wave_sum(a);
                if (lane == 0) (kv ? B1V : B1K)[u] = a + b1[u];
                continue; } r -= I_B1;
            {
                float gq = fabsf(args.in[3][lane]); float gk = fmaxf(fmaxf(fabsf(args.in[4][lane]), fabsf(args.in[4][64 + lane])), fabsf(args.in[4][128 + lane]));
                gq = wave_max(gq); gk = wave_max(gk);
                if (lane < 8) { float mb = -1e30f; for (int bk = 0; bk < 32; ++bk) mb = fmaxf(mb, args.in[15][bk * 8 + lane] - args.in[15][31 * 8 + lane]);
                    const float top = (8.f * gq * gk + mb) * 1.4426950408889634f;
                    BOUNDS[lane] = top > 100.f ? 100.f - top : 0.f; }
            }
        }
        else
        for (int m = gw; m < NTOK; m += NGW) rms_row_to_bf16(x + (size_t)m * D_MODEL, XN + (size_t)m * D_MODEL, lane);
        }
    }
    SEAM(0);
    if (IN(1)) {
        pg8::Gemm g{XN, WinT, NTOK, NP_PAD, 1024}; pg8::StaticOrder S; S.init(NTOK, NP_PAD, G, bx);
        pg8::EpiProj E{QN, KV, ML, GB, SB};
        pg8::gemm_phase<pg8::EpiProj, pg8::StaticOrder, true, true>(lds, g, S, E);
    }
    SEAM(1);
    if (IN(2)) {
        const float* kgain = args.in[4];
        if (bx < 128) { const int kvs = bx & 1; compress_unit(bx, KV, kvs ? CV1T : CK1T, kvs ? CV2T : CK2T, kvs ? B1V : B1K, args.in[kvs ? 14 : 9], kgain, KCN, VCT, lds, tid); }
        else if (bx < 144) ml_gates_unit(bx - 128, SB, args.in[18], args.in[19], GTb, lds, tid);
        unsigned* pctr = (unsigned*)(ws + WS_CTL + CTL_QCTR) + 64;
        LAS int* pm = (LAS int*)(lds + 147000);
        LAS unsigned short* scr = (LAS unsigned short*)(lds + wave * 17408);
        for (;;) {
            __syncthreads();
            if (tid == 0) pm[0] = (int)atomicAdd(pctr, 1u);
            __syncthreads();
            const int u = pm[0];
            if (u >= 2048 + 512) break;
            if (u < 2048) ml_prep_unit(u, ML, args.in[16], args.in[17], QCb, KCb, KTb, VTb, lds, tid);
            else {
                const int it = (u - 2048) * 8 + wave;
                const int kind = it & 3, bgj = it >> 2, bg = bgj >> 7, j = bgj & 127, b = bg >> 1, g = bg & 1;
                const size_t tok0 = (size_t)b * SEQ + 64 * j;
                if (kind == 0) knorm_item(KV, 256 + 64 * g, kgain + 64, KSN + ((size_t)bg * SEQ + 64 * j) * 64, tok0, lane);
                else if (kind == 1) knorm_item(KV, 512 + 64 * g, kgain + 128, KWN + ((size_t)bg * SEQ + 64 * j) * 64, tok0, lane);
                else if (kind == 2) vtrans_item(KV, 384 + 64 * g, VST + ((size_t)bg * 128 + j) * 4096, tok0, scr, lane);
                else vtrans_item(KV, 640 + 64 * g, VWT + ((size_t)bg * 128 + j) * 4096, tok0, scr, lane);
            }
        }
    }
    SEAM(2);
    if (IN(3)) {
        if (bx < 16) { ChainPtrs CP{QCb, KCb, KTb, VTb, GTb, ML, YB, RDb}; ml_chain(bx, CP, lds, tid); }
        EngPtrs P{QN, KCN, VCT, KSN, VST, KWN, VWT, SB, args.in[15], args.in[3], BOUNDS, YA};
        unsigned* qctr = (unsigned*)(ws + WS_CTL + CTL_QCTR);
        LAS int* misc = (LAS int*)(lds + ENG_MISC);
        __syncthreads();
        eng_tables(args.in[15], lds, tid);
        for (;;) {
            __syncthreads();
            if (tid == 0) misc[0] = (int)atomicAdd(qctr, 1u);
            __syncthreads();
            const int u = misc[0];
            if (u >= 1024) break;
            eng_unit(u, P, lds, tid);
        }
    }
    SEAM(3);
    if (IN(4)) {
        {
            const int gt_ = bx * (NWAVES * 64) + tid, GT_ = G * NWAVES * 64;
            for (int i = gt_; i < NTOK * 64; i += GT_) {
                const int row = i >> 6, c8 = (i & 63) * 8;
                const v4u y = *(const v4u*)(YB + (size_t)row * 512 + c8), o = *(const v4u*)(ML + (size_t)row * 2048 + 1536 + c8);
                const float rd = RDb[(size_t)row * 4 + (c8 >> 7)];
                v4u r;
                r.x = pg8::cvt_pk_bf16(pg8::bf_lo(y.x) * pg8::bf_lo(o.x) * rd, pg8::bf_hi(y.x) * pg8::bf_hi(o.x) * rd); r.y = pg8::cvt_pk_bf16(pg8::bf_lo(y.y) * pg8::bf_lo(o.y) * rd, pg8::bf_hi(y.y) * pg8::bf_hi(o.y) * rd);
                r.z = pg8::cvt_pk_bf16(pg8::bf_lo(y.z) * pg8::bf_lo(o.z) * rd, pg8::bf_hi(y.z) * pg8::bf_hi(o.z) * rd); r.w = pg8::cvt_pk_bf16(pg8::bf_lo(y.w) * pg8::bf_lo(o.w) * rd, pg8::bf_hi(y.w) * pg8::bf_hi(o.w) * rd);
                *(v4u*)(YB + (size_t)row * 512 + c8) = r;
            }
        }
        pg8::Gemm g{YA, WaT, NTOK, 1024, 512}; pg8::StaticOrder S; S.init(NTOK, 1024, G, bx);
        pg8::EpiGate<false> E{GB, 0, MX};
        pg8::gemm_phase<pg8::EpiGate<false>, pg8::StaticOrder, true, true>(lds, g, S, E);
    }
    SEAM(4);
    if (IN(5)) {
        pg8::Gemm g{YB, WbT, NTOK, 1024, 512}; pg8::StaticOrder S; S.init(NTOK, 1024, G, bx);
        pg8::EpiGate<true> E{GB, 1024, MX};
        pg8::gemm_phase<pg8::EpiGate<true>, pg8::StaticOrder, true, true>(lds, g, S, E);
    }
    SEAM(5);
    if (IN(6)) {
        pg8::Gemm g{MX, WoT, NTOK, 1024, 1024}; pg8::StaticOrder S; S.init(NTOK, 1024, G, bx);
        pg8::EpiOut E{x, args.out, XN, rowss};
        pg8::gemm_phase<pg8::EpiOut, pg8::StaticOrder, true, true>(lds, g, S, E);
    }
    SEAM(6);
    if (IN(7)) {
        pg8::Gemm g{XN, W1T, NTOK, 4096, 1024}; pg8::StaticOrder S; S.init(NTOK, 4096, G, bx);
        pg8::EpiFF1 E{rowss, UB};
        pg8::gemm_phase<pg8::EpiFF1, pg8::StaticOrder, true, true>(lds, g, S, E);
    }
    SEAM(7);
    if (IN(8)) {
        pg8::Gemm g{UB, W2T, NTOK, 1024, 4096}; pg8::StaticOrder S; S.init(NTOK, 1024, G, bx);
        pg8::EpiFF2 E{args.out};
        pg8::gemm_phase<pg8::EpiFF2, pg8::StaticOrder, true, true>(lds, g, S, E);
    }
#undef IN
#undef SEAM
}

extern "C" void kernel_launch(void* const* d_in, const int* in_sizes, int n_in, void* d_out, int out_size, void* d_ws, size_t ws_size, hipStream_t stream) {
    static int grid = 0;
    if (grid == 0) {
        int dev = 0, cus = 0, per_cu = 0;
        if (hipGetDevice(&dev) != hipSuccess || hipDeviceGetAttribute(&cus, hipDeviceAttributeMultiprocessorCount, dev) != hipSuccess) { grid = -1; return; }
        if (hipFuncSetAttribute((const void*)mk_fwd, hipFuncAttributeMaxDynamicSharedMemorySize, LDS_BYTES) != hipSuccess) { fprintf(stderr, "hipFuncSetAttribute failed\n"); grid = -1; return; }
        if (hipOccupancyMaxActiveBlocksPerMultiprocessor(&per_cu, (const void*)mk_fwd, NWAVES * 64, LDS_BYTES) != hipSuccess || per_cu < 1) { fprintf(stderr, "occupancy query failed (%d)\n", per_cu); grid = -1; return; }
        if (ws_size < WS_END) { fprintf(stderr, "workspace too small: %zu < %zu\n", ws_size, (size_t)WS_END); grid = -1; return; }
        grid = cus;
    }
    if (grid < 0) return;
    (void)hipMemsetAsync((char*)d_ws + WS_CTL, 0, CTL_ZERO_BYTES, stream);
    Args a{};
    for (int i = 0; i < 26; ++i) a.in[i] = (const float*)d_in[i];
    a.out = (float*)d_out; a.ws = (unsigned char*)d_ws; a.ph_lo = 0; a.ph_hi = 9;
    void* kargs[] = {&a};
    hipError_t e = hipLaunchCooperativeKernel((const void*)mk_fwd, dim3(grid), dim3(NWAVES * 64), kargs, LDS_BYTES, stream);
    if (e != hipSuccess) fprintf(stderr, "cooperative launch failed: %s (grid %d)\n", hipGetErrorString(e), grid);
}
```
